# Optimizing an MI355X kernel written in HIP

```python
import jax, jax.numpy as jnp
from jax import lax
import numpy as np

D_MODEL = 4096
BATCH = 2
SEQ = 4096
DEPTH = 4

GRID_W = 64
CTX_LEN = 256
N_MIXERS = 2
N_RG = (DEPTH + N_MIXERS - 1) // N_MIXERS
N_NA = DEPTH // N_MIXERS
ADA_GAIN = 0.5
D_RNN = D_MODEL
LRU_BLOCK = 256
LRU_N_BLOCKS = D_RNN // LRU_BLOCK
CONV_W = 4
LRU_C = 8.0
N_HEADS = 32
HEAD_DIM = D_MODEL // N_HEADS
NA_KH = 8
NA_KW = 16
N_COL_BLOCKS = GRID_W // NA_KW
BAND_W = 2 * NA_KW
ATTN_SCALE = HEAD_DIM ** -0.5
EPS = 1e-6

kernel_name = "hybrid_rglru_natten_prefix_dit"


def rms_norm(x, g):
    xf = x.astype(jnp.float32)
    y = xf * lax.rsqrt(jnp.mean(xf * xf, axis=-1, keepdims=True) + EPS)
    return (y * g.astype(jnp.float32)).astype(x.dtype)


def centred_conv(u, w, b):
    t = u.shape[1]
    left = CONV_W // 2
    up = jnp.pad(u, ((0, 0), (left, CONV_W - 1 - left), (0, 0)))
    y = w[0] * up[:, 0:t]
    for k in range(1, CONV_W):
        y = y + w[k] * up[:, k:k + t]
    return y + b


def _affine_combine(left, right):
    a_l, b_l = left
    a_r, b_r = right
    return a_l * a_r, a_r * b_l + b_r


def linear_scan(a, b, h0, reverse):
    if reverse:
        a, b = a[:, ::-1], b[:, ::-1]
    b = b.at[:, 0].add(a[:, 0] * h0)
    _, hs = lax.associative_scan(_affine_combine, (a, b), axis=1)
    return hs[:, ::-1] if reverse else hs


def lru_coeffs(u, gate_w, gate_b, lam):
    bsz, t, _ = u.shape
    ub = u.reshape(bsz, t, LRU_N_BLOCKS, LRU_BLOCK)
    z = jnp.einsum('btnk,gnkj->gbtnj', ub, gate_w.astype(jnp.float32)).reshape(2, bsz, t, D_RNN)
    z = z + gate_b.astype(jnp.float32)[:, None, None, :]
    r = jax.nn.sigmoid(z[0])
    i_gate = jax.nn.sigmoid(z[1])
    log_a = -LRU_C * r * jax.nn.softplus(-lam.astype(jnp.float32))
    a = jnp.exp(log_a)
    b = jnp.sqrt(-jnp.expm1(2.0 * log_a)) * (i_gate * u)
    return a, b


def rglru_mixer(h, hc, in_w, conv_w, conv_b, gate_w, gate_b, lam, out_w, need_ctx):
    f32 = jnp.float32
    u, g = jnp.split(h @ in_w, 2, axis=-1)
    if need_ctx:
        uc, gc = jnp.split(hc @ in_w, 2, axis=-1)
    else:
        uc = hc @ in_w[:, :D_RNN]
    u = centred_conv(u, conv_w, conv_b).astype(f32)
    uc = centred_conv(uc, conv_w, conv_b).astype(f32)
    zeros = jnp.zeros((uc.shape[0], D_RNN), f32)
    a, b = lru_coeffs(uc, gate_w[0], gate_b[0], lam[0])
    hc_f = linear_scan(a, b, zeros, reverse=False)
    a, b = lru_coeffs(u, gate_w[0], gate_b[0], lam[0])
    h_f = linear_scan(a, b, hc_f[:, -1], reverse=False)
    a, b = lru_coeffs(uc, gate_w[1], gate_b[1], lam[1])
    hc_b = linear_scan(a, b, zeros, reverse=True)
    a, b = lru_coeffs(u, gate_w[1], gate_b[1], lam[1])
    h_b = linear_scan(a, b, hc_b[:, 0], reverse=True)
    y = ((h_f + h_b).astype(h.dtype) * jax.nn.silu(g)) @ out_w
    yc = (((hc_f + hc_b).astype(hc.dtype) * jax.nn.silu(gc)) @ out_w) if need_ctx else None
    return y, yc


def neighbourhood_attention(q, k, v, kc, vc, rpb):
    bsz, seq, n_heads, dh = q.shape
    rows = seq // GRID_W
    kh = min(NA_KH, rows)
    qg = q.reshape(bsz, rows, N_COL_BLOCKS, NA_KW, n_heads, dh)
    kg = k.reshape(bsz, rows, GRID_W, n_heads, dh)
    vg = v.reshape(bsz, rows, GRID_W, n_heads, dh)
    q_cols = jnp.arange(GRID_W).reshape(N_COL_BLOCKS, NA_KW)
    q_col_start = jnp.clip(q_cols - NA_KW // 2, 0, GRID_W - NA_KW)
    band_start = jnp.clip(jnp.arange(N_COL_BLOCKS) * NA_KW - NA_KW // 2, 0, GRID_W - BAND_W)
    band_cols = band_start[:, None] + jnp.arange(BAND_W)
    kcol = band_cols[:, None, :]
    col_mask = (kcol >= q_col_start[..., None]) & (kcol < q_col_start[..., None] + NA_KW)
    col_idx = jnp.clip(kcol - q_cols[..., None], -(NA_KW - 1), NA_KW - 1) + (NA_KW - 1)
    rpb_cols = rpb[:, :, col_idx]
    n_lat = kh * BAND_W

    def one_row(r):
        row_start = jnp.clip(r - kh // 2, 0, rows - kh)
        kr = jnp.take(lax.dynamic_slice_in_dim(kg, row_start, kh, axis=1), band_cols, axis=2)
        vr = jnp.take(lax.dynamic_slice_in_dim(vg, row_start, kh, axis=1), band_cols, axis=2)
        qr = lax.dynamic_index_in_dim(qg, r, axis=1, keepdims=False)
        s_lat = jnp.einsum('bnqhd,binchd->bhnqic', qr, kr, preferred_element_type=jnp.float32) * ATTN_SCALE
        row_idx = row_start + jnp.arange(kh) - r + (NA_KH - 1)
        bias = jnp.take(rpb_cols, row_idx, axis=1).transpose(0, 2, 3, 1, 4)
        s_lat = jnp.where(col_mask[:, :, None, :], s_lat + bias.astype(jnp.float32), -jnp.inf)
        s_ctx = jnp.einsum('bnqhd,bkhd->bhnqk', qr, kc, preferred_element_type=jnp.float32) * ATTN_SCALE
        sh = s_lat.shape
        p = jax.nn.softmax(jnp.concatenate([s_lat.reshape(sh[0], sh[1], sh[2], sh[3], n_lat), s_ctx], axis=-1), axis=-1)
        p_lat = p[..., :n_lat].reshape(sh).astype(v.dtype)
        p_ctx = p[..., n_lat:].astype(v.dtype)
        return (jnp.einsum('bhnqic,binchd->bnqhd', p_lat, vr)
                + jnp.einsum('bhnqk,bkhd->bnqhd', p_ctx, vc))

    out = lax.map(one_row, jnp.arange(rows))
    return jnp.moveaxis(out, 0, 1).reshape(bsz, seq, n_heads, dh)


def context_attention(qc, kc, vc):
    s = jnp.einsum('bqhd,bkhd->bhqk', qc, kc, preferred_element_type=jnp.float32) * ATTN_SCALE
    p = jax.nn.softmax(s, axis=-1).astype(vc.dtype)
    return jnp.einsum('bhqk,bkhd->bqhd', p, vc)


def na_mixer(h, hc, in_w, qk_norm, rpb, out_w, need_ctx):
    bsz, seq, _ = h.shape
    n_ctx = hc.shape[1]
    q, k, v, g = jnp.split(h @ in_w, 4, axis=-1)
    q = rms_norm(q.reshape(bsz, seq, N_HEADS, HEAD_DIM), qk_norm[0])
    k = rms_norm(k.reshape(bsz, seq, N_HEADS, HEAD_DIM), qk_norm[1])
    v = v.reshape(bsz, seq, N_HEADS, HEAD_DIM)
    if need_ctx:
        qc, kc, vc, gc = jnp.split(hc @ in_w, 4, axis=-1)
    else:
        kc, vc = jnp.split(hc @ in_w[:, D_MODEL:3 * D_MODEL], 2, axis=-1)
    kc = rms_norm(kc.reshape(bsz, n_ctx, N_HEADS, HEAD_DIM), qk_norm[1])
    vc = vc.reshape(bsz, n_ctx, N_HEADS, HEAD_DIM)
    o = neighbourhood_attention(q, k, v, kc, vc, rpb)
    y = (o.reshape(bsz, seq, D_MODEL) * jax.nn.silu(g)) @ out_w
    yc = None
    if need_ctx:
        qc = rms_norm(qc.reshape(bsz, n_ctx, N_HEADS, HEAD_DIM), qk_norm[0])
        oc = context_attention(qc, kc, vc)
        yc = (oc.reshape(bsz, n_ctx, D_MODEL) * jax.nn.silu(gc)) @ out_w
    return y, yc


def setup_inputs(seed: int = 0) -> dict:
    key = jax.random.key(seed)
    ks = jax.random.split(key, 18)
    f32 = jnp.float32

    def nrm(k, shape, s):
        return jax.random.normal(k, shape, f32) * s

    a_pow = jax.random.uniform(ks[12], (N_RG, 2, D_RNN), f32, 0.9, 0.999)
    s_lam = a_pow ** (1.0 / LRU_C)
    return {
        'x': nrm(ks[0], (BATCH, SEQ, D_MODEL), 1.0),
        'c': nrm(ks[1], (BATCH, D_MODEL), 1.0),
        'ctx': nrm(ks[2], (BATCH, CTX_LEN, D_MODEL), 1.0),
        'c_ctx': nrm(ks[3], (D_MODEL,), 1.0),
        'ada_w': nrm(ks[4], (DEPTH, D_MODEL, 3 * D_MODEL), ADA_GAIN * D_MODEL ** -0.5),
        'ada_b': nrm(ks[5], (DEPTH, 3 * D_MODEL), 0.01),
        'norm_g': 1.0 + nrm(ks[6], (DEPTH, D_MODEL), 0.02),
        'lru_in_w': nrm(ks[7], (N_RG, D_MODEL, 2 * D_RNN), D_MODEL ** -0.5),
        'lru_conv_w': nrm(ks[8], (N_RG, CONV_W, D_RNN), CONV_W ** -0.5),
        'lru_conv_b': nrm(ks[9], (N_RG, D_RNN), 0.01),
        'lru_gate_w': nrm(ks[10], (N_RG, 2, 2, LRU_N_BLOCKS, LRU_BLOCK, LRU_BLOCK), LRU_BLOCK ** -0.5),
        'lru_gate_b': nrm(ks[11], (N_RG, 2, 2, D_RNN), 0.01),
        'lru_lambda': jnp.log(s_lam) - jnp.log1p(-s_lam),
        'lru_out_w': nrm(ks[13], (N_RG, D_RNN, D_MODEL), D_RNN ** -0.5),
        'na_in_w': nrm(ks[14], (N_NA, D_MODEL, 4 * D_MODEL), D_MODEL ** -0.5),
        'na_qk_norm': 1.0 + nrm(ks[15], (N_NA, 2, HEAD_DIM), 0.02),
        'na_rpb': nrm(ks[16], (N_NA, N_HEADS, 2 * NA_KH - 1, 2 * NA_KW - 1), 0.1),
        'na_out_w': nrm(ks[17], (N_NA, D_MODEL, D_MODEL), D_MODEL ** -0.5),
    }


def reference(x, c, ctx, c_ctx, ada_w, ada_b, norm_g, lru_in_w, lru_conv_w, lru_conv_b, lru_gate_w,
              lru_gate_b, lru_lambda, lru_out_w, na_in_w, na_qk_norm, na_rpb, na_out_w):
    cond = jax.nn.silu(c)
    cond_ctx = jax.nn.silu(c_ctx)
    for i in range(DEPTH):
        need_ctx = i < DEPTH - 1
        shift, scale, gate = jnp.split(cond @ ada_w[i] + ada_b[i], 3, axis=-1)
        shift_c, scale_c, gate_c = jnp.split(cond_ctx @ ada_w[i] + ada_b[i], 3, axis=-1)
        h = rms_norm(x, norm_g[i]) * (1.0 + scale[:, None, :]) + shift[:, None, :]
        hc = rms_norm(ctx, norm_g[i]) * (1.0 + scale_c) + shift_c
        j = i // N_MIXERS
        if i % N_MIXERS == 0:
            y, yc = rglru_mixer(h, hc, lru_in_w[j], lru_conv_w[j], lru_conv_b[j], lru_gate_w[j],
                                lru_gate_b[j], lru_lambda[j], lru_out_w[j], need_ctx)
        else:
            y, yc = na_mixer(h, hc, na_in_w[j], na_qk_norm[j], na_rpb[j], na_out_w[j], need_ctx)
        x = x + gate[:, None, :] * y
        if need_ctx:
            ctx = ctx + gate_c * yc
    return x
```

```cpp
#include <hip/hip_runtime.h>
#include <cstdio>
#include <cstdint>
namespace pg8 {
#define PG8_LAS __attribute__((address_space(3)))
typedef unsigned short bf16_t;
typedef short bf16x8 __attribute__((ext_vector_type(8)));
typedef float f32x4 __attribute__((ext_vector_type(4)));
typedef unsigned u32x4 __attribute__((ext_vector_type(4)));
constexpr int BM = 256, BK = 64, HALF = 128, HTB = HALF * BK * 2  , STAGE_BYTES = 8 * HTB, NXCD = 8, WGM = 8;

__host__ __device__ __forceinline__ int lds_byte(int r, int c) { const int st = (r >> 4) * 2 + (c >> 5), rr = r & 15, cc = c & 31, ob = rr * 64 + cc * 2; return st * 1024 + (ob ^ (((ob >> 9) & 1) << 5)); }
__host__ __device__ __forceinline__ void stage_rc(int b, int& R, int& C) { const int st = b / 1024, sb = b % 1024, swz = sb ^ (((sb >> 9) & 1) << 5); R = (st >> 1) * 16 + swz / 64; C = (st & 1) * 32 + (swz % 64) / 2; }
__host__ __device__ __forceinline__ int perm32(int rho) { const int n = rho >> 4, i = rho & 15; return 8 * (i >> 2) + 4 * n + (i & 3); }

struct Unit { int pm, pn; };
struct Gemm { const bf16_t* A; const bf16_t* Bt; int M, N, K; };

struct StaticOrder {
    int nM, nN, nwg, G, c;
    __host__ __device__ void init(int M, int N, int G_, int c_) { nM = M / BM; nN = N / BM; nwg = nM * nN; G = G_; c = c_; }
    __host__ __device__ bool next(int i, Unit& u) const {
        const long L = (long)i * G + c; if (L >= nwg) return false;
        int wgid = (int)L; { const int q = nwg / NXCD, r = nwg % NXCD, xcd = wgid % NXCD, off = wgid / NXCD; wgid = (xcd < r ? xcd * (q + 1) : r * (q + 1) + (xcd - r) * q) + off; }
        const int nig = WGM * nN, gid = wgid / nig, fm = gid * WGM, gsz = (nM - fm) < WGM ? (nM - fm) : WGM;
        u.pm = fm + ((wgid % nig) % gsz); u.pn = (wgid % nig) / gsz; return true;
    }
    __device__ __forceinline__ void a_ready(const Unit&) const {}
    __device__ __forceinline__ void done(const Unit&) const {}
};

__device__ __forceinline__ unsigned cvt_pk_bf16(float lo, float hi) { unsigned r; asm volatile("v_cvt_pk_bf16_f32 %0, %1, %2" : "=v"(r) : "v"(lo), "v"(hi)); return r; }
__device__ __forceinline__ float silu_f(float v) { return v * __builtin_amdgcn_rcpf(1.0f + __builtin_amdgcn_exp2f(-1.4426950408889634f * v)); }
__device__ __forceinline__ f32x4 silu4(f32x4 v) { f32x4 o; o[0] = silu_f(v[0]); o[1] = silu_f(v[1]); o[2] = silu_f(v[2]); o[3] = silu_f(v[3]); return o; }
constexpr int DM = 4096;

struct EpiRgIn {
    static constexpr bool PERM = true, AFTER_DRAIN = false;
    bf16_t* U; bf16_t* G;
    __device__ __forceinline__ void operator()(const f32x4 (&acc)[2][2][4][2], const Unit& u, int wr, int wc, int fr, int fq) const {
        const int row0 = u.pm * BM + wr * 64 + fr; const bool isg = u.pn >= 16; bf16_t* base = isg ? G : U; const int col0 = (u.pn & 15) * BM + wc * 32 + 8 * fq;
#pragma unroll
        for (int ai = 0; ai < 2; ++ai)
#pragma unroll
            for (int m = 0; m < 4; ++m) { bf16_t* rowp = base + (size_t)(row0 + ai * HALF + m * 16) * DM + col0;
#pragma unroll
                for (int bj = 0; bj < 2; ++bj) { f32x4 v0 = acc[ai][bj][m][0], v1 = acc[ai][bj][m][1];
                    if (isg) { v0 = silu4(v0); v1 = silu4(v1); }
                    u32x4 w; w.x = cvt_pk_bf16(v0[0], v0[1]); w.y = cvt_pk_bf16(v0[2], v0[3]); w.z = cvt_pk_bf16(v1[0], v1[1]); w.w = cvt_pk_bf16(v1[2], v1[3]);
                    *(u32x4*)(rowp + bj * HALF) = w; } }
    }
};
struct EpiNaIn {
    static constexpr bool PERM = true, AFTER_DRAIN = false;
    bf16_t *Q, *K, *V, *G; const float* qkn; PG8_LAS float* P;
    __device__ __forceinline__ void operator()(const f32x4 (&acc)[2][2][4][2], const Unit& u, int wr, int wc, int fr, int fq) const {
        const int t = u.pn >> 4; bf16_t* base = t == 0 ? Q : (t == 1 ? K : (t == 2 ? V : G));
        const int row0 = u.pm * BM + wr * 64 + fr, col0 = (u.pn & 15) * BM + wc * 32 + 8 * fq;
        if (t < 2) {
#pragma unroll
            for (int ai = 0; ai < 2; ++ai)
#pragma unroll
                for (int m = 0; m < 4; ++m)
#pragma unroll
                    for (int bj = 0; bj < 2; ++bj) { const f32x4 a = acc[ai][bj][m][0], b = acc[ai][bj][m][1];
                        float s = (a[0] * a[0] + a[1] * a[1]) + (a[2] * a[2] + a[3] * a[3]) + (b[0] * b[0] + b[1] * b[1]) + (b[2] * b[2] + b[3] * b[3]);
                        s += __shfl_xor(s, 16); s += __shfl_xor(s, 32);
                        if (fq == 0) P[((ai * HALF + wr * 64 + m * 16 + fr) * 2 + bj) * 4 + wc] = s; }
            asm volatile("s_waitcnt lgkmcnt(0)" ::: "memory"); __builtin_amdgcn_s_barrier(); asm volatile("" ::: "memory");
            const float* wg = qkn + t * 128 + wc * 32 + 8 * fq; const f32x4 w0 = *(const f32x4*)wg, w1 = *(const f32x4*)(wg + 4);
#pragma unroll
            for (int ai = 0; ai < 2; ++ai)
#pragma unroll
                for (int m = 0; m < 4; ++m) { bf16_t* rowp = base + (size_t)(row0 + ai * HALF + m * 16) * DM + col0;
#pragma unroll
                    for (int bj = 0; bj < 2; ++bj) { const f32x4 p = *(const PG8_LAS f32x4*)(P + ((ai * HALF + wr * 64 + m * 16 + fr) * 2 + bj) * 4);
                        const float rinv = __builtin_amdgcn_rsqf(((p[0] + p[1]) + (p[2] + p[3])) * (1.0f / 128.0f) + 1e-6f);
                        const f32x4 v0 = acc[ai][bj][m][0] * rinv * w0, v1 = acc[ai][bj][m][1] * rinv * w1;
                        u32x4 w; w.x = cvt_pk_bf16(v0[0], v0[1]); w.y = cvt_pk_bf16(v0[2], v0[3]); w.z = cvt_pk_bf16(v1[0], v1[1]); w.w = cvt_pk_bf16(v1[2], v1[3]);
                        *(u32x4*)(rowp + bj * HALF) = w; } }
        } else {
#pragma unroll
            for (int ai = 0; ai < 2; ++ai)
#pragma unroll
                for (int m = 0; m < 4; ++m) { bf16_t* rowp = base + (size_t)(row0 + ai * HALF + m * 16) * DM + col0;
#pragma unroll
                    for (int bj = 0; bj < 2; ++bj) { f32x4 v0 = acc[ai][bj][m][0], v1 = acc[ai][bj][m][1];
                        if (t == 3) { v0 = silu4(v0); v1 = silu4(v1); }
                        u32x4 w; w.x = cvt_pk_bf16(v0[0], v0[1]); w.y = cvt_pk_bf16(v0[2], v0[3]); w.z = cvt_pk_bf16(v1[0], v1[1]); w.w = cvt_pk_bf16(v1[2], v1[3]);
                        *(u32x4*)(rowp + bj * HALF) = w; } }
        }
    }
};
struct EpiOut {
    static constexpr bool PERM = false, AFTER_DRAIN = false;
    const float* src_lat; const float* src_ctx; float* dst; const float* gate;
    __device__ __forceinline__ void operator()(const f32x4 (&acc)[2][2][4][2], const Unit& u, int wr, int wc, int fr, int fq) const {
        const int row0 = u.pm * BM + wr * 64 + fr, col0 = u.pn * BM + wc * 32 + 4 * fq; const int r = u.pm < 32 ? (u.pm >> 4) : 2;
        const float* gp = gate + (size_t)r * (3 * DM) + col0;
        f32x4 gv[2][2];
#pragma unroll
        for (int bj = 0; bj < 2; ++bj)
#pragma unroll
            for (int n = 0; n < 2; ++n) gv[bj][n] = *(const f32x4*)(gp + bj * HALF + n * 16);
#pragma unroll
        for (int ai = 0; ai < 2; ++ai)
#pragma unroll
            for (int m = 0; m < 4; ++m) { const int row = row0 + ai * HALF + m * 16;
                const float* sp = (row < 8192 ? src_lat + (size_t)row * DM : src_ctx + (size_t)(row - 8192) * DM) + col0; float* dp = dst + (size_t)row * DM + col0;
#pragma unroll
                for (int bj = 0; bj < 2; ++bj)
#pragma unroll
                    for (int n = 0; n < 2; ++n) *(f32x4*)(dp + bj * HALF + n * 16) = *(const f32x4*)(sp + bj * HALF + n * 16) + gv[bj][n] * acc[ai][bj][m][n]; }
    }
};

template <class Epi, class Sched, bool ALIGN_EPI = false, bool SP2 = false>
__device__ __forceinline__ void gemm_phase(PG8_LAS unsigned char* lds, const Gemm g, const Sched& S, const Epi& E) {
    int tid_o = threadIdx.x; asm volatile("" : "+v"(tid_o));
    const int tid = tid_o, wid = __builtin_amdgcn_readfirstlane(tid >> 6), lane = tid & 63, wr = wid >> 2, wc = wid & 3, fr = lane & 15, fq = lane >> 4;
    const int K = g.K, nt = K / BK;
    unsigned voffA[2], voffB[2];
#pragma unroll
    for (int i = 0; i < 2; ++i) { int R, C; stage_rc(tid * 16 + i * 8192, R, C); const int Rb = Epi::PERM ? ((R & ~31) + perm32(R & 31)) : R;
        voffA[i] = (unsigned)(R * K + C) * 2u; voffB[i] = (unsigned)(Rb * K + C) * 2u; }
    const size_t kstep = (size_t)(BK * 2);
    const size_t hstep = (size_t)HALF * K * 2;
    const size_t tstep = 2 * hstep;
    const unsigned ldsw = (unsigned)wid * 1024u;
    const int aoff = lds_byte(wr * 64 + fr, fq * 8), boff = lds_byte(wc * 32 + fr, fq * 8);
#define PG8_SA(b, h) (((b) * 2 + (h)) * HTB)
#define PG8_SB(b, h) ((4 + (b) * 2 + (h)) * HTB)
#define PG8_STAGE(bufoff, gbase, voff) do { _Pragma("unroll") for (int _i = 0; _i < 2; ++_i) \
        __builtin_amdgcn_global_load_lds((const unsigned*)((const char*)(gbase) + (voff)[_i]), (PG8_LAS unsigned*)(lds + (bufoff) + ldsw + _i * 8192), 16, 0, 0); } while (0)
#define PG8_LDA(dst, b, h) do { _Pragma("unroll") for (int m = 0; m < 4; ++m) _Pragma("unroll") for (int k = 0; k < 2; ++k) dst[m][k] = *(const PG8_LAS bf16x8*)(lds + PG8_SA(b, h) + aoff + m * 2048 + k * 1024); } while (0)
#define PG8_LDB(dst, b, h) do { _Pragma("unroll") for (int n = 0; n < 2; ++n) _Pragma("unroll") for (int k = 0; k < 2; ++k) dst[n][k] = *(const PG8_LAS bf16x8*)(lds + PG8_SB(b, h) + boff + n * 2048 + k * 1024); } while (0)
#define PG8_MMA(ai, bj, At, Bt) do { __builtin_amdgcn_s_setprio(1); _Pragma("unroll") for (int m = 0; m < 4; ++m) _Pragma("unroll") for (int n = 0; n < 2; ++n) _Pragma("unroll") for (int k = 0; k < 2; ++k) \
        acc[ai][bj][m][n] = __builtin_amdgcn_mfma_f32_16x16x32_bf16(Bt[n][k], At[m][k], acc[ai][bj][m][n], 0, 0, 0); __builtin_amdgcn_s_setprio(0); } while (0)
#define PG8_WAIT_V(n) asm volatile("s_waitcnt vmcnt(" #n ")" ::: "memory")
#define PG8_WAIT_L(n) asm volatile("s_waitcnt lgkmcnt(" #n ")" ::: "memory")
#define PG8_BAR __builtin_amdgcn_s_barrier()
#define PG8_SCHED __builtin_amdgcn_sched_barrier(0)
    Unit cur, nxt; int ui = 0;
    if (!S.next(0, cur)) return;
    f32x4 acc[2][2][4][2];
#pragma unroll
    for (int a = 0; a < 2; ++a)
#pragma unroll
        for (int b = 0; b < 2; ++b)
#pragma unroll
            for (int m = 0; m < 4; ++m)
#pragma unroll
                for (int n = 0; n < 2; ++n) acc[a][b][m][n] = (f32x4){0.f, 0.f, 0.f, 0.f};
    bf16x8 At[4][2], B0[2][2], B1[2][2];
    const char* cA = (const char*)g.A + (size_t)cur.pm * tstep; const char* cB = (const char*)g.Bt + (size_t)cur.pn * tstep;
    S.a_ready(cur);
    if constexpr (SP2) {
        PG8_STAGE(PG8_SB(0, 0), cB, voffB); PG8_STAGE(PG8_SB(0, 1), cB + hstep, voffB); PG8_STAGE(PG8_SA(0, 0), cA, voffA); PG8_STAGE(PG8_SA(0, 1), cA + hstep, voffA);
        if (wr == 1) PG8_BAR;
        PG8_WAIT_V(2); PG8_BAR;
        PG8_STAGE(PG8_SB(1, 0), cB + kstep, voffB); PG8_STAGE(PG8_SA(1, 0), cA + kstep, voffA); PG8_STAGE(PG8_SB(1, 1), cB + hstep + kstep, voffB);
        PG8_WAIT_V(6); PG8_BAR;
    } else {
        PG8_STAGE(PG8_SB(0, 0), cB, voffB); PG8_STAGE(PG8_SA(0, 0), cA, voffA); PG8_STAGE(PG8_SB(0, 1), cB + hstep, voffB); PG8_STAGE(PG8_SA(0, 1), cA + hstep, voffA);
        if (wr == 1) PG8_BAR;
        PG8_WAIT_V(4); PG8_BAR;
        PG8_STAGE(PG8_SB(1, 0), cB + kstep, voffB); PG8_STAGE(PG8_SA(1, 0), cA + kstep, voffA); PG8_STAGE(PG8_SB(1, 1), cB + hstep + kstep, voffB);
        PG8_WAIT_V(6); PG8_BAR;
    }
    for (;;) {
        const bool has_next = S.next(ui + 1, nxt);
        const char* nA = has_next ? (const char*)g.A + (size_t)nxt.pm * tstep : cA; const char* nB = has_next ? (const char*)g.Bt + (size_t)nxt.pn * tstep : cB;
        for (int t = 0; t < nt; t += 2) {
            const bool last = (t == nt - 2);
            const char* a1 = cA + (size_t)(t + 1) * kstep;
            const char* a2 = last ? nA : cA + (size_t)(t + 2) * kstep; const char* b2 = last ? nB : cB + (size_t)(t + 2) * kstep;
            const char* a3 = a2 + kstep; const char* b3 = b2 + kstep;
            if (last && has_next) S.a_ready(nxt);
            if constexpr (SP2) {
            PG8_LDB(B0, 0, 0); PG8_LDB(B1, 0, 1); PG8_SCHED; PG8_LDA(At, 0, 0); PG8_STAGE(PG8_SA(1, 1), a1 + hstep, voffA);
            PG8_WAIT_V(8); PG8_WAIT_L(0); PG8_BAR; PG8_MMA(0, 0, At, B0); PG8_MMA(0, 1, At, B1); PG8_BAR; PG8_SCHED;
            PG8_LDA(At, 0, 1); PG8_STAGE(PG8_SB(0, 0), b2, voffB); PG8_STAGE(PG8_SB(0, 1), b2 + hstep, voffB); PG8_STAGE(PG8_SA(0, 0), a2, voffA);
            PG8_WAIT_V(8); PG8_WAIT_L(0); PG8_BAR; PG8_MMA(1, 0, At, B0); PG8_MMA(1, 1, At, B1); PG8_BAR; PG8_SCHED;
            PG8_LDB(B0, 1, 0); PG8_LDB(B1, 1, 1); PG8_SCHED; PG8_LDA(At, 1, 0); PG8_STAGE(PG8_SA(0, 1), a2 + hstep, voffA);
            PG8_WAIT_V(8); PG8_WAIT_L(0); PG8_BAR; PG8_MMA(0, 0, At, B0); PG8_MMA(0, 1, At, B1); PG8_BAR; PG8_SCHED;
            PG8_LDA(At, 1, 1); PG8_STAGE(PG8_SB(1, 0), b3, voffB); PG8_STAGE(PG8_SB(1, 1), b3 + hstep, voffB); PG8_STAGE(PG8_SA(1, 0), a3, voffA);
            PG8_WAIT_V(8); PG8_WAIT_L(0); PG8_BAR; PG8_MMA(1, 0, At, B0); PG8_MMA(1, 1, At, B1); PG8_BAR; PG8_SCHED;
            } else {
            PG8_LDB(B0, 0, 0); PG8_SCHED; PG8_LDA(At, 0, 0); PG8_STAGE(PG8_SA(1, 1), a1 + hstep, voffA);
            PG8_WAIT_L(8); PG8_BAR; PG8_WAIT_L(0); PG8_MMA(0, 0, At, B0); PG8_BAR; PG8_SCHED;
            PG8_LDB(B1, 0, 1); PG8_STAGE(PG8_SB(0, 0), b2, voffB);
            PG8_BAR; PG8_WAIT_L(0); PG8_MMA(0, 1, At, B1); PG8_BAR;
            PG8_LDA(At, 0, 1); PG8_STAGE(PG8_SA(0, 0), a2, voffA);
            PG8_BAR; PG8_WAIT_L(0); PG8_MMA(1, 0, At, B0); PG8_BAR; PG8_SCHED;
            PG8_STAGE(PG8_SB(0, 1), b2 + hstep, voffB);
            PG8_WAIT_V(6); PG8_BAR; PG8_MMA(1, 1, At, B1); PG8_BAR;
            PG8_LDB(B0, 1, 0); PG8_SCHED; PG8_LDA(At, 1, 0); PG8_STAGE(PG8_SA(0, 1), a2 + hstep, voffA);
            PG8_WAIT_L(8); PG8_BAR; PG8_WAIT_L(0); PG8_MMA(0, 0, At, B0); PG8_BAR; PG8_SCHED;
            PG8_LDB(B1, 1, 1); PG8_STAGE(PG8_SB(1, 0), b3, voffB);
            PG8_BAR; PG8_WAIT_L(0); PG8_MMA(0, 1, At, B1); PG8_BAR;
            PG8_LDA(At, 1, 1); PG8_STAGE(PG8_SA(1, 0), a3, voffA);
            PG8_BAR; PG8_WAIT_L(0); PG8_MMA(1, 0, At, B0); PG8_BAR; PG8_SCHED;
            PG8_STAGE(PG8_SB(1, 1), b3 + hstep, voffB);
            PG8_WAIT_V(6); PG8_BAR; PG8_MMA(1, 1, At, B1); PG8_BAR;
            }
        }
        if constexpr (ALIGN_EPI) { if (wr == 0) PG8_BAR; }
        if constexpr (!Epi::AFTER_DRAIN) { E(acc, cur, wr, wc, fr, fq); S.done(cur); }
        if (!has_next) break;
#pragma unroll
        for (int a = 0; a < 2; ++a)
#pragma unroll
            for (int b = 0; b < 2; ++b)
#pragma unroll
                for (int m = 0; m < 4; ++m)
#pragma unroll
                    for (int n = 0; n < 2; ++n) acc[a][b][m][n] = (f32x4){0.f, 0.f, 0.f, 0.f};
        cur = nxt; cA = nA; cB = nB; ++ui;
        if constexpr (ALIGN_EPI) { if (wr == 1) PG8_BAR; }
    }
    PG8_WAIT_V(0);
    if constexpr (!ALIGN_EPI) { if (wr == 0) PG8_BAR; }
    PG8_BAR;
    if constexpr (Epi::AFTER_DRAIN) { E.fused(acc, cur, wr, wc, fr, fq, lds, wid, lane); S.done(cur); }
#undef PG8_SA
#undef PG8_SB
#undef PG8_STAGE
#undef PG8_LDA
#undef PG8_LDB
#undef PG8_MMA
#undef PG8_WAIT_V
#undef PG8_WAIT_L
#undef PG8_BAR
#undef PG8_SCHED
}
}

constexpr int NWAVES = 8;
constexpr int D = 4096, NBATCH = 2, SEQ = 4096, CTXL = 256, DEPTH = 4, NHEAD = 32, HDIM = 128;
constexpr int ML = NBATCH * SEQ;
constexpr int MC = NBATCH * CTXL;
constexpr int MT = ML + MC;
constexpr float EPS = 1e-6f;
constexpr float LOG2E = 1.4426950408889634f;
constexpr float ATTN_C1 = 0.08838834764831845f * LOG2E;

#ifndef MK_PER_PHASE
#define MK_PER_PHASE 0
#endif
constexpr int NPHASE = 19;

constexpr size_t MiB = 1u << 20;
constexpr size_t WS_CTL = 0, CTL_ZERO_BYTES = 1 * MiB;
constexpr size_t WS_MOD = 1 * MiB;
constexpr size_t WS_AGG = 2 * MiB;
constexpr size_t WS_WGATE = 8 * MiB;
constexpr size_t WS_WLIN = 24 * MiB;
constexpr size_t WS_WLOUT = 152 * MiB;
constexpr size_t WS_WNIN = 216 * MiB;
constexpr size_t WS_WNOUT = 472 * MiB;
constexpr size_t WS_XRES = 536 * MiB;
constexpr size_t WS_H = 672 * MiB;
constexpr size_t WS_A = 740 * MiB, WS_B = 808 * MiB, WS_C = 876 * MiB, WS_D = 944 * MiB;
constexpr size_t WS_END = 1012 * MiB;
constexpr int CW_BAR = 4096;

constexpr int RING_BYTES = 131072;
constexpr int EPI_P_OFF = RING_BYTES;
constexpr int MISC_OFF = RING_BYTES + 8192 + 320;
constexpr int LDS_BYTES = 147456;

#define GAS __attribute__((address_space(1)))
#define LAS __attribute__((address_space(3)))
#define DI __device__ __forceinline__
typedef unsigned short bf16;
typedef unsigned v4u __attribute__((ext_vector_type(4)));
typedef unsigned v2u __attribute__((ext_vector_type(2)));
typedef float f32x4 __attribute__((ext_vector_type(4)));
typedef float f32x16 __attribute__((ext_vector_type(16)));
typedef short bf16x8 __attribute__((ext_vector_type(8)));
typedef short s16x4 __attribute__((ext_vector_type(4)));
#define LDS_WAIT() asm volatile("s_waitcnt lgkmcnt(0)" ::: "memory")
#define VM_WAIT() asm volatile("s_waitcnt vmcnt(0)" ::: "memory")
DI unsigned pk2(float lo, float hi) { return pg8::cvt_pk_bf16(lo, hi); }
DI float bflo(unsigned w) { return __uint_as_float(w << 16); }
DI float bfhi(unsigned w) { return __uint_as_float(w & 0xffff0000u); }
DI float fast_exp2(float x) { return __builtin_amdgcn_exp2f(x); }
DI float fast_rcp(float x) { return __builtin_amdgcn_rcpf(x); }

#define XB_TMO      128
#define XB_XCNT(j)  (256  + 64 * (j))
#define XB_XSUB(j)  (1280 + 64 * (j))
#define XB_XGEN(j)  (2304 + 64 * (j))
#define XB_TOP      3328
#define XB_TOPGEN   3392
#define XCD_BAR_WORDS 3456
#define XB_SPIN_CAP (1u << 18)
__device__ __forceinline__ unsigned xb_ld(unsigned* p)              { return __hip_atomic_load(p, __ATOMIC_RELAXED, __HIP_MEMORY_SCOPE_AGENT); }
__device__ __forceinline__ unsigned xb_add(unsigned* p, unsigned v) { return __hip_atomic_fetch_add(p, v, __ATOMIC_RELAXED, __HIP_MEMORY_SCOPE_AGENT); }
__device__ __forceinline__ unsigned xb_xcc_id() { return (unsigned)__builtin_amdgcn_s_getreg((3 << 11) | 20) & 0xFu; }
#define XB_SPIN(cond, bar) do { unsigned _sp = 0; while (cond) { __builtin_amdgcn_s_sleep(1); \
    if ((++_sp & 255u) == 0u) { if (xb_ld(&(bar)[XB_TMO])) break; if (_sp > XB_SPIN_CAP) { atomicAdd(&(bar)[XB_TMO], 1u); break; } } } } while (0)
struct XcdBarrier { unsigned* bar; unsigned x; volatile LAS unsigned* st; };
__device__ __forceinline__ XcdBarrier xcd_barrier_post(unsigned* bar, volatile LAS unsigned* st) {
    XcdBarrier b; b.bar = bar; b.x = xb_xcc_id(); b.st = st;
    if (threadIdx.x == 0) (void)xb_add(&bar[XB_XCNT(b.x)], 1u);
    return b;
}
__device__ __forceinline__ void xcd_barrier_complete(unsigned* bar, unsigned x, unsigned& nloc, unsigned& nx) {
    const unsigned G = gridDim.x * gridDim.y * gridDim.z;
    unsigned sum, cnt, mine, sp = 0u;
    for (;;) {
        sum = 0u; cnt = 0u; mine = 0u;
#pragma unroll
        for (unsigned j = 0; j < 16; ++j) { const unsigned c = xb_ld(&bar[XB_XCNT(j)]); sum += c; cnt += (c > 0u) ? 1u : 0u; mine = (j == x) ? c : mine; }
        if (sum == G) break;
        __builtin_amdgcn_s_sleep(1);
        if ((++sp & 255u) == 0u) { if (xb_ld(&bar[XB_TMO])) break; if (sp > XB_SPIN_CAP) { atomicAdd(&bar[XB_TMO], 1u); break; } }
    }
    nloc = mine > 0u ? mine : 1u; nx = cnt > 0u ? cnt : 1u;
}
__device__ __forceinline__ void xcd_barrier(const XcdBarrier& b) {
    asm volatile("s_waitcnt vmcnt(0)" ::: "memory");
    __syncthreads();
    if (threadIdx.x == 0) {
        unsigned* bar = b.bar;
        __builtin_amdgcn_s_waitcnt(0);
        const unsigned bx_ = xb_xcc_id();
        unsigned nloc = b.st[0], nx = b.st[1];
        if (nloc == 0u) { xcd_barrier_complete(bar, bx_, nloc, nx); b.st[0] = nloc; b.st[1] = nx; }
        const unsigned old = xb_add(&bar[XB_XSUB(bx_)], 1u);
        const unsigned gen = old / nloc;
        if (old + 1u == (gen + 1u) * nloc) {
            __builtin_amdgcn_fence(__ATOMIC_RELEASE, "agent");
            asm volatile("s_waitcnt vmcnt(0)" ::: "memory");
            const unsigned og = xb_add(&bar[XB_TOP], 1u);
            const unsigned tg = og / nx;
            if (og + 1u == (tg + 1u) * nx) xb_add(&bar[XB_TOPGEN], 1u);
            else XB_SPIN(xb_ld(&bar[XB_TOPGEN]) == tg, bar);
            __builtin_amdgcn_fence(__ATOMIC_ACQUIRE, "agent");
            xb_add(&bar[XB_XGEN(bx_)], 1u);
            asm volatile("s_waitcnt vmcnt(0)" ::: "memory");
        } else {
            XB_SPIN(xb_ld(&bar[XB_XGEN(bx_)]) == gen, bar);
            __builtin_amdgcn_fence(__ATOMIC_ACQUIRE, "agent");
            asm volatile("s_waitcnt vmcnt(0)" ::: "memory");
        }
    }
    __syncthreads();
}

struct Args { const float* in[18]; float* out; unsigned char* ws; int ph_lo, ph_hi; };
enum { I_X = 0, I_C, I_CTX, I_CCTX, I_ADAW, I_ADAB, I_NORMG, I_LIN, I_LCONVW, I_LCONVB, I_LGATEW, I_LGATEB, I_LLAM, I_LOUT, I_NIN, I_NQKN, I_NRPB, I_NOUT };

DI float wave_sum(float v) {
#pragma unroll
    for (int o = 1; o < 64; o <<= 1) v += __shfl_xor(v, o);
    return v;
}

DI void p0_transpose_item(const float* W, int K, int N, bf16* WT, int row_off, LAS float* scr, int item, int lane) {
    const int nblk = N / 32, kb = item / nblk, nb = item % nblk, k0 = 64 * kb, n0 = 32 * nb;
#pragma unroll 8
    for (int i = 0; i < 32; ++i) { const int kk = 2 * i + (lane >> 5); scr[kk * 33 + (lane & 31)] = W[(size_t)(k0 + kk) * N + n0 + (lane & 31)]; }
    LDS_WAIT(); asm volatile("" ::: "memory");
    const int c = lane & 7;
#pragma unroll
    for (int j = 0; j < 4; ++j) { const int n = (lane >> 3) + 8 * j; const LAS float* s = scr + (8 * c) * 33 + n;
        v4u o; o.x = pk2(s[0 * 33], s[1 * 33]); o.y = pk2(s[2 * 33], s[3 * 33]); o.z = pk2(s[4 * 33], s[5 * 33]); o.w = pk2(s[6 * 33], s[7 * 33]);
        *(GAS v4u*)(WT + (size_t)(row_off + n0 + n) * K + k0 + 8 * c) = o; }
    LDS_WAIT(); asm volatile("" ::: "memory");
}

DI void p0_prologue(const Args& a, LAS unsigned char* lds, int tid, int wave, int lane, int vcu, int G) {
    asm volatile("" : "+v"(tid), "+v"(lane));
    unsigned char* ws = a.ws;
    {
        LAS f32x4* condL = (LAS f32x4*)lds;
        LAS float* red = (LAS float*)(lds + 65536);
        const float* c = a.in[I_C]; const float* cc = a.in[I_CCTX];
        for (int k = tid; k < D; k += NWAVES * 64) { f32x4 v; v[0] = pg8::silu_f(c[k]); v[1] = pg8::silu_f(c[D + k]); v[2] = pg8::silu_f(cc[k]); v[3] = 0.f; condL[k] = v; }
        __syncthreads();
        float* mod = (float*)(ws + WS_MOD);
        for (int item = vcu; item < 4 * 192; item += G) {
            const int i = item / 192, n0 = (item % 192) * 64;
            const float* wp = a.in[I_ADAW] + ((size_t)i * D + wave * 512) * (3 * D) + n0 + lane;
            float a0 = 0.f, a1 = 0.f, a2 = 0.f;
            for (int kk = 0; kk < 512; kk += 16) {
                float w[16];
#pragma unroll
                for (int j = 0; j < 16; ++j) w[j] = wp[(size_t)(kk + j) * (3 * D)];
#pragma unroll
                for (int j = 0; j < 16; ++j) { const f32x4 cv = condL[wave * 512 + kk + j]; a0 += cv[0] * w[j]; a1 += cv[1] * w[j]; a2 += cv[2] * w[j]; }
            }
            red[(wave * 3 + 0) * 64 + lane] = a0; red[(wave * 3 + 1) * 64 + lane] = a1; red[(wave * 3 + 2) * 64 + lane] = a2;
            __syncthreads();
            if (tid < 192) { const int r = tid >> 6, l = tid & 63; float s = 0.f;
#pragma unroll
                for (int w8 = 0; w8 < 8; ++w8) s += red[(w8 * 3 + r) * 64 + l];
                mod[((size_t)i * 3 + r) * (3 * D) + n0 + l] = s + a.in[I_ADAB][(size_t)i * (3 * D) + n0 + l]; }
            __syncthreads();
        }
    }
    {
        const float* gw = a.in[I_LGATEW]; v4u* dst = (v4u*)(ws + WS_WGATE);
        for (int f = vcu * (NWAVES * 64) + tid; f < 2 * 16 * 2 * 8 * 2 * 16 * 64; f += G * NWAVES * 64) {
            const int ln = f & 63, ks = (f >> 6) & 15, gate = (f >> 10) & 1, jt = (f >> 11) & 7, dir = (f >> 14) & 1, nb = (f >> 15) & 15, lj = f >> 19;
            const int k0 = ks * 16 + 8 * (ln >> 5), j = jt * 32 + (ln & 31);
            const float* s = gw + ((((size_t)(lj * 2 + dir) * 2 + gate) * 16 + nb) * 256 + k0) * 256 + j;
            v4u o; o.x = pk2(s[0], s[256]); o.y = pk2(s[512], s[768]); o.z = pk2(s[1024], s[1280]); o.w = pk2(s[1536], s[1792]);
            dst[f] = o;
        }
    }
    {
        LAS float* scr = (LAS float*)(lds + wave * 16384);
        const int gw = vcu * NWAVES + wave, NGW = G * NWAVES;
        constexpr int I_A = 64 * (8192 / 32), I_B = 64 * (4096 / 32), I_CN = 64 * (16384 / 32);
        constexpr int NITEMS = 2 * (I_A + I_B + I_CN + I_B);
        for (int it = gw; it < NITEMS; it += NGW) {
            int r = it; const int lj = r / (I_A + I_B + I_CN + I_B); r -= lj * (I_A + I_B + I_CN + I_B);
            if (r < I_A) { p0_transpose_item(a.in[I_LIN] + (size_t)lj * D * 8192, D, 8192, (bf16*)(ws + WS_WLIN) + (size_t)lj * 8192 * D, 0, scr, r, lane); continue; } r -= I_A;
            if (r < I_B) { p0_transpose_item(a.in[I_LOUT] + (size_t)lj * D * D, D, D, (bf16*)(ws + WS_WLOUT) + (size_t)lj * D * D, 0, scr, r, lane); continue; } r -= I_B;
            if (r < I_CN) { p0_transpose_item(a.in[I_NIN] + (size_t)lj * D * 16384, D, 16384, (bf16*)(ws + WS_WNIN) + (size_t)lj * 16384 * D, 0, scr, r, lane); continue; } r -= I_CN;
            p0_transpose_item(a.in[I_NOUT] + (size_t)lj * D * D, D, D, (bf16*)(ws + WS_WNOUT) + (size_t)lj * D * D, 0, scr, r, lane);
        }
    }
}

DI void norm_phase(const Args& a, int layer, int wave, int lane, int vcu, int G) {
    asm volatile("" : "+v"(lane));
    unsigned char* ws = a.ws;
    const float* mod = (const float*)(ws + WS_MOD) + (size_t)layer * 3 * (3 * D);
    const float* ng = a.in[I_NORMG] + (size_t)layer * D;
    bf16* H = (bf16*)(ws + WS_H);
    const float* xres = (const float*)(ws + WS_XRES);
    const int gw = vcu * NWAVES + wave, NGW = G * NWAVES;
    for (int m = gw; m < MT; m += NGW) {
        const float* src = layer == 0 ? (m < ML ? a.in[I_X] + (size_t)m * D : a.in[I_CTX] + (size_t)(m - ML) * D) : xres + (size_t)m * D;
        const int r = m < ML ? (m >> 12) : 2;
        const float* shift = mod + (size_t)r * (3 * D); const float* scale = shift + D;
        const GAS f32x4* xr = (const GAS f32x4*)src + lane;
        f32x4 v[16]; float s = 0.f;
#pragma unroll
        for (int j = 0; j < 16; ++j) { v[j] = xr[64 * j]; s += (v[j][0] * v[j][0] + v[j][1] * v[j][1]) + (v[j][2] * v[j][2] + v[j][3] * v[j][3]); }
        const float rinv = __builtin_amdgcn_rsqf(wave_sum(s) * (1.0f / D) + EPS);
        GAS v2u* o8 = (GAS v2u*)(H + (size_t)m * D) + lane;
#pragma unroll
        for (int j = 0; j < 16; ++j) {
            const f32x4 g4 = *((const GAS f32x4*)ng + lane + 64 * j), sc = *((const GAS f32x4*)scale + lane + 64 * j), sh = *((const GAS f32x4*)shift + lane + 64 * j);
            const f32x4 y = v[j] * rinv * g4 * (sc + 1.0f) + sh;
            v2u w; w.x = pk2(y[0], y[1]); w.y = pk2(y[2], y[3]); o8[64 * j] = w; }
    }
}

DI int rg_rmap(int t) { return ((t >> 4) & 3) * 32 + ((t >> 2) & 3) * 8 + (t >> 6) * 4 + (t & 3); }
template <int PASS>
DI void rg_unit(LAS unsigned char* lds, int unit, int lj, const bf16* U, const bf16* Gb, bf16* HS, const float* conv_w, const float* conv_b, const v4u* wgt, const float* gate_b, const float* lam,
                float* agg, int tid, int wave, int lane) {
    asm volatile("" : "+v"(tid), "+v"(lane));
    const int gc = unit >> 4, nb = unit & 15, m0 = gc * 128;
    const bool has_left = gc < 64 ? ((gc & 31) != 0) : ((gc & 1) != 0);
    const bool has_right = gc < 64 ? ((gc & 31) != 31) : ((gc & 1) != 1);
    {
        const int cg = tid & 31, run = tid >> 5, ch0 = nb * 256 + cg * 8;
        float xin[11][8];
#pragma unroll
        for (int rr = 0; rr < 11; ++rr) { const int lr = run * 8 - 2 + rr; const bool valid = (lr >= 0 || has_left) && (lr < 128 || has_right);
            v4u raw = (v4u){0u, 0u, 0u, 0u}; if (valid) raw = *(const GAS v4u*)(U + (size_t)(m0 + lr) * D + ch0);
            xin[rr][0] = bflo(raw.x); xin[rr][1] = bfhi(raw.x); xin[rr][2] = bflo(raw.y); xin[rr][3] = bfhi(raw.y); xin[rr][4] = bflo(raw.z); xin[rr][5] = bfhi(raw.z); xin[rr][6] = bflo(raw.w); xin[rr][7] = bfhi(raw.w); }
        float cw[4][8], cb[8];
#pragma unroll
        for (int k = 0; k < 4; ++k) { const f32x4 w0 = *(const GAS f32x4*)(conv_w + ((size_t)lj * 4 + k) * D + ch0), w1 = *(const GAS f32x4*)(conv_w + ((size_t)lj * 4 + k) * D + ch0 + 4);
#pragma unroll
            for (int e = 0; e < 4; ++e) { cw[k][e] = w0[e]; cw[k][4 + e] = w1[e]; } }
        { const f32x4 b0 = *(const GAS f32x4*)(conv_b + (size_t)lj * D + ch0), b1 = *(const GAS f32x4*)(conv_b + (size_t)lj * D + ch0 + 4);
#pragma unroll
          for (int e = 0; e < 4; ++e) { cb[e] = b0[e]; cb[4 + e] = b1[e]; } }
#pragma unroll
        for (int tt = 0; tt < 8; ++tt) { float o[8];
#pragma unroll
            for (int e = 0; e < 8; ++e) { float s = cb[e];
#pragma unroll
                for (int k = 0; k < 4; ++k) s += cw[k][e] * xin[tt + k][e];
                o[e] = s; }
            v4u w; w.x = pk2(o[0], o[1]); w.y = pk2(o[2], o[3]); w.z = pk2(o[4], o[5]); w.w = pk2(o[6], o[7]);
            const int R = rg_rmap(run * 8 + tt);
            *(LAS v4u*)(lds + R * 512 + ((cg ^ (R & 15)) << 4)) = w; }
    }
    LDS_WAIT(); __syncthreads();
    const int c = lane & 31, hh = lane >> 5, chl = wave * 32 + c, ch = nb * 256 + chl;
    float cf = 0.f, cbk = 0.f;
    if (PASS == 2) {
        const float* aggd = agg + (size_t)hh * (2 * D) + ch;
        float h = 0.f;
        int n, q0, stp;
        if (gc < 64) { const int bb = gc >> 5, ci = gc & 31;
            const int qa = hh == 0 ? 64 + 2 * bb : 64 + 2 * bb + 1, qb = hh == 0 ? 64 + 2 * bb + 1 : 64 + 2 * bb;
            const float A0 = aggd[(size_t)qa * (4 * D)], H0 = aggd[(size_t)qa * (4 * D) + D], A1 = aggd[(size_t)qb * (4 * D)], H1 = aggd[(size_t)qb * (4 * D) + D];
            h = A1 * H0 + H1;
            (void)A0;
            n = hh == 0 ? ci : 31 - ci; q0 = hh == 0 ? bb * 32 : bb * 32 + 31; stp = hh == 0 ? 1 : -1;
        } else { const int k = gc & 1; const bool has = hh == 0 ? (k == 1) : (k == 0); const int q = hh == 0 ? gc - 1 : gc + 1;
            const float H0 = aggd[(size_t)(has ? q : gc) * (4 * D) + D];
            h = has ? H0 : 0.f; n = 0; q0 = gc; stp = 0; }
        const int nmax = max(__shfl_xor(n, 32), n);
        for (int s0 = 0; s0 < nmax; s0 += 8) {
            float Av[8], Hv[8];
#pragma unroll
            for (int j = 0; j < 8; ++j) { const int se = min(s0 + j, n > 0 ? n - 1 : 0); const float* ap = aggd + (size_t)(q0 + stp * se) * (4 * D); Av[j] = ap[0]; Hv[j] = ap[D]; }
#pragma unroll
            for (int j = 0; j < 8; ++j) { const bool on = s0 + j < n; h = (on ? Av[j] : 1.f) * h + (on ? Hv[j] : 0.f); }
        }
        const float ho = __shfl_xor(h, 32);
        cf = hh == 0 ? h : ho; cbk = hh == 1 ? h : ho;
    }
#pragma unroll 1
    for (int d = 0; d < 2; ++d) {
        f32x16 zr[4], zi[4];
#pragma unroll
        for (int mt = 0; mt < 4; ++mt)
#pragma unroll
            for (int i = 0; i < 16; ++i) { zr[mt][i] = 0.f; zi[mt][i] = 0.f; }
        unsigned lo_ = (unsigned)lane; asm volatile("" : "+v"(lo_));
        const unsigned c_ = lo_ & 31u, hh_ = lo_ >> 5, chl_ = (unsigned)wave * 32u + c_;
        const GAS bf16x8* wp = (const GAS bf16x8*)wgt + ((((size_t)(lj * 16 + nb) * 2 + d) * 8 + wave) * 2) * (16 * 64) + lo_;
        const unsigned abase = c_ * 512u + ((hh_ ^ (c_ & 15u)) << 4);
#pragma unroll 2
        for (int ks = 0; ks < 16; ++ks) {
            const bf16x8 br = wp[ks * 64], bi = wp[(16 + ks) * 64];
            const LAS unsigned char* ap = lds + (abase ^ ((unsigned)ks << 5));
#pragma unroll
            for (int mt = 0; mt < 4; ++mt) {
                const bf16x8 av = *(const LAS bf16x8*)(ap + mt * 16384);
                zr[mt] = __builtin_amdgcn_mfma_f32_32x32x16_bf16(av, br, zr[mt], 0, 0, 0);
                zi[mt] = __builtin_amdgcn_mfma_f32_32x32x16_bf16(av, bi, zi[mt], 0, 0, 0); }
        }
        const unsigned ubase = hh_ * 2048u + ((((chl_ >> 3) ^ (hh_ << 2))) << 4) + (chl_ & 7u) * 2u;
        const float gbr = gate_b[((size_t)(lj * 2 + d) * 2 + 0) * D + ch], gbi = gate_b[((size_t)(lj * 2 + d) * 2 + 1) * D + ch];
        const float lamv = lam[(size_t)(lj * 2 + d) * D + ch];
        const float kk = -8.0f * log1pf(__expf(-lamv));
        float S2 = 0.f;
#pragma unroll
        for (int mt = 0; mt < 4; ++mt)
#pragma unroll
            for (int r = 0; r < 16; ++r) {
                const unsigned cr = (unsigned)(((r >> 2) & 1) * 8 + (r & 3));
                const float up = __uint_as_float((unsigned)(*(const LAS unsigned short*)(lds + (ubase ^ (cr << 4)) + mt * 16384 + (r >> 2) * 4096 + (r & 3) * 512)) << 16);
                const float rg = fast_rcp(1.0f + fast_exp2(-LOG2E * (zr[mt][r] + gbr)));
                const float ig = fast_rcp(1.0f + fast_exp2(-LOG2E * (zi[mt][r] + gbi)));
                const float la = kk * rg, la2 = la * LOG2E, av = fast_exp2(la2), x2 = 2.0f * la;
                const float poly = -x2 * (1.0f + x2 * (0.5f + x2 * (0.16666667f + x2 * (0.041666668f + x2 * 0.0083333338f))));
                const float em = x2 > -0.25f ? poly : 1.0f - av * av;
                S2 += la2; zr[mt][r] = av; zi[mt][r] = __builtin_amdgcn_sqrtf(em) * (ig * up);
            }
        float Hl = 0.f;
        if (d == 0) {
#pragma unroll
            for (int mt = 0; mt < 4; ++mt)
#pragma unroll
                for (int r = 0; r < 16; ++r) Hl = zr[mt][r] * Hl + zi[mt][r];
        } else {
#pragma unroll
            for (int mt = 3; mt >= 0; --mt)
#pragma unroll
                for (int r = 15; r >= 0; --r) Hl = zr[mt][r] * Hl + zi[mt][r];
        }
        const float So = __shfl_xor(S2, 32), Ho = __shfl_xor(Hl, 32);
        if (PASS == 1) {
            if (hh == 0) { const float At = fast_exp2(S2 + So); const float Ht = d == 0 ? fast_exp2(So) * Hl + Ho : fast_exp2(S2) * Ho + Hl;
                float* ap = agg + ((size_t)(gc * 2 + d) * 2) * D + ch; ap[0] = At; ap[D] = Ht; }
        } else {
            float h;
            LAS unsigned short* hst = (LAS unsigned short*)(lds + 65536) + chl_ + hh_ * (64 * 256);
            if (d == 0) { h = hh == 0 ? cf : fast_exp2(So) * cf + Ho;
#pragma unroll
                for (int mt = 0; mt < 4; ++mt) {
#pragma unroll
                    for (int r = 0; r < 16; ++r) { h = zr[mt][r] * h + zi[mt][r]; hst[(mt * 16 + r) * 256] = (unsigned short)(pk2(h, 0.f) & 0xffffu); }
                    asm volatile("" ::: "memory"); }
            } else { h = hh == 1 ? cbk : fast_exp2(So) * cbk + Ho;
#pragma unroll
                for (int mt = 3; mt >= 0; --mt) {
#pragma unroll
                    for (int r = 15; r >= 0; --r) { h = zr[mt][r] * h + zi[mt][r]; LAS unsigned short* p = hst + (mt * 16 + r) * 256;
                        const float hf = __uint_as_float((unsigned)(*p) << 16); *p = (unsigned short)(pk2(hf + h, 0.f) & 0xffffu); }
                    asm volatile("" ::: "memory"); }
            }
        }
    }
    if (PASS == 2) {
        LDS_WAIT(); __syncthreads();
        int tid2 = tid; asm volatile("" : "+v"(tid2));
        const int cg = tid2 & 31, run = tid2 >> 5, ch0 = nb * 256 + cg * 8;
#pragma unroll
        for (int tt = 0; tt < 8; ++tt) { const int t = run * 8 + tt;
            const v4u hv = *(const LAS v4u*)(lds + 65536 + t * 512 + cg * 16); const v4u gv = *(const GAS v4u*)(Gb + (size_t)(m0 + t) * D + ch0);
            v4u o; o.x = pk2(bflo(hv.x) * bflo(gv.x), bfhi(hv.x) * bfhi(gv.x)); o.y = pk2(bflo(hv.y) * bflo(gv.y), bfhi(hv.y) * bfhi(gv.y));
            o.z = pk2(bflo(hv.z) * bflo(gv.z), bfhi(hv.z) * bfhi(gv.z)); o.w = pk2(bflo(hv.w) * bflo(gv.w), bfhi(hv.w) * bfhi(gv.w));
            *(GAS v4u*)(HS + (size_t)(m0 + t) * D + ch0) = o; }
    }
    LDS_WAIT(); __syncthreads();
}

DI unsigned off_b(unsigned row, unsigned ch) { return 256u * row + 16u * (ch ^ (((row & 3u) << 2) | ((row >> 2) & 3u))); }
DI int clampi(int v, int lo, int hi) { return v < lo ? lo : (v > hi ? hi : v); }
DI void tr_read8(s16x4 (&o)[8], unsigned a0, unsigned a1, unsigned a2, unsigned a3, unsigned a4, unsigned a5, unsigned a6, unsigned a7) {
    asm volatile("ds_read_b64_tr_b16 %0, %8\n\tds_read_b64_tr_b16 %1, %9\n\tds_read_b64_tr_b16 %2, %10\n\tds_read_b64_tr_b16 %3, %11\n\t"
                 "ds_read_b64_tr_b16 %4, %12\n\tds_read_b64_tr_b16 %5, %13\n\tds_read_b64_tr_b16 %6, %14\n\tds_read_b64_tr_b16 %7, %15\n\ts_waitcnt lgkmcnt(0)"
                 : "=&v"(o[0]), "=&v"(o[1]), "=&v"(o[2]), "=&v"(o[3]), "=&v"(o[4]), "=&v"(o[5]), "=&v"(o[6]), "=&v"(o[7])
                 : "v"(a0), "v"(a1), "v"(a2), "v"(a3), "v"(a4), "v"(a5), "v"(a6), "v"(a7) : "memory");
}
DI void attn_unit(LAS unsigned char* lds, int unit, const bf16* Qb, const bf16* Kb, const bf16* Vb, const bf16* Gb, bf16* Ob, const float* rpb, int tid, int wave, int lane) {
    asm volatile("" : "+v"(tid), "+v"(lane));
    const bool lat = unit < 2048;
    int b, hd, r0 = 0, half = 0;
    if (lat) { b = unit >> 10; hd = (unit >> 5) & 31; r0 = (unit & 31) * 2; } else { const int u2 = unit - 2048; b = u2 >> 6; hd = (u2 >> 1) & 31; half = u2 & 1; }
    const int rr = wave >> 2, n = wave & 3, ql = lane & 15, g = lane >> 4;
    const int rq = r0 + rr;
    const int qtok = lat ? b * SEQ + rq * 64 + n * 16 + ql : ML + b * CTXL + half * 128 + wave * 16 + ql;
    const int rs0 = clampi(r0 - 4, 0, 56), rsq = clampi(rq - 4, 0, 56);
    const int bs = n == 0 ? 0 : (n == 1 ? 8 : (n == 2 ? 24 : 32));
    const int qc = n * 16 + ql, qcs = clampi(qc - 8, 0, 48);
    LAS float* rpbL = (LAS float*)(lds + 65536);
    bf16x8 qf[4];
#pragma unroll
    for (int ks = 0; ks < 4; ++ks) qf[ks] = *(const GAS bf16x8*)(Qb + (size_t)qtok * D + hd * HDIM + ks * 32 + 8 * g);
    if (lat) for (int i = tid; i < 15 * 31; i += NWAVES * 64) { const int r1 = i / 31, c1 = i - r1 * 31; rpbL[r1 * 32 + c1] = rpb[((size_t)hd * 15 + r1) * 31 + c1] * LOG2E; }
    const int crow = tid >> 4, cch = tid & 15;
#define TILE_LOAD(idx, p0, p1) do { const int _i = (idx); const bf16* _src; \
        if (_i < 18) { const int _s = _i < 9 ? _i : _i - 9; const int _kr = (rs0 + _s) > 63 ? 63 : (rs0 + _s); _src = (_i < 9 ? Kb : Vb) + (size_t)(b * SEQ + _kr * 64) * D + hd * HDIM; } \
        else { const int _j = _i < 22 ? _i - 18 : _i - 22; _src = (_i < 22 ? Kb : Vb) + (size_t)(ML + b * CTXL + _j * 64) * D + hd * HDIM; } \
        p0 = *(const GAS v4u*)(_src + (size_t)crow * D + cch * 8); p1 = *(const GAS v4u*)(_src + (size_t)(crow + 32) * D + cch * 8); } while (0)
#define TILE_STORE(idx, p0, p1) do { LAS unsigned char* _b = lds + (((idx) & 1) << 14); *(LAS v4u*)(_b + off_b(crow, cch)) = p0; *(LAS v4u*)(_b + off_b(crow + 32, cch)) = p1; } while (0)
    v4u pf0, pf1;
    TILE_LOAD(lat ? 0 : 18, pf0, pf1);
    f32x4 O[8];
#pragma unroll
    for (int dt = 0; dt < 8; ++dt) O[dt] = (f32x4){0.f, 0.f, 0.f, 0.f};
    float m1 = -1e30f, l1 = 0.f;
    unsigned vb_lat[2], vb_ctx[2][2], kb_lat[2], kb_ctx[2][2];
#pragma unroll
    for (int t = 0; t < 2; ++t) { kb_lat[t] = off_b((unsigned)(bs + 8 * (ql >> 2) + 4 * t + (ql & 3)), (unsigned)g);
#pragma unroll
        for (int pp = 0; pp < 2; ++pp) kb_ctx[pp][t] = off_b((unsigned)(32 * pp + 8 * (ql >> 2) + 4 * t + (ql & 3)), (unsigned)g); }
    {
        const unsigned q4 = (unsigned)(ql >> 2), p = (unsigned)(lane & 3);
#pragma unroll
        for (int tt = 0; tt < 2; ++tt) {
            { const unsigned row = (unsigned)(bs + 8 * g + 4 * tt) + q4; vb_lat[tt] = off_b(row, p >> 1) + 8u * (p & 1u); }
#pragma unroll
            for (int pp = 0; pp < 2; ++pp) { const unsigned row = (unsigned)(32 * pp + 8 * g + 4 * tt) + q4; vb_ctx[pp][tt] = off_b(row, p >> 1) + 8u * (p & 1u); }
        }
    }
    const unsigned ldsb = (unsigned)(size_t)lds;
    if (lat) {
        f32x4 S[9][2];
#pragma unroll
        for (int s = 0; s < 9; ++s) {
            TILE_STORE(s, pf0, pf1); LDS_WAIT(); __syncthreads(); TILE_LOAD(s + 1, pf0, pf1);
            const LAS unsigned char* buf = lds + ((s & 1) << 14);
#pragma unroll
            for (int t = 0; t < 2; ++t) { f32x4 acc = (f32x4){0.f, 0.f, 0.f, 0.f};
#pragma unroll
                for (int ks = 0; ks < 4; ++ks) { const bf16x8 kf = *(const LAS bf16x8*)(buf + (kb_lat[t] ^ ((unsigned)ks << 6)));
                    acc = __builtin_amdgcn_mfma_f32_16x16x32_bf16(kf, qf[ks], acc, 0, 0, 0); }
                S[s][t] = acc; }
        }
        float mx = -1e30f;
#pragma unroll
        for (int s = 0; s < 9; ++s) { const int kr = rs0 + s; const bool rowok = kr >= rsq && kr < rsq + 8; const int bi0 = clampi(kr - rq + 7, 0, 14) * 32;
#pragma unroll
            for (int t = 0; t < 2; ++t)
#pragma unroll
                for (int r = 0; r < 4; ++r) { const int kc = bs + 8 * g + 4 * t + r; const bool ok = rowok && kc >= qcs && kc < qcs + 16;
                    const float bias = rpbL[bi0 + clampi(kc - qc + 15, 0, 30)];
                    const float v = ok ? S[s][t][r] * ATTN_C1 + bias : -1e30f; S[s][t][r] = v; mx = fmaxf(mx, v); } }
        mx = fmaxf(mx, __shfl_xor(mx, 16)); mx = fmaxf(mx, __shfl_xor(mx, 32));
        m1 = mx;
        v4u Pp[9];
#pragma unroll
        for (int s = 0; s < 9; ++s) { float p[2][4];
#pragma unroll
            for (int t = 0; t < 2; ++t)
#pragma unroll
                for (int r = 0; r < 4; ++r) { p[t][r] = fast_exp2(S[s][t][r] - mx); l1 += p[t][r]; }
            Pp[s].x = pk2(p[0][0], p[0][1]); Pp[s].y = pk2(p[0][2], p[0][3]); Pp[s].z = pk2(p[1][0], p[1][1]); Pp[s].w = pk2(p[1][2], p[1][3]); }
#pragma unroll
        for (int s = 0; s < 9; ++s) {
            const int idx = 9 + s;
            TILE_STORE(idx, pf0, pf1); LDS_WAIT(); __syncthreads(); TILE_LOAD(idx + 1, pf0, pf1);
            const unsigned vb = ldsb + ((unsigned)(idx & 1) << 14);
            const bf16x8 pfr = __builtin_bit_cast(bf16x8, Pp[s]);
#pragma unroll
            for (int dh = 0; dh < 2; ++dh) { s16x4 o[8];
                tr_read8(o, (vb + vb_lat[0]) ^ ((dh * 4 + 0) << 5), (vb + vb_lat[1]) ^ ((dh * 4 + 0) << 5), (vb + vb_lat[0]) ^ ((dh * 4 + 1) << 5), (vb + vb_lat[1]) ^ ((dh * 4 + 1) << 5),
                            (vb + vb_lat[0]) ^ ((dh * 4 + 2) << 5), (vb + vb_lat[1]) ^ ((dh * 4 + 2) << 5), (vb + vb_lat[0]) ^ ((dh * 4 + 3) << 5), (vb + vb_lat[1]) ^ ((dh * 4 + 3) << 5));
#pragma unroll
                for (int j = 0; j < 4; ++j) { const bf16x8 vf = __builtin_shufflevector(o[2 * j], o[2 * j + 1], 0, 1, 2, 3, 4, 5, 6, 7);
                    O[dh * 4 + j] = __builtin_amdgcn_mfma_f32_16x16x32_bf16(vf, pfr, O[dh * 4 + j], 0, 0, 0); } }
        }
    }
    {
        f32x4 S[4][2][2];
#pragma unroll
        for (int j = 0; j < 4; ++j) {
            const int idx = 18 + j;
            TILE_STORE(idx, pf0, pf1); LDS_WAIT(); __syncthreads(); TILE_LOAD(idx + 1, pf0, pf1);
            const LAS unsigned char* buf = lds + ((idx & 1) << 14);
#pragma unroll
            for (int pp = 0; pp < 2; ++pp)
#pragma unroll
                for (int t = 0; t < 2; ++t) { f32x4 acc = (f32x4){0.f, 0.f, 0.f, 0.f};
#pragma unroll
                    for (int ks = 0; ks < 4; ++ks) { const bf16x8 kf = *(const LAS bf16x8*)(buf + (kb_ctx[pp][t] ^ ((unsigned)ks << 6)));
                        acc = __builtin_amdgcn_mfma_f32_16x16x32_bf16(kf, qf[ks], acc, 0, 0, 0); }
                    S[j][pp][t] = acc; }
        }
        float mx = -1e30f;
#pragma unroll
        for (int j = 0; j < 4; ++j)
#pragma unroll
            for (int pp = 0; pp < 2; ++pp)
#pragma unroll
                for (int t = 0; t < 2; ++t)
#pragma unroll
                    for (int r = 0; r < 4; ++r) { const float v = S[j][pp][t][r] * ATTN_C1; S[j][pp][t][r] = v; mx = fmaxf(mx, v); }
        mx = fmaxf(mx, __shfl_xor(mx, 16)); mx = fmaxf(mx, __shfl_xor(mx, 32));
        const float mn = fmaxf(m1, mx), alpha = fast_exp2(m1 - mn);
#pragma unroll
        for (int dt = 0; dt < 8; ++dt) O[dt] = O[dt] * alpha;
        l1 *= alpha;
        v4u Pc[4][2];
#pragma unroll
        for (int j = 0; j < 4; ++j)
#pragma unroll
            for (int pp = 0; pp < 2; ++pp) { float p[2][4];
#pragma unroll
                for (int t = 0; t < 2; ++t)
#pragma unroll
                    for (int r = 0; r < 4; ++r) { p[t][r] = fast_exp2(S[j][pp][t][r] - mn); l1 += p[t][r]; }
                Pc[j][pp].x = pk2(p[0][0], p[0][1]); Pc[j][pp].y = pk2(p[0][2], p[0][3]); Pc[j][pp].z = pk2(p[1][0], p[1][1]); Pc[j][pp].w = pk2(p[1][2], p[1][3]); }
#pragma unroll
        for (int j = 0; j < 4; ++j) {
            const int idx = 22 + j;
            TILE_STORE(idx, pf0, pf1); LDS_WAIT(); __syncthreads(); if (j < 3) TILE_LOAD(idx + 1, pf0, pf1);
            const unsigned vb = ldsb + ((unsigned)(idx & 1) << 14);
#pragma unroll
            for (int pp = 0; pp < 2; ++pp) {
                const bf16x8 pfr = __builtin_bit_cast(bf16x8, Pc[j][pp]);
#pragma unroll
                for (int dh = 0; dh < 2; ++dh) { s16x4 o[8];
                    tr_read8(o, (vb + vb_ctx[pp][0]) ^ ((dh * 4 + 0) << 5), (vb + vb_ctx[pp][1]) ^ ((dh * 4 + 0) << 5), (vb + vb_ctx[pp][0]) ^ ((dh * 4 + 1) << 5), (vb + vb_ctx[pp][1]) ^ ((dh * 4 + 1) << 5),
                                (vb + vb_ctx[pp][0]) ^ ((dh * 4 + 2) << 5), (vb + vb_ctx[pp][1]) ^ ((dh * 4 + 2) << 5), (vb + vb_ctx[pp][0]) ^ ((dh * 4 + 3) << 5), (vb + vb_ctx[pp][1]) ^ ((dh * 4 + 3) << 5));
#pragma unroll
                    for (int jj = 0; jj < 4; ++jj) { const bf16x8 vf = __builtin_shufflevector(o[2 * jj], o[2 * jj + 1], 0, 1, 2, 3, 4, 5, 6, 7);
                        O[dh * 4 + jj] = __builtin_amdgcn_mfma_f32_16x16x32_bf16(vf, pfr, O[dh * 4 + jj], 0, 0, 0); } }
            }
        }
    }
#undef TILE_LOAD
#undef TILE_STORE
    l1 += __shfl_xor(l1, 16); l1 += __shfl_xor(l1, 32);
    const float inv = fast_rcp(l1);
#pragma unroll
    for (int dt = 0; dt < 8; ++dt) { const size_t off = (size_t)qtok * D + hd * HDIM + dt * 16 + 4 * g;
        const v2u gv = *(const GAS v2u*)(Gb + off);
        v2u w; w.x = pk2(O[dt][0] * inv * bflo(gv.x), O[dt][1] * inv * bfhi(gv.x)); w.y = pk2(O[dt][2] * inv * bflo(gv.y), O[dt][3] * inv * bfhi(gv.y));
        *(GAS v2u*)(Ob + off) = w; }
    __syncthreads();
}

__global__ void __launch_bounds__(NWAVES * 64, 2) mega_fwd(Args args) {
    extern __shared__ __attribute__((aligned(16))) unsigned char lds_raw[];
    LAS unsigned char* lds = (LAS unsigned char*)lds_raw;
    volatile LAS unsigned* MISC = (volatile LAS unsigned*)(lds + MISC_OFF);
    const int tid = threadIdx.x, lane = tid & 63, wave = __builtin_amdgcn_readfirstlane(tid >> 6);
    const int G = gridDim.x; const int bx = blockIdx.x; const int vcu = (G % 8 == 0) ? (bx % 8) * (G / 8) + bx / 8 : bx;
    unsigned char* ws = args.ws;
    if (tid < 32) MISC[tid] = 0u;
    __syncthreads();
    XcdBarrier bar; bar.bar = (unsigned*)(ws + WS_CTL) + CW_BAR; bar.x = 0; bar.st = nullptr;
    if (!MK_PER_PHASE) bar = xcd_barrier_post((unsigned*)(ws + WS_CTL) + CW_BAR, MISC + 8);
#if MK_PER_PHASE
    const int lo = args.ph_lo, hi = args.ph_hi;
#else
    constexpr int lo = 0, hi = NPHASE;
#endif
#ifndef SITE_MASK
#define SITE_MASK 0xffff
#endif
#define SITE(x) ((SITE_MASK >> (x)) & 1)
#define IN(k) (lo <= (k) && (k) < hi)
#define SEAM(k) do { if (IN(k) && IN((k) + 1)) xcd_barrier(bar); } while (0)
#define FRESH() int vcu_ = vcu, G_ = G; asm volatile("" : "+s"(vcu_), "+s"(G_))

    bf16* Hb = (bf16*)(ws + WS_H); bf16* Ab = (bf16*)(ws + WS_A); bf16* Bb = (bf16*)(ws + WS_B); bf16* Cb = (bf16*)(ws + WS_C); bf16* Db = (bf16*)(ws + WS_D);
    float* xres = (float*)(ws + WS_XRES); const float* mod = (const float*)(ws + WS_MOD);

    if (SITE(0) && IN(0)) { FRESH(); p0_prologue(args, lds, tid, wave, lane, vcu_, G_); }
    SEAM(0);

    for (int lp = 0; lp < 2; ++lp) {
        const int pb = 1 + lp * 9;
        { const int layer = 2 * lp;
          if (SITE(1) && IN(pb + 0)) { FRESH(); norm_phase(args, layer, wave, lane, vcu_, G_); }
          SEAM(pb + 0);
          if (SITE(2) && IN(pb + 1)) {
              pg8::Gemm g{Hb, (const bf16*)(ws + WS_WLIN) + (size_t)lp * 8192 * D, MT, 8192, D}; pg8::StaticOrder S; S.init(MT, 8192, G, bx);
              pg8::EpiRgIn E{Ab, Bb};
              pg8::gemm_phase<pg8::EpiRgIn, pg8::StaticOrder, true, true>(lds, g, S, E);
          }
          SEAM(pb + 1);
          if (SITE(3) && IN(pb + 2)) {
              FRESH();
              for (int u = vcu_; u < 68 * 16; u += G_)
                  rg_unit<1>(lds, u, lp, Ab, Bb, Hb, args.in[I_LCONVW], args.in[I_LCONVB], (const v4u*)(ws + WS_WGATE), args.in[I_LGATEB], args.in[I_LLAM], (float*)(ws + WS_AGG), tid, wave, lane);
          }
          SEAM(pb + 2);
          if (SITE(4) && IN(pb + 3)) {
              FRESH();
              for (int u = vcu_; u < 68 * 16; u += G_)
                  rg_unit<2>(lds, u, lp, Ab, Bb, Hb, args.in[I_LCONVW], args.in[I_LCONVB], (const v4u*)(ws + WS_WGATE), args.in[I_LGATEB], args.in[I_LLAM], (float*)(ws + WS_AGG), tid, wave, lane);
          }
          SEAM(pb + 3);
          if (SITE(5) && IN(pb + 4)) {
              pg8::Gemm g{Hb, (const bf16*)(ws + WS_WLOUT) + (size_t)lp * D * D, MT, D, D}; pg8::StaticOrder S; S.init(MT, D, G, bx);
              pg8::EpiOut E{layer == 0 ? args.in[I_X] : xres, layer == 0 ? args.in[I_CTX] : xres + (size_t)ML * D, xres, mod + (size_t)layer * 3 * (3 * D) + 2 * D};
              pg8::gemm_phase<pg8::EpiOut, pg8::StaticOrder, true, true>(lds, g, S, E);
          }
          SEAM(pb + 4);
        }
        { const int layer = 2 * lp + 1; const bool last = layer == DEPTH - 1;
          if (SITE(1) && IN(pb + 5)) { FRESH(); norm_phase(args, layer, wave, lane, vcu_, G_); }
          SEAM(pb + 5);
          if (SITE(6) && IN(pb + 6)) {
              pg8::Gemm g{Hb, (const bf16*)(ws + WS_WNIN) + (size_t)lp * 16384 * D, MT, 16384, D}; pg8::StaticOrder S; S.init(MT, 16384, G, bx);
              pg8::EpiNaIn E{Ab, Bb, Cb, Db, args.in[I_NQKN] + (size_t)lp * 2 * HDIM, (LAS float*)(lds + EPI_P_OFF)};
              pg8::gemm_phase<pg8::EpiNaIn, pg8::StaticOrder, true, true>(lds, g, S, E);
          }
          SEAM(pb + 6);
          if (SITE(7) && IN(pb + 7)) {
              FRESH();
              const int per = (2048 + G_ - 1) / G_, nctx = last ? 0 : (128 - vcu_ + G_ - 1) / G_;
              for (int i = 0; i < per + nctx; ++i) { const int u = i < per ? vcu_ * per + i : 2048 + vcu_ + (i - per) * G_;
                  if (u < 2048 + 128 && (i >= per || u < 2048))
                      attn_unit(lds, u, Ab, Bb, Cb, Db, Hb, args.in[I_NRPB] + (size_t)lp * NHEAD * 15 * 31, tid, wave, lane); }
          }
          SEAM(pb + 7);
          if (SITE(5) && IN(pb + 8)) {
              const int Mo = last ? ML : MT;
              pg8::Gemm g{Hb, (const bf16*)(ws + WS_WNOUT) + (size_t)lp * D * D, Mo, D, D}; pg8::StaticOrder S; S.init(Mo, D, G, bx);
              pg8::EpiOut E{xres, xres + (size_t)ML * D, last ? args.out : xres, mod + (size_t)layer * 3 * (3 * D) + 2 * D};
              pg8::gemm_phase<pg8::EpiOut, pg8::StaticOrder, true, true>(lds, g, S, E);
          }
          SEAM(pb + 8);
        }
    }
#undef IN
#undef SEAM
}

extern "C" void kernel_launch(void* const* d_in, const int* in_sizes, int n_in, void* d_out, int out_size, void* d_ws, size_t ws_size, hipStream_t stream) {
    static int grid = 0;
    if (grid == 0) {
        if (n_in != 18 || ws_size < WS_END) { fprintf(stderr, "kernel_launch: unexpected inputs (n_in %d, ws %zu)\n", n_in, ws_size); grid = -1; return; }
        int dev = 0, cus = 0, per_cu = 0;
        if (hipGetDevice(&dev) != hipSuccess || hipDeviceGetAttribute(&cus, hipDeviceAttributeMultiprocessorCount, dev) != hipSuccess) { grid = -1; return; }
        if (hipFuncSetAttribute((const void*)mega_fwd, hipFuncAttributeMaxDynamicSharedMemorySize, LDS_BYTES) != hipSuccess) { fprintf(stderr, "kernel_launch: hipFuncSetAttribute failed\n"); grid = -1; return; }
        if (hipOccupancyMaxActiveBlocksPerMultiprocessor(&per_cu, (const void*)mega_fwd, NWAVES * 64, LDS_BYTES) != hipSuccess || per_cu < 1)
            fprintf(stderr, "kernel_launch: occupancy query reports %d workgroups per CU\n", per_cu);
        (void)hipGetLastError();
        grid = cus;
    }
    if (grid < 0) return;
    if (hipMemsetAsync((char*)d_ws + WS_CTL, 0, CTL_ZERO_BYTES, stream) != hipSuccess) return;
    Args a{};
    for (int i = 0; i < 18; ++i) a.in[i] = (const float*)d_in[i];
    a.out = (float*)d_out; a.ws = (unsigned char*)d_ws;
#if MK_PER_PHASE
    for (int p = 0; p < NPHASE; ++p) { a.ph_lo = p; a.ph_hi = p + 1; hipLaunchKernelGGL(mega_fwd, dim3(grid), dim3(NWAVES * 64), LDS_BYTES, stream, a); }
#else
    a.ph_lo = 0; a.ph_hi = NPHASE;
    hipLaunchKernelGGL(mega_fwd, dim3(grid), dim3(NWAVES * 64), LDS_BYTES, stream, a);
#endif
    (void)in_sizes; (void)out_size;
}
```

```cpp
#include <hip/hip_runtime.h>
#include <cstdio>
#include <cstdint>
namespace pg8 {
#define PG8_LAS __attribute__((address_space(3)))
typedef unsigned short bf16_t;
typedef short bf16x8 __attribute__((ext_vector_type(8)));
typedef float f32x4 __attribute__((ext_vector_type(4)));
typedef unsigned u32x4 __attribute__((ext_vector_type(4)));
constexpr int BM = 256, BK = 64, HALF = 128, HTB = HALF * BK * 2  , STAGE_BYTES = 8 * HTB, NXCD = 8, WGM = 8;

__host__ __device__ __forceinline__ int lds_byte(int r, int c) { const int st = (r >> 4) * 2 + (c >> 5), rr = r & 15, cc = c & 31, ob = rr * 64 + cc * 2; return st * 1024 + (ob ^ (((ob >> 9) & 1) << 5)); }
__host__ __device__ __forceinline__ void stage_rc(int b, int& R, int& C) { const int st = b / 1024, sb = b % 1024, swz = sb ^ (((sb >> 9) & 1) << 5); R = (st >> 1) * 16 + swz / 64; C = (st & 1) * 32 + (swz % 64) / 2; }
__host__ __device__ __forceinline__ int perm32(int rho) { const int n = rho >> 4, i = rho & 15; return 8 * (i >> 2) + 4 * n + (i & 3); }

struct Unit { int pm, pn; };
struct Gemm { const bf16_t* A; const bf16_t* Bt; int M, N, K; };

struct StaticOrder {
    int nM, nN, nwg, G, c;
    __host__ __device__ void init(int M, int N, int G_, int c_) { nM = M / BM; nN = N / BM; nwg = nM * nN; G = G_; c = c_; }
    __host__ __device__ bool next(int i, Unit& u) const {
        const long L = (long)i * G + c; if (L >= nwg) return false;
        int wgid = (int)L; { const int q = nwg / NXCD, r = nwg % NXCD, xcd = wgid % NXCD, off = wgid / NXCD; wgid = (xcd < r ? xcd * (q + 1) : r * (q + 1) + (xcd - r) * q) + off; }
        const int nig = WGM * nN, gid = wgid / nig, fm = gid * WGM, gsz = (nM - fm) < WGM ? (nM - fm) : WGM;
        u.pm = fm + ((wgid % nig) % gsz); u.pn = (wgid % nig) / gsz; return true;
    }
    __device__ __forceinline__ void a_ready(const Unit&) const {}
    __device__ __forceinline__ void done(const Unit&) const {}
};

__device__ __forceinline__ unsigned cvt_pk_bf16(float lo, float hi) { unsigned r; asm volatile("v_cvt_pk_bf16_f32 %0, %1, %2" : "=v"(r) : "v"(lo), "v"(hi)); return r; }
__device__ __forceinline__ float silu_f(float v) { return v * __builtin_amdgcn_rcpf(1.0f + __builtin_amdgcn_exp2f(-1.4426950408889634f * v)); }
__device__ __forceinline__ f32x4 silu4(f32x4 v) { f32x4 o; o[0] = silu_f(v[0]); o[1] = silu_f(v[1]); o[2] = silu_f(v[2]); o[3] = silu_f(v[3]); return o; }
constexpr int DM = 4096;

struct EpiRgIn {
    static constexpr bool PERM = true, AFTER_DRAIN = false;
    bf16_t* U; bf16_t* G;
    __device__ __forceinline__ void operator()(const f32x4 (&acc)[2][2][4][2], const Unit& u, int wr, int wc, int fr, int fq) const {
        const int row0 = u.pm * BM + wr * 64 + fr; const bool isg = u.pn >= 16; bf16_t* base = isg ? G : U; const int col0 = (u.pn & 15) * BM + wc * 32 + 8 * fq;
#pragma unroll
        for (int ai = 0; ai < 2; ++ai)
#pragma unroll
            for (int m = 0; m < 4; ++m) { bf16_t* rowp = base + (size_t)(row0 + ai * HALF + m * 16) * DM + col0;
#pragma unroll
                for (int bj = 0; bj < 2; ++bj) { f32x4 v0 = acc[ai][bj][m][0], v1 = acc[ai][bj][m][1];
                    if (isg) { v0 = silu4(v0); v1 = silu4(v1); }
                    u32x4 w; w.x = cvt_pk_bf16(v0[0], v0[1]); w.y = cvt_pk_bf16(v0[2], v0[3]); w.z = cvt_pk_bf16(v1[0], v1[1]); w.w = cvt_pk_bf16(v1[2], v1[3]);
                    *(u32x4*)(rowp + bj * HALF) = w; } }
    }
};
struct EpiNaIn {
    static constexpr bool PERM = true, AFTER_DRAIN = false;
    bf16_t *Q, *K, *V, *G; const float* qkn; PG8_LAS float* P;
    __device__ __forceinline__ void operator()(const f32x4 (&acc)[2][2][4][2], const Unit& u, int wr, int wc, int fr, int fq) const {
        const int t = u.pn >> 4; bf16_t* base = t == 0 ? Q : (t == 1 ? K : (t == 2 ? V : G));
        const int row0 = u.pm * BM + wr * 64 + fr, col0 = (u.pn & 15) * BM + wc * 32 + 8 * fq;
        if (t < 2) {
#pragma unroll
            for (int ai = 0; ai < 2; ++ai)
#pragma unroll
                for (int m = 0; m < 4; ++m)
#pragma unroll
                    for (int bj = 0; bj < 2; ++bj) { const f32x4 a = acc[ai][bj][m][0], b = acc[ai][bj][m][1];
                        float s = (a[0] * a[0] + a[1] * a[1]) + (a[2] * a[2] + a[3] * a[3]) + (b[0] * b[0] + b[1] * b[1]) + (b[2] * b[2] + b[3] * b[3]);
                        s += __shfl_xor(s, 16); s += __shfl_xor(s, 32);
                        if (fq == 0) P[((ai * HALF + wr * 64 + m * 16 + fr) * 2 + bj) * 4 + wc] = s; }
            asm volatile("s_waitcnt lgkmcnt(0)" ::: "memory"); __builtin_amdgcn_s_barrier(); asm volatile("" ::: "memory");
            const float* wg = qkn + t * 128 + wc * 32 + 8 * fq; const f32x4 w0 = *(const f32x4*)wg, w1 = *(const f32x4*)(wg + 4);
#pragma unroll
            for (int ai = 0; ai < 2; ++ai)
#pragma unroll
                for (int m = 0; m < 4; ++m) { bf16_t* rowp = base + (size_t)(row0 + ai * HALF + m * 16) * DM + col0;
#pragma unroll
                    for (int bj = 0; bj < 2; ++bj) { const f32x4 p = *(const PG8_LAS f32x4*)(P + ((ai * HALF + wr * 64 + m * 16 + fr) * 2 + bj) * 4);
                        const float rinv = __builtin_amdgcn_rsqf(((p[0] + p[1]) + (p[2] + p[3])) * (1.0f / 128.0f) + 1e-6f);
                        const f32x4 v0 = acc[ai][bj][m][0] * rinv * w0, v1 = acc[ai][bj][m][1] * rinv * w1;
                        u32x4 w; w.x = cvt_pk_bf16(v0[0], v0[1]); w.y = cvt_pk_bf16(v0[2], v0[3]); w.z = cvt_pk_bf16(v1[0], v1[1]); w.w = cvt_pk_bf16(v1[2], v1[3]);
                        *(u32x4*)(rowp + bj * HALF) = w; } }
        } else {
#pragma unroll
            for (int ai = 0; ai < 2; ++ai)
#pragma unroll
                for (int m = 0; m < 4; ++m) { bf16_t* rowp = base + (size_t)(row0 + ai * HALF + m * 16) * DM + col0;
#pragma unroll
                    for (int bj = 0; bj < 2; ++bj) { f32x4 v0 = acc[ai][bj][m][0], v1 = acc[ai][bj][m][1];
                        if (t == 3) { v0 = silu4(v0); v1 = silu4(v1); }
                        u32x4 w; w.x = cvt_pk_bf16(v0[0], v0[1]); w.y = cvt_pk_bf16(v0[2], v0[3]); w.z = cvt_pk_bf16(v1[0], v1[1]); w.w = cvt_pk_bf16(v1[2], v1[3]);
                        *(u32x4*)(rowp + bj * HALF) = w; } }
        }
    }
};
struct EpiOut {
    static constexpr bool PERM = false, AFTER_DRAIN = false;
    const float* src_lat; const float* src_ctx; float* dst; const float* gate;
    __device__ __forceinline__ void operator()(const f32x4 (&acc)[2][2][4][2], const Unit& u, int wr, int wc, int fr, int fq) const {
        const int row0 = u.pm * BM + wr * 64 + fr, col0 = u.pn * BM + wc * 32 + 4 * fq; const int r = u.pm < 32 ? (u.pm >> 4) : 2;
        const float* gp = gate + (size_t)r * (3 * DM) + col0;
        f32x4 gv[2][2];
#pragma unroll
        for (int bj = 0; bj < 2; ++bj)
#pragma unroll
            for (int n = 0; n < 2; ++n) gv[bj][n] = *(const f32x4*)(gp + bj * HALF + n * 16);
#pragma unroll
        for (int ai = 0; ai < 2; ++ai)
#pragma unroll
            for (int m = 0; m < 4; ++m) { const int row = row0 + ai * HALF + m * 16;
                const float* sp = (row < 8192 ? src_lat + (size_t)row * DM : src_ctx + (size_t)(row - 8192) * DM) + col0; float* dp = dst + (size_t)row * DM + col0;
#pragma unroll
                for (int bj = 0; bj < 2; ++bj)
#pragma unroll
                    for (int n = 0; n < 2; ++n) *(f32x4*)(dp + bj * HALF + n * 16) = *(const f32x4*)(sp + bj * HALF + n * 16) + gv[bj][n] * acc[ai][bj][m][n]; }
    }
};

template <class Epi, class Sched, bool ALIGN_EPI = false, bool SP2 = false>
__device__ __forceinline__ void gemm_phase(PG8_LAS unsigned char* lds, const Gemm g, const Sched& S, const Epi& E) {
    int tid_o = threadIdx.x; asm volatile("" : "+v"(tid_o));
    const int tid = tid_o, wid = __builtin_amdgcn_readfirstlane(tid >> 6), lane = tid & 63, wr = wid >> 2, wc = wid & 3, fr = lane & 15, fq = lane >> 4;
    const int K = g.K, nt = K / BK;
    unsigned voffA[2], voffB[2];
#pragma unroll
    for (int i = 0; i < 2; ++i) { int R, C; stage_rc(tid * 16 + i * 8192, R, C); const int Rb = Epi::PERM ? ((R & ~31) + perm32(R & 31)) : R;
        voffA[i] = (unsigned)(R * K + C) * 2u; voffB[i] = (unsigned)(Rb * K + C) * 2u; }
    const size_t kstep = (size_t)(BK * 2);
    const size_t hstep = (size_t)HALF * K * 2;
    const size_t tstep = 2 * hstep;
    const unsigned ldsw = (unsigned)wid * 1024u;
    const int aoff = lds_byte(wr * 64 + fr, fq * 8), boff = lds_byte(wc * 32 + fr, fq * 8);
#define PG8_SA(b, h) (((b) * 2 + (h)) * HTB)
#define PG8_SB(b, h) ((4 + (b) * 2 + (h)) * HTB)
#define PG8_STAGE(bufoff, gbase, voff) do { _Pragma("unroll") for (int _i = 0; _i < 2; ++_i) \
        __builtin_amdgcn_global_load_lds((const unsigned*)((const char*)(gbase) + (voff)[_i]), (PG8_LAS unsigned*)(lds + (bufoff) + ldsw + _i * 8192), 16, 0, 0); } while (0)
#define PG8_LDA(dst, b, h) do { _Pragma("unroll") for (int m = 0; m < 4; ++m) _Pragma("unroll") for (int k = 0; k < 2; ++k) dst[m][k] = *(const PG8_LAS bf16x8*)(lds + PG8_SA(b, h) + aoff + m * 2048 + k * 1024); } while (0)
#define PG8_LDB(dst, b, h) do { _Pragma("unroll") for (int n = 0; n < 2; ++n) _Pragma("unroll") for (int k = 0; k < 2; ++k) dst[n][k] = *(const PG8_LAS bf16x8*)(lds + PG8_SB(b, h) + boff + n * 2048 + k * 1024); } while (0)
#define PG8_MMA(ai, bj, At, Bt) do { __builtin_amdgcn_s_setprio(1); _Pragma("unroll") for (int m = 0; m < 4; ++m) _Pragma("unroll") for (int n = 0; n < 2; ++n) _Pragma("unroll") for (int k = 0; k < 2; ++k) \
        acc[ai][bj][m][n] = __builtin_amdgcn_mfma_f32_16x16x32_bf16(Bt[n][k], At[m][k], acc[ai][bj][m][n], 0, 0, 0); __builtin_amdgcn_s_setprio(0); } while (0)
#define PG8_WAIT_V(n) asm volatile("s_waitcnt vmcnt(" #n ")" ::: "memory")
#define PG8_WAIT_L(n) asm volatile("s_waitcnt lgkmcnt(" #n ")" ::: "memory")
#define PG8_BAR __builtin_amdgcn_s_barrier()
#define PG8_SCHED __builtin_amdgcn_sched_barrier(0)
    Unit cur, nxt; int ui = 0;
    if (!S.next(0, cur)) return;
    f32x4 acc[2][2][4][2];
#pragma unroll
    for (int a = 0; a < 2; ++a)
#pragma unroll
        for (int b = 0; b < 2; ++b)
#pragma unroll
            for (int m = 0; m < 4; ++m)
#pragma unroll
                for (int n = 0; n < 2; ++n) acc[a][b][m][n] = (f32x4){0.f, 0.f, 0.f, 0.f};
    bf16x8 At[4][2], B0[2][2], B1[2][2];
    const char* cA = (const char*)g.A + (size_t)cur.pm * tstep; const char* cB = (const char*)g.Bt + (size_t)cur.pn * tstep;
    S.a_ready(cur);
    if constexpr (SP2) {
        PG8_STAGE(PG8_SB(0, 0), cB, voffB); PG8_STAGE(PG8_SB(0, 1), cB + hstep, voffB); PG8_STAGE(PG8_SA(0, 0), cA, voffA); PG8_STAGE(PG8_SA(0, 1), cA + hstep, voffA);
        if (wr == 1) PG8_BAR;
        PG8_WAIT_V(2); PG8_BAR;
        PG8_STAGE(PG8_SB(1, 0), cB + kstep, voffB); PG8_STAGE(PG8_SA(1, 0), cA + kstep, voffA); PG8_STAGE(PG8_SB(1, 1), cB + hstep + kstep, voffB);
        PG8_WAIT_V(6); PG8_BAR;
    } else {
        PG8_STAGE(PG8_SB(0, 0), cB, voffB); PG8_STAGE(PG8_SA(0, 0), cA, voffA); PG8_STAGE(PG8_SB(0, 1), cB + hstep, voffB); PG8_STAGE(PG8_SA(0, 1), cA + hstep, voffA);
        if (wr == 1) PG8_BAR;
        PG8_WAIT_V(4); PG8_BAR;
        PG8_STAGE(PG8_SB(1, 0), cB + kstep, voffB); PG8_STAGE(PG8_SA(1, 0), cA + kstep, voffA); PG8_STAGE(PG8_SB(1, 1), cB + hstep + kstep, voffB);
        PG8_WAIT_V(6); PG8_BAR;
    }
    for (;;) {
        const bool has_next = S.next(ui + 1, nxt);
        const char* nA = has_next ? (const char*)g.A + (size_t)nxt.pm * tstep : cA; const char* nB = has_next ? (const char*)g.Bt + (size_t)nxt.pn * tstep : cB;
        for (int t = 0; t < nt; t += 2) {
            const bool last = (t == nt - 2);
            const char* a1 = cA + (size_t)(t + 1) * kstep;
            const char* a2 = last ? nA : cA + (size_t)(t + 2) * kstep; const char* b2 = last ? nB : cB + (size_t)(t + 2) * kstep;
            const char* a3 = a2 + kstep; const char* b3 = b2 + kstep;
            if (last && has_next) S.a_ready(nxt);
            if constexpr (SP2) {
            PG8_LDB(B0, 0, 0); PG8_LDB(B1, 0, 1); PG8_SCHED; PG8_LDA(At, 0, 0); PG8_STAGE(PG8_SA(1, 1), a1 + hstep, voffA);
            PG8_WAIT_V(8); PG8_WAIT_L(0); PG8_BAR; PG8_MMA(0, 0, At, B0); PG8_MMA(0, 1, At, B1); PG8_BAR; PG8_SCHED;
            PG8_LDA(At, 0, 1); PG8_STAGE(PG8_SB(0, 0), b2, voffB); PG8_STAGE(PG8_SB(0, 1), b2 + hstep, voffB); PG8_STAGE(PG8_SA(0, 0), a2, voffA);
            PG8_WAIT_V(8); PG8_WAIT_L(0); PG8_BAR; PG8_MMA(1, 0, At, B0); PG8_MMA(1, 1, At, B1); PG8_BAR; PG8_SCHED;
            PG8_LDB(B0, 1, 0); PG8_LDB(B1, 1, 1); PG8_SCHED; PG8_LDA(At, 1, 0); PG8_STAGE(PG8_SA(0, 1), a2 + hstep, voffA);
            PG8_WAIT_V(8); PG8_WAIT_L(0); PG8_BAR; PG8_MMA(0, 0, At, B0); PG8_MMA(0, 1, At, B1); PG8_BAR; PG8_SCHED;
            PG8_LDA(At, 1, 1); PG8_STAGE(PG8_SB(1, 0), b3, voffB); PG8_STAGE(PG8_SB(1, 1), b3 + hstep, voffB); PG8_STAGE(PG8_SA(1, 0), a3, voffA);
            PG8_WAIT_V(8); PG8_WAIT_L(0); PG8_BAR; PG8_MMA(1, 0, At, B0); PG8_MMA(1, 1, At, B1); PG8_BAR; PG8_SCHED;
            } else {
            PG8_LDB(B0, 0, 0); PG8_SCHED; PG8_LDA(At, 0, 0); PG8_STAGE(PG8_SA(1, 1), a1 + hstep, voffA);
            PG8_WAIT_L(8); PG8_BAR; PG8_WAIT_L(0); PG8_MMA(0, 0, At, B0); PG8_BAR; PG8_SCHED;
            PG8_LDB(B1, 0, 1); PG8_STAGE(PG8_SB(0, 0), b2, voffB);
            PG8_BAR; PG8_WAIT_L(0); PG8_MMA(0, 1, At, B1); PG8_BAR;
            PG8_LDA(At, 0, 1); PG8_STAGE(PG8_SA(0, 0), a2, voffA);
            PG8_BAR; PG8_WAIT_L(0); PG8_MMA(1, 0, At, B0); PG8_BAR; PG8_SCHED;
            PG8_STAGE(PG8_SB(0, 1), b2 + hstep, voffB);
            PG8_WAIT_V(6); PG8_BAR; PG8_MMA(1, 1, At, B1); PG8_BAR;
            PG8_LDB(B0, 1, 0); PG8_SCHED; PG8_LDA(At, 1, 0); PG8_STAGE(PG8_SA(0, 1), a2 + hstep, voffA);
            PG8_WAIT_L(8); PG8_BAR; PG8_WAIT_L(0); PG8_MMA(0, 0, At, B0); PG8_BAR; PG8_SCHED;
            PG8_LDB(B1, 1, 1); PG8_STAGE(PG8_SB(1, 0), b3, voffB);
            PG8_BAR; PG8_WAIT_L(0); PG8_MMA(0, 1, At, B1); PG8_BAR;
            PG8_LDA(At, 1, 1); PG8_STAGE(PG8_SA(1, 0), a3, voffA);
            PG8_BAR; PG8_WAIT_L(0); PG8_MMA(1, 0, At, B0); PG8_BAR; PG8_SCHED;
            PG8_STAGE(PG8_SB(1, 1), b3 + hstep, voffB);
            PG8_WAIT_V(6); PG8_BAR; PG8_MMA(1, 1, At, B1); PG8_BAR;
            }
        }
        if constexpr (ALIGN_EPI) { if (wr == 0) PG8_BAR; }
        if constexpr (!Epi::AFTER_DRAIN) { E(acc, cur, wr, wc, fr, fq); S.done(cur); }
        if (!has_next) break;
#pragma unroll
        for (int a = 0; a < 2; ++a)
#pragma unroll
            for (int b = 0; b < 2; ++b)
#pragma unroll
                for (int m = 0; m < 4; ++m)
#pragma unroll
                    for (int n = 0; n < 2; ++n) acc[a][b][m][n] = (f32x4){0.f, 0.f, 0.f, 0.f};
        cur = nxt; cA = nA; cB = nB; ++ui;
        if constexpr (ALIGN_EPI) { if (wr == 1) PG8_BAR; }
    }
    PG8_WAIT_V(0);
    if constexpr (!ALIGN_EPI) { if (wr == 0) PG8_BAR; }
    PG8_BAR;
    if constexpr (Epi::AFTER_DRAIN) { E.fused(acc, cur, wr, wc, fr, fq, lds, wid, lane); S.done(cur); }
#undef PG8_SA
#undef PG8_SB
#undef PG8_STAGE
#undef PG8_LDA
#undef PG8_LDB
#undef PG8_MMA
#undef PG8_WAIT_V
#undef PG8_WAIT_L
#undef PG8_BAR
#undef PG8_SCHED
}
}

constexpr int NWAVES = 8;
constexpr int D = 4096, NBATCH = 2, SEQ = 4096, CTXL = 256, DEPTH = 4, NHEAD = 32, HDIM = 128;
constexpr int ML = NBATCH * SEQ;
constexpr int MC = NBATCH * CTXL;
constexpr int MT = ML + MC;
constexpr float EPS = 1e-6f;
constexpr float LOG2E = 1.4426950408889634f;
constexpr float ATTN_C1 = 0.08838834764831845f * LOG2E;

#ifndef DUP_MASK
#define DUP_MASK 0
#endif
#define NREP(x) (1 + ((DUP_MASK >> (x)) & 1))
#ifndef MK_PER_PHASE
#define MK_PER_PHASE 0
#endif
constexpr int NPHASE = 19;

constexpr size_t MiB = 1u << 20;
constexpr size_t WS_CTL = 0, CTL_ZERO_BYTES = 1 * MiB;
constexpr size_t WS_MOD = 1 * MiB;
constexpr size_t WS_AGG = 2 * MiB;
constexpr size_t WS_WGATE = 8 * MiB;
constexpr size_t WS_WLIN = 24 * MiB;
constexpr size_t WS_WLOUT = 152 * MiB;
constexpr size_t WS_WNIN = 216 * MiB;
constexpr size_t WS_WNOUT = 472 * MiB;
constexpr size_t WS_XRES = 536 * MiB;
constexpr size_t WS_H = 672 * MiB;
constexpr size_t WS_A = 740 * MiB, WS_B = 808 * MiB, WS_C = 876 * MiB, WS_D = 944 * MiB;
constexpr size_t WS_END = 1012 * MiB;
constexpr int CW_BAR = 4096;

constexpr int RING_BYTES = 131072;
constexpr int EPI_P_OFF = RING_BYTES;
constexpr int MISC_OFF = RING_BYTES + 8192 + 320;
constexpr int LDS_BYTES = 147456;

#define GAS __attribute__((address_space(1)))
#define LAS __attribute__((address_space(3)))
#define DI __device__ __forceinline__
typedef unsigned short bf16;
typedef unsigned v4u __attribute__((ext_vector_type(4)));
typedef unsigned v2u __attribute__((ext_vector_type(2)));
typedef float f32x4 __attribute__((ext_vector_type(4)));
typedef float f32x16 __attribute__((ext_vector_type(16)));
typedef short bf16x8 __attribute__((ext_vector_type(8)));
typedef short s16x4 __attribute__((ext_vector_type(4)));
#define LDS_WAIT() asm volatile("s_waitcnt lgkmcnt(0)" ::: "memory")
#define VM_WAIT() asm volatile("s_waitcnt vmcnt(0)" ::: "memory")
DI unsigned pk2(float lo, float hi) { return pg8::cvt_pk_bf16(lo, hi); }
DI float bflo(unsigned w) { return __uint_as_float(w << 16); }
DI float bfhi(unsigned w) { return __uint_as_float(w & 0xffff0000u); }
DI float fast_exp2(float x) { return __builtin_amdgcn_exp2f(x); }
DI float fast_rcp(float x) { return __builtin_amdgcn_rcpf(x); }

#define XB_TMO      128
#define XB_XCNT(j)  (256  + 64 * (j))
#define XB_XSUB(j)  (1280 + 64 * (j))
#define XB_XGEN(j)  (2304 + 64 * (j))
#define XB_TOP      3328
#define XB_TOPGEN   3392
#define XCD_BAR_WORDS 3456
#define XB_SPIN_CAP (1u << 18)
__device__ __forceinline__ unsigned xb_ld(unsigned* p)              { return __hip_atomic_load(p, __ATOMIC_RELAXED, __HIP_MEMORY_SCOPE_AGENT); }
__device__ __forceinline__ unsigned xb_add(unsigned* p, unsigned v) { return __hip_atomic_fetch_add(p, v, __ATOMIC_RELAXED, __HIP_MEMORY_SCOPE_AGENT); }
__device__ __forceinline__ unsigned xb_xcc_id() { return (unsigned)__builtin_amdgcn_s_getreg((3 << 11) | 20) & 0xFu; }
#define XB_SPIN(cond, bar) do { unsigned _sp = 0; while (cond) { __builtin_amdgcn_s_sleep(1); \
    if ((++_sp & 255u) == 0u) { if (xb_ld(&(bar)[XB_TMO])) break; if (_sp > XB_SPIN_CAP) { atomicAdd(&(bar)[XB_TMO], 1u); break; } } } } while (0)
struct XcdBarrier { unsigned* bar; unsigned x; volatile LAS unsigned* st; };
__device__ __forceinline__ XcdBarrier xcd_barrier_post(unsigned* bar, volatile LAS unsigned* st) {
    XcdBarrier b; b.bar = bar; b.x = xb_xcc_id(); b.st = st;
    if (threadIdx.x == 0) (void)xb_add(&bar[XB_XCNT(b.x)], 1u);
    return b;
}
__device__ __forceinline__ void xcd_barrier_complete(unsigned* bar, unsigned x, unsigned& nloc, unsigned& nx) {
    const unsigned G = gridDim.x * gridDim.y * gridDim.z;
    unsigned sum, cnt, mine, sp = 0u;
    for (;;) {
        sum = 0u; cnt = 0u; mine = 0u;
#pragma unroll
        for (unsigned j = 0; j < 16; ++j) { const unsigned c = xb_ld(&bar[XB_XCNT(j)]); sum += c; cnt += (c > 0u) ? 1u : 0u; mine = (j == x) ? c : mine; }
        if (sum == G) break;
        __builtin_amdgcn_s_sleep(1);
        if ((++sp & 255u) == 0u) { if (xb_ld(&bar[XB_TMO])) break; if (sp > XB_SPIN_CAP) { atomicAdd(&bar[XB_TMO], 1u); break; } }
    }
    nloc = mine > 0u ? mine : 1u; nx = cnt > 0u ? cnt : 1u;
}
__device__ __forceinline__ void xcd_barrier(const XcdBarrier& b) {
    asm volatile("s_waitcnt vmcnt(0)" ::: "memory");
    __syncthreads();
    if (threadIdx.x == 0) {
        unsigned* bar = b.bar;
        __builtin_amdgcn_s_waitcnt(0);
        const unsigned bx_ = xb_xcc_id();
        unsigned nloc = b.st[0], nx = b.st[1];
        if (nloc == 0u) { xcd_barrier_complete(bar, bx_, nloc, nx); b.st[0] = nloc; b.st[1] = nx; }
        const unsigned old = xb_add(&bar[XB_XSUB(bx_)], 1u);
        const unsigned gen = old / nloc;
        if (old + 1u == (gen + 1u) * nloc) {
            __builtin_amdgcn_fence(__ATOMIC_RELEASE, "agent");
            asm volatile("s_waitcnt vmcnt(0)" ::: "memory");
            const unsigned og = xb_add(&bar[XB_TOP], 1u);
            const unsigned tg = og / nx;
            if (og + 1u == (tg + 1u) * nx) xb_add(&bar[XB_TOPGEN], 1u);
            else XB_SPIN(xb_ld(&bar[XB_TOPGEN]) == tg, bar);
            __builtin_amdgcn_fence(__ATOMIC_ACQUIRE, "agent");
            xb_add(&bar[XB_XGEN(bx_)], 1u);
            asm volatile("s_waitcnt vmcnt(0)" ::: "memory");
        } else {
            XB_SPIN(xb_ld(&bar[XB_XGEN(bx_)]) == gen, bar);
            __builtin_amdgcn_fence(__ATOMIC_ACQUIRE, "agent");
            asm volatile("s_waitcnt vmcnt(0)" ::: "memory");
        }
    }
    __syncthreads();
}

struct Args { const float* in[18]; float* out; unsigned char* ws; int ph_lo, ph_hi; };
enum { I_X = 0, I_C, I_CTX, I_CCTX, I_ADAW, I_ADAB, I_NORMG, I_LIN, I_LCONVW, I_LCONVB, I_LGATEW, I_LGATEB, I_LLAM, I_LOUT, I_NIN, I_NQKN, I_NRPB, I_NOUT };

DI float wave_sum(float v) {
#pragma unroll
    for (int o = 1; o < 64; o <<= 1) v += __shfl_xor(v, o);
    return v;
}

DI void tr_load(const float* W, int N, int item, int lane, f32x4 (&v)[16]) {
    const int nblk = N >> 6, kb = item / nblk, nb = item - kb * nblk;
    const GAS float* p = (const GAS float*)W + (size_t)(64 * kb + (lane >> 4)) * N + 64 * nb + 4 * (lane & 15);
#pragma unroll
    for (int i = 0; i < 16; ++i) v[i] = *(const GAS f32x4*)(p + (size_t)(4 * i) * N);
}
DI void tr_store(bf16* WT, int K, int N, int item, int lane, LAS float* scr, const f32x4 (&v)[16]) {
    const int nblk = N >> 6, kb = item / nblk, nb = item - kb * nblk;
    { LAS float* w = scr + (lane >> 4) * 65 + 4 * (lane & 15);
#pragma unroll
      for (int i = 0; i < 16; ++i) { w[(4 * i) * 65 + 0] = v[i][0]; w[(4 * i) * 65 + 1] = v[i][1]; w[(4 * i) * 65 + 2] = v[i][2]; w[(4 * i) * 65 + 3] = v[i][3]; } }
    LDS_WAIT(); asm volatile("" ::: "memory");
    const int c = lane & 7;
#pragma unroll
    for (int j = 0; j < 8; ++j) { const int n = (lane >> 3) + 8 * j; const LAS float* q = scr + (8 * c) * 65 + n;
        v4u o; o.x = pk2(q[0 * 65], q[1 * 65]); o.y = pk2(q[2 * 65], q[3 * 65]); o.z = pk2(q[4 * 65], q[5 * 65]); o.w = pk2(q[6 * 65], q[7 * 65]);
        *(GAS v4u*)(WT + (size_t)(64 * nb + n) * K + 64 * kb + 8 * c) = o; }
    LDS_WAIT(); asm volatile("" ::: "memory");
}

struct BgTasks { int ada_layer, gate_lj, tr0, tr1; };
DI void bg_run(const Args& a, LAS unsigned char* lds, int tid, int wave, int lane, int widx, int nw, const BgTasks t) {
    asm volatile("" : "+v"(tid), "+v"(lane));
    unsigned char* ws = a.ws;
    if (t.ada_layer >= 0) {
        const int i = t.ada_layer;
        LAS f32x4* condL = (LAS f32x4*)lds;
        LAS float* red = (LAS float*)(lds + 65536);
        const float* c = a.in[I_C]; const float* cc = a.in[I_CCTX];
        for (int k = tid; k < D; k += NWAVES * 64) { f32x4 v; v[0] = pg8::silu_f(c[k]); v[1] = pg8::silu_f(c[D + k]); v[2] = pg8::silu_f(cc[k]); v[3] = 0.f; condL[k] = v; }
        __syncthreads();
        float* mod = (float*)(ws + WS_MOD);
        for (int item = widx; item < 192; item += nw) {
            const int n0 = item * 64;
            const float* wp = a.in[I_ADAW] + ((size_t)i * D + wave * 512) * (3 * D) + n0 + lane;
            float a0 = 0.f, a1 = 0.f, a2 = 0.f;
            for (int kk = 0; kk < 512; kk += 32) {
                float w[32];
#pragma unroll
                for (int j = 0; j < 32; ++j) w[j] = wp[(size_t)(kk + j) * (3 * D)];
#pragma unroll
                for (int j = 0; j < 32; ++j) { const f32x4 cv = condL[wave * 512 + kk + j]; a0 += cv[0] * w[j]; a1 += cv[1] * w[j]; a2 += cv[2] * w[j]; }
            }
            red[(wave * 3 + 0) * 64 + lane] = a0; red[(wave * 3 + 1) * 64 + lane] = a1; red[(wave * 3 + 2) * 64 + lane] = a2;
            __syncthreads();
            if (tid < 192) { const int r = tid >> 6, l = tid & 63; float s = 0.f;
#pragma unroll
                for (int w8 = 0; w8 < 8; ++w8) s += red[(w8 * 3 + r) * 64 + l];
                mod[((size_t)i * 3 + r) * (3 * D) + n0 + l] = s + a.in[I_ADAB][(size_t)i * (3 * D) + n0 + l]; }
            __syncthreads();
        }
    }
    if (t.gate_lj >= 0) {
        const float* gw = a.in[I_LGATEW]; v4u* dst = (v4u*)(ws + WS_WGATE);
        for (int f0 = widx * (NWAVES * 64) + tid; f0 < 16 * 2 * 8 * 2 * 16 * 64; f0 += nw * NWAVES * 64) {
            const int f = f0 + (t.gate_lj << 19);
            const int ln = f & 63, ks = (f >> 6) & 15, gate = (f >> 10) & 1, jt = (f >> 11) & 7, dir = (f >> 14) & 1, nb = (f >> 15) & 15, lj = f >> 19;
            const int k0 = ks * 16 + 8 * (ln >> 5), j = jt * 32 + (ln & 31);
            const float* s = gw + ((((size_t)(lj * 2 + dir) * 2 + gate) * 16 + nb) * 256 + k0) * 256 + j;
            v4u o; o.x = pk2(s[0], s[256]); o.y = pk2(s[512], s[768]); o.z = pk2(s[1024], s[1280]); o.w = pk2(s[1536], s[1792]);
            dst[f] = o;
        }
    }
    {
        LAS float* scr = (LAS float*)(lds + wave * 16640);
        const int gw = widx * NWAVES + wave, NGW = nw * NWAVES;
#pragma unroll 1
        for (int q = 0; q < 2; ++q) { const int id = q == 0 ? t.tr0 : t.tr1; if (id < 0) continue;
            const int kind = id >> 1, lj = id & 1; const int N = kind == 0 ? 8192 : (kind == 2 ? 16384 : D);
            const float* W = a.in[kind == 0 ? I_LIN : (kind == 1 ? I_LOUT : (kind == 2 ? I_NIN : I_NOUT))] + (size_t)lj * D * N;
            bf16* WT = (bf16*)(ws + (kind == 0 ? WS_WLIN : (kind == 1 ? WS_WLOUT : (kind == 2 ? WS_WNIN : WS_WNOUT)))) + (size_t)lj * N * D;
            const int nitems = 64 * (N / 64);
            f32x4 va[16], vb[16];
            if (gw < nitems) tr_load(W, N, gw, lane, va);
            for (int it = gw; it < nitems; it += 2 * NGW) {
                if (it + NGW < nitems) tr_load(W, N, it + NGW, lane, vb);
                tr_store(WT, D, N, it, lane, scr, va);
                if (it + 2 * NGW < nitems) tr_load(W, N, it + 2 * NGW, lane, va);
                if (it + NGW < nitems) tr_store(WT, D, N, it + NGW, lane, scr, vb);
            }
        }
    }
    __syncthreads();
}
DI int gemm_wgs(int nunits, int G) { const int rounds = (nunits + G - 1) / G; return (nunits + rounds - 1) / rounds; }
#define BG_SPARE(Gg, ...) do { const BgTasks _t = __VA_ARGS__; if ((Gg) >= G) bg_run(args, lds, tid, wave, lane, bx, G, _t); else if (bx >= (Gg)) bg_run(args, lds, tid, wave, lane, bx - (Gg), G - (Gg), _t); } while (0)

DI void norm_phase(const Args& a, int layer, int wave, int lane, int vcu, int G) {
    asm volatile("" : "+v"(lane));
    unsigned char* ws = a.ws;
    const float* mod = (const float*)(ws + WS_MOD) + (size_t)layer * 3 * (3 * D);
    const float* ng = a.in[I_NORMG] + (size_t)layer * D;
    bf16* H = (bf16*)(ws + WS_H);
    const float* xres = (const float*)(ws + WS_XRES);
    const int gw = vcu * NWAVES + wave, NGW = G * NWAVES;
    for (int m2 = gw; m2 < MT * NREP(1); m2 += NGW) { const int m = m2 >= MT ? m2 - MT : m2;
        const float* src = layer == 0 ? (m < ML ? a.in[I_X] + (size_t)m * D : a.in[I_CTX] + (size_t)(m - ML) * D) : xres + (size_t)m * D;
        const int r = m < ML ? (m >> 12) : 2;
        const float* shift = mod + (size_t)r * (3 * D); const float* scale = shift + D;
        const GAS f32x4* xr = (const GAS f32x4*)src + lane;
        f32x4 v[16]; float s = 0.f;
#pragma unroll
        for (int j = 0; j < 16; ++j) { v[j] = xr[64 * j]; s += (v[j][0] * v[j][0] + v[j][1] * v[j][1]) + (v[j][2] * v[j][2] + v[j][3] * v[j][3]); }
        const float rinv = __builtin_amdgcn_rsqf(wave_sum(s) * (1.0f / D) + EPS);
        GAS v2u* o8 = (GAS v2u*)(H + (size_t)m * D) + lane;
#pragma unroll
        for (int j = 0; j < 16; ++j) {
            const f32x4 g4 = *((const GAS f32x4*)ng + lane + 64 * j), sc = *((const GAS f32x4*)scale + lane + 64 * j), sh = *((const GAS f32x4*)shift + lane + 64 * j);
            const f32x4 y = v[j] * rinv * g4 * (sc + 1.0f) + sh;
            v2u w; w.x = pk2(y[0], y[1]); w.y = pk2(y[2], y[3]); o8[64 * j] = w; }
    }
}

DI int rg_rmap(int t) { return ((t >> 4) & 3) * 32 + ((t >> 2) & 3) * 8 + (t >> 6) * 4 + (t & 3); }
template <int PASS>
DI void rg_unit(LAS unsigned char* lds, int unit, int lj, const bf16* U, const bf16* Gb, bf16* HS, const float* conv_w, const float* conv_b, const v4u* wgt, const float* gate_b, const float* lam,
                float* agg, int tid, int wave, int lane) {
    asm volatile("" : "+v"(tid), "+v"(lane));
    const int gc = unit >> 4, nb = unit & 15, m0 = gc * 128;
    const bool has_left = gc < 64 ? ((gc & 31) != 0) : ((gc & 1) != 0);
    const bool has_right = gc < 64 ? ((gc & 31) != 31) : ((gc & 1) != 1);
    {
        const int cg = tid & 31, run = tid >> 5, ch0 = nb * 256 + cg * 8;
        float xin[11][8];
#pragma unroll
        for (int rr = 0; rr < 11; ++rr) { const int lr = run * 8 - 2 + rr; const bool valid = (lr >= 0 || has_left) && (lr < 128 || has_right);
            v4u raw = (v4u){0u, 0u, 0u, 0u}; if (valid) raw = *(const GAS v4u*)(U + (size_t)(m0 + lr) * D + ch0);
            xin[rr][0] = bflo(raw.x); xin[rr][1] = bfhi(raw.x); xin[rr][2] = bflo(raw.y); xin[rr][3] = bfhi(raw.y); xin[rr][4] = bflo(raw.z); xin[rr][5] = bfhi(raw.z); xin[rr][6] = bflo(raw.w); xin[rr][7] = bfhi(raw.w); }
        float cw[4][8], cb[8];
#pragma unroll
        for (int k = 0; k < 4; ++k) { const f32x4 w0 = *(const GAS f32x4*)(conv_w + ((size_t)lj * 4 + k) * D + ch0), w1 = *(const GAS f32x4*)(conv_w + ((size_t)lj * 4 + k) * D + ch0 + 4);
#pragma unroll
            for (int e = 0; e < 4; ++e) { cw[k][e] = w0[e]; cw[k][4 + e] = w1[e]; } }
        { const f32x4 b0 = *(const GAS f32x4*)(conv_b + (size_t)lj * D + ch0), b1 = *(const GAS f32x4*)(conv_b + (size_t)lj * D + ch0 + 4);
#pragma unroll
          for (int e = 0; e < 4; ++e) { cb[e] = b0[e]; cb[4 + e] = b1[e]; } }
#pragma unroll
        for (int tt = 0; tt < 8; ++tt) { float o[8];
#pragma unroll
            for (int e = 0; e < 8; ++e) { float s = cb[e];
#pragma unroll
                for (int k = 0; k < 4; ++k) s += cw[k][e] * xin[tt + k][e];
                o[e] = s; }
            v4u w; w.x = pk2(o[0], o[1]); w.y = pk2(o[2], o[3]); w.z = pk2(o[4], o[5]); w.w = pk2(o[6], o[7]);
            const int R = rg_rmap(run * 8 + tt);
            *(LAS v4u*)(lds + R * 512 + ((cg ^ (R & 15)) << 4)) = w; }
    }
    LDS_WAIT(); __syncthreads();
    const int c = lane & 31, hh = lane >> 5, chl = wave * 32 + c, ch = nb * 256 + chl;
    float cf = 0.f, cbk = 0.f;
    if (PASS == 2) {
        const float* aggd = agg + (size_t)hh * (2 * D) + ch;
        float h = 0.f;
        int n, q0, stp;
        if (gc < 64) { const int bb = gc >> 5, ci = gc & 31;
            const int qa = hh == 0 ? 64 + 2 * bb : 64 + 2 * bb + 1, qb = hh == 0 ? 64 + 2 * bb + 1 : 64 + 2 * bb;
            const float A0 = aggd[(size_t)qa * (4 * D)], H0 = aggd[(size_t)qa * (4 * D) + D], A1 = aggd[(size_t)qb * (4 * D)], H1 = aggd[(size_t)qb * (4 * D) + D];
            h = A1 * H0 + H1;
            (void)A0;
            n = hh == 0 ? ci : 31 - ci; q0 = hh == 0 ? bb * 32 : bb * 32 + 31; stp = hh == 0 ? 1 : -1;
        } else { const int k = gc & 1; const bool has = hh == 0 ? (k == 1) : (k == 0); const int q = hh == 0 ? gc - 1 : gc + 1;
            const float H0 = aggd[(size_t)(has ? q : gc) * (4 * D) + D];
            h = has ? H0 : 0.f; n = 0; q0 = gc; stp = 0; }
        const int nmax = max(__shfl_xor(n, 32), n);
        for (int s0 = 0; s0 < nmax; s0 += 8) {
            float Av[8], Hv[8];
#pragma unroll
            for (int j = 0; j < 8; ++j) { const int se = min(s0 + j, n > 0 ? n - 1 : 0); const float* ap = aggd + (size_t)(q0 + stp * se) * (4 * D); Av[j] = ap[0]; Hv[j] = ap[D]; }
#pragma unroll
            for (int j = 0; j < 8; ++j) { const bool on = s0 + j < n; h = (on ? Av[j] : 1.f) * h + (on ? Hv[j] : 0.f); }
        }
        const float ho = __shfl_xor(h, 32);
        cf = hh == 0 ? h : ho; cbk = hh == 1 ? h : ho;
    }
#pragma unroll 1
    for (int d = 0; d < 2; ++d) {
        f32x16 zr[4], zi[4];
#pragma unroll
        for (int mt = 0; mt < 4; ++mt)
#pragma unroll
            for (int i = 0; i < 16; ++i) { zr[mt][i] = 0.f; zi[mt][i] = 0.f; }
        unsigned lo_ = (unsigned)lane; asm volatile("" : "+v"(lo_));
        const unsigned c_ = lo_ & 31u, hh_ = lo_ >> 5, chl_ = (unsigned)wave * 32u + c_;
        const GAS bf16x8* wp = (const GAS bf16x8*)wgt + ((((size_t)(lj * 16 + nb) * 2 + d) * 8 + wave) * 2) * (16 * 64) + lo_;
        const unsigned abase = c_ * 512u + ((hh_ ^ (c_ & 15u)) << 4);
#pragma unroll 2
        for (int ks = 0; ks < 16; ++ks) {
            const bf16x8 br = wp[ks * 64], bi = wp[(16 + ks) * 64];
            const LAS unsigned char* ap = lds + (abase ^ ((unsigned)ks << 5));
#pragma unroll
            for (int mt = 0; mt < 4; ++mt) {
                const bf16x8 av = *(const LAS bf16x8*)(ap + mt * 16384);
                zr[mt] = __builtin_amdgcn_mfma_f32_32x32x16_bf16(av, br, zr[mt], 0, 0, 0);
                zi[mt] = __builtin_amdgcn_mfma_f32_32x32x16_bf16(av, bi, zi[mt], 0, 0, 0); }
        }
        const unsigned ubase = hh_ * 2048u + ((((chl_ >> 3) ^ (hh_ << 2))) << 4) + (chl_ & 7u) * 2u;
        const float gbr = gate_b[((size_t)(lj * 2 + d) * 2 + 0) * D + ch], gbi = gate_b[((size_t)(lj * 2 + d) * 2 + 1) * D + ch];
        const float lamv = lam[(size_t)(lj * 2 + d) * D + ch];
        const float kk = -8.0f * log1pf(__expf(-lamv));
        float S2 = 0.f;
#pragma unroll
        for (int mt = 0; mt < 4; ++mt)
#pragma unroll
            for (int r = 0; r < 16; ++r) {
                const unsigned cr = (unsigned)(((r >> 2) & 1) * 8 + (r & 3));
                const float up = __uint_as_float((unsigned)(*(const LAS unsigned short*)(lds + (ubase ^ (cr << 4)) + mt * 16384 + (r >> 2) * 4096 + (r & 3) * 512)) << 16);
                const float rg = fast_rcp(1.0f + fast_exp2(-LOG2E * (zr[mt][r] + gbr)));
                const float ig = fast_rcp(1.0f + fast_exp2(-LOG2E * (zi[mt][r] + gbi)));
                const float la = kk * rg, la2 = la * LOG2E, av = fast_exp2(la2), x2 = 2.0f * la;
                const float poly = -x2 * (1.0f + x2 * (0.5f + x2 * (0.16666667f + x2 * (0.041666668f + x2 * 0.0083333338f))));
                const float em = x2 > -0.25f ? poly : 1.0f - av * av;
                S2 += la2; zr[mt][r] = av; zi[mt][r] = __builtin_amdgcn_sqrtf(em) * (ig * up);
            }
        float Hl = 0.f;
        if (d == 0) {
#pragma unroll
            for (int mt = 0; mt < 4; ++mt)
#pragma unroll
                for (int r = 0; r < 16; ++r) Hl = zr[mt][r] * Hl + zi[mt][r];
        } else {
#pragma unroll
            for (int mt = 3; mt >= 0; --mt)
#pragma unroll
                for (int r = 15; r >= 0; --r) Hl = zr[mt][r] * Hl + zi[mt][r];
        }
        const float So = __shfl_xor(S2, 32), Ho = __shfl_xor(Hl, 32);
        if (PASS == 1) {
            if (hh == 0) { const float At = fast_exp2(S2 + So); const float Ht = d == 0 ? fast_exp2(So) * Hl + Ho : fast_exp2(S2) * Ho + Hl;
                float* ap = agg + ((size_t)(gc * 2 + d) * 2) * D + ch; ap[0] = At; ap[D] = Ht; }
        } else {
            float h;
            LAS unsigned short* hst = (LAS unsigned short*)(lds + 65536) + chl_ + hh_ * (64 * 256);
            if (d == 0) { h = hh == 0 ? cf : fast_exp2(So) * cf + Ho;
#pragma unroll
                for (int mt = 0; mt < 4; ++mt) {
#pragma unroll
                    for (int r = 0; r < 16; ++r) { h = zr[mt][r] * h + zi[mt][r]; hst[(mt * 16 + r) * 256] = (unsigned short)(pk2(h, 0.f) & 0xffffu); }
                    asm volatile("" ::: "memory"); }
            } else { h = hh == 1 ? cbk : fast_exp2(So) * cbk + Ho;
#pragma unroll
                for (int mt = 3; mt >= 0; --mt) {
#pragma unroll
                    for (int r = 15; r >= 0; --r) { h = zr[mt][r] * h + zi[mt][r]; LAS unsigned short* p = hst + (mt * 16 + r) * 256;
                        const float hf = __uint_as_float((unsigned)(*p) << 16); *p = (unsigned short)(pk2(hf + h, 0.f) & 0xffffu); }
                    asm volatile("" ::: "memory"); }
            }
        }
    }
    if (PASS == 2) {
        LDS_WAIT(); __syncthreads();
        int tid2 = tid; asm volatile("" : "+v"(tid2));
        const int cg = tid2 & 31, run = tid2 >> 5, ch0 = nb * 256 + cg * 8;
#pragma unroll
        for (int tt = 0; tt < 8; ++tt) { const int t = run * 8 + tt;
            const v4u hv = *(const LAS v4u*)(lds + 65536 + t * 512 + cg * 16); const v4u gv = *(const GAS v4u*)(Gb + (size_t)(m0 + t) * D + ch0);
            v4u o; o.x = pk2(bflo(hv.x) * bflo(gv.x), bfhi(hv.x) * bfhi(gv.x)); o.y = pk2(bflo(hv.y) * bflo(gv.y), bfhi(hv.y) * bfhi(gv.y));
            o.z = pk2(bflo(hv.z) * bflo(gv.z), bfhi(hv.z) * bfhi(gv.z)); o.w = pk2(bflo(hv.w) * bflo(gv.w), bfhi(hv.w) * bfhi(gv.w));
            *(GAS v4u*)(HS + (size_t)(m0 + t) * D + ch0) = o; }
    }
    LDS_WAIT(); __syncthreads();
}

DI unsigned off_b(unsigned row, unsigned ch) { return 256u * row + 16u * (ch ^ (((row & 3u) << 2) | ((row >> 2) & 3u))); }
DI int clampi(int v, int lo, int hi) { return v < lo ? lo : (v > hi ? hi : v); }
DI void tr_read8(s16x4 (&o)[8], unsigned a0, unsigned a1, unsigned a2, unsigned a3, unsigned a4, unsigned a5, unsigned a6, unsigned a7) {
    asm volatile("ds_read_b64_tr_b16 %0, %8\n\tds_read_b64_tr_b16 %1, %9\n\tds_read_b64_tr_b16 %2, %10\n\tds_read_b64_tr_b16 %3, %11\n\t"
                 "ds_read_b64_tr_b16 %4, %12\n\tds_read_b64_tr_b16 %5, %13\n\tds_read_b64_tr_b16 %6, %14\n\tds_read_b64_tr_b16 %7, %15\n\ts_waitcnt lgkmcnt(0)"
                 : "=&v"(o[0]), "=&v"(o[1]), "=&v"(o[2]), "=&v"(o[3]), "=&v"(o[4]), "=&v"(o[5]), "=&v"(o[6]), "=&v"(o[7])
                 : "v"(a0), "v"(a1), "v"(a2), "v"(a3), "v"(a4), "v"(a5), "v"(a6), "v"(a7) : "memory");
}
DI void attn_unit(LAS unsigned char* lds, int unit, const bf16* Qb, const bf16* Kb, const bf16* Vb, const bf16* Gb, bf16* Ob, const float* rpb, int tid, int wave, int lane) {
    asm volatile("" : "+v"(tid), "+v"(lane));
    const bool lat = unit < 2048;
    int b, hd, r0 = 0, half = 0;
    if (lat) { b = unit >> 10; hd = (unit >> 5) & 31; r0 = (unit & 31) * 2; } else { const int u2 = unit - 2048; b = u2 >> 6; hd = (u2 >> 1) & 31; half = u2 & 1; }
    const int rr = wave >> 2, n = wave & 3, ql = lane & 15, g = lane >> 4;
    const int rq = r0 + rr;
    const int qtok = lat ? b * SEQ + rq * 64 + n * 16 + ql : ML + b * CTXL + half * 128 + wave * 16 + ql;
    const int rs0 = clampi(r0 - 4, 0, 56), rsq = clampi(rq - 4, 0, 56);
    const int bs = n == 0 ? 0 : (n == 1 ? 8 : (n == 2 ? 24 : 32));
    const int qc = n * 16 + ql, qcs = clampi(qc - 8, 0, 48);
    LAS float* rpbL = (LAS float*)(lds + 65536);
    bf16x8 qf[4];
#pragma unroll
    for (int ks = 0; ks < 4; ++ks) qf[ks] = *(const GAS bf16x8*)(Qb + (size_t)qtok * D + hd * HDIM + ks * 32 + 8 * g);
    if (lat) for (int i = tid; i < 15 * 31; i += NWAVES * 64) { const int r1 = i / 31, c1 = i - r1 * 31; rpbL[r1 * 32 + c1] = rpb[((size_t)hd * 15 + r1) * 31 + c1] * LOG2E; }
    const int crow = tid >> 4, cch = tid & 15;
#define TILE_LOAD(idx, p0, p1) do { const int _i = (idx); const bf16* _src; \
        if (_i < 18) { const int _s = _i < 9 ? _i : _i - 9; const int _kr = (rs0 + _s) > 63 ? 63 : (rs0 + _s); _src = (_i < 9 ? Kb : Vb) + (size_t)(b * SEQ + _kr * 64) * D + hd * HDIM; } \
        else { const int _j = _i < 22 ? _i - 18 : _i - 22; _src = (_i < 22 ? Kb : Vb) + (size_t)(ML + b * CTXL + _j * 64) * D + hd * HDIM; } \
        p0 = *(const GAS v4u*)(_src + (size_t)crow * D + cch * 8); p1 = *(const GAS v4u*)(_src + (size_t)(crow + 32) * D + cch * 8); } while (0)
#define TILE_STORE(idx, p0, p1) do { LAS unsigned char* _b = lds + (((idx) & 1) << 14); *(LAS v4u*)(_b + off_b(crow, cch)) = p0; *(LAS v4u*)(_b + off_b(crow + 32, cch)) = p1; } while (0)
    v4u pf0, pf1;
    TILE_LOAD(lat ? 0 : 18, pf0, pf1);
    f32x4 O[8];
#pragma unroll
    for (int dt = 0; dt < 8; ++dt) O[dt] = (f32x4){0.f, 0.f, 0.f, 0.f};
    float m1 = -1e30f, l1 = 0.f;
    unsigned vb_lat[2], vb_ctx[2][2], kb_lat[2], kb_ctx[2][2];
#pragma unroll
    for (int t = 0; t < 2; ++t) { kb_lat[t] = off_b((unsigned)(bs + 8 * (ql >> 2) + 4 * t + (ql & 3)), (unsigned)g);
#pragma unroll
        for (int pp = 0; pp < 2; ++pp) kb_ctx[pp][t] = off_b((unsigned)(32 * pp + 8 * (ql >> 2) + 4 * t + (ql & 3)), (unsigned)g); }
    {
        const unsigned q4 = (unsigned)(ql >> 2), p = (unsigned)(lane & 3);
#pragma unroll
        for (int tt = 0; tt < 2; ++tt) {
            { const unsigned row = (unsigned)(bs + 8 * g + 4 * tt) + q4; vb_lat[tt] = off_b(row, p >> 1) + 8u * (p & 1u); }
#pragma unroll
            for (int pp = 0; pp < 2; ++pp) { const unsigned row = (unsigned)(32 * pp + 8 * g + 4 * tt) + q4; vb_ctx[pp][tt] = off_b(row, p >> 1) + 8u * (p & 1u); }
        }
    }
    const unsigned ldsb = (unsigned)(size_t)lds;
    if (lat) {
        f32x4 S[9][2];
#pragma unroll
        for (int s = 0; s < 9; ++s) {
            TILE_STORE(s, pf0, pf1); LDS_WAIT(); __syncthreads(); TILE_LOAD(s + 1, pf0, pf1);
            const LAS unsigned char* buf = lds + ((s & 1) << 14);
#pragma unroll
            for (int t = 0; t < 2; ++t) { f32x4 acc = (f32x4){0.f, 0.f, 0.f, 0.f};
#pragma unroll
                for (int ks = 0; ks < 4; ++ks) { const bf16x8 kf = *(const LAS bf16x8*)(buf + (kb_lat[t] ^ ((unsigned)ks << 6)));
                    acc = __builtin_amdgcn_mfma_f32_16x16x32_bf16(kf, qf[ks], acc, 0, 0, 0); }
                S[s][t] = acc; }
        }
        float mx = -1e30f;
#pragma unroll
        for (int s = 0; s < 9; ++s) { const int kr = rs0 + s; const bool rowok = kr >= rsq && kr < rsq + 8; const int bi0 = clampi(kr - rq + 7, 0, 14) * 32;
#pragma unroll
            for (int t = 0; t < 2; ++t)
#pragma unroll
                for (int r = 0; r < 4; ++r) { const int kc = bs + 8 * g + 4 * t + r; const bool ok = rowok && kc >= qcs && kc < qcs + 16;
                    const float bias = rpbL[bi0 + clampi(kc - qc + 15, 0, 30)];
                    const float v = ok ? S[s][t][r] * ATTN_C1 + bias : -1e30f; S[s][t][r] = v; mx = fmaxf(mx, v); } }
        mx = fmaxf(mx, __shfl_xor(mx, 16)); mx = fmaxf(mx, __shfl_xor(mx, 32));
        m1 = mx;
        v4u Pp[9];
#pragma unroll
        for (int s = 0; s < 9; ++s) { float p[2][4];
#pragma unroll
            for (int t = 0; t < 2; ++t)
#pragma unroll
                for (int r = 0; r < 4; ++r) { p[t][r] = fast_exp2(S[s][t][r] - mx); l1 += p[t][r]; }
            Pp[s].x = pk2(p[0][0], p[0][1]); Pp[s].y = pk2(p[0][2], p[0][3]); Pp[s].z = pk2(p[1][0], p[1][1]); Pp[s].w = pk2(p[1][2], p[1][3]); }
#pragma unroll
        for (int s = 0; s < 9; ++s) {
            const int idx = 9 + s;
            TILE_STORE(idx, pf0, pf1); LDS_WAIT(); __syncthreads(); TILE_LOAD(idx + 1, pf0, pf1);
            const unsigned vb = ldsb + ((unsigned)(idx & 1) << 14);
            const bf16x8 pfr = __builtin_bit_cast(bf16x8, Pp[s]);
#pragma unroll
            for (int dh = 0; dh < 2; ++dh) { s16x4 o[8];
                tr_read8(o, (vb + vb_lat[0]) ^ ((dh * 4 + 0) << 5), (vb + vb_lat[1]) ^ ((dh * 4 + 0) << 5), (vb + vb_lat[0]) ^ ((dh * 4 + 1) << 5), (vb + vb_lat[1]) ^ ((dh * 4 + 1) << 5),
                            (vb + vb_lat[0]) ^ ((dh * 4 + 2) << 5), (vb + vb_lat[1]) ^ ((dh * 4 + 2) << 5), (vb + vb_lat[0]) ^ ((dh * 4 + 3) << 5), (vb + vb_lat[1]) ^ ((dh * 4 + 3) << 5));
#pragma unroll
                for (int j = 0; j < 4; ++j) { const bf16x8 vf = __builtin_shufflevector(o[2 * j], o[2 * j + 1], 0, 1, 2, 3, 4, 5, 6, 7);
                    O[dh * 4 + j] = __builtin_amdgcn_mfma_f32_16x16x32_bf16(vf, pfr, O[dh * 4 + j], 0, 0, 0); } }
        }
    }
    {
        f32x4 S[4][2][2];
#pragma unroll
        for (int j = 0; j < 4; ++j) {
            const int idx = 18 + j;
            TILE_STORE(idx, pf0, pf1); LDS_WAIT(); __syncthreads(); TILE_LOAD(idx + 1, pf0, pf1);
            const LAS unsigned char* buf = lds + ((idx & 1) << 14);
#pragma unroll
            for (int pp = 0; pp < 2; ++pp)
#pragma unroll
                for (int t = 0; t < 2; ++t) { f32x4 acc = (f32x4){0.f, 0.f, 0.f, 0.f};
#pragma unroll
                    for (int ks = 0; ks < 4; ++ks) { const bf16x8 kf = *(const LAS bf16x8*)(buf + (kb_ctx[pp][t] ^ ((unsigned)ks << 6)));
                        acc = __builtin_amdgcn_mfma_f32_16x16x32_bf16(kf, qf[ks], acc, 0, 0, 0); }
                    S[j][pp][t] = acc; }
        }
        float mx = -1e30f;
#pragma unroll
        for (int j = 0; j < 4; ++j)
#pragma unroll
            for (int pp = 0; pp < 2; ++pp)
#pragma unroll
                for (int t = 0; t < 2; ++t)
#pragma unroll
                    for (int r = 0; r < 4; ++r) { const float v = S[j][pp][t][r] * ATTN_C1; S[j][pp][t][r] = v; mx = fmaxf(mx, v); }
        mx = fmaxf(mx, __shfl_xor(mx, 16)); mx = fmaxf(mx, __shfl_xor(mx, 32));
        const float mn = fmaxf(m1, mx), alpha = fast_exp2(m1 - mn);
#pragma unroll
        for (int dt = 0; dt < 8; ++dt) O[dt] = O[dt] * alpha;
        l1 *= alpha;
        v4u Pc[4][2];
#pragma unroll
        for (int j = 0; j < 4; ++j)
#pragma unroll
            for (int pp = 0; pp < 2; ++pp) { float p[2][4];
#pragma unroll
                for (int t = 0; t < 2; ++t)
#pragma unroll
                    for (int r = 0; r < 4; ++r) { p[t][r] = fast_exp2(S[j][pp][t][r] - mn); l1 += p[t][r]; }
                Pc[j][pp].x = pk2(p[0][0], p[0][1]); Pc[j][pp].y = pk2(p[0][2], p[0][3]); Pc[j][pp].z = pk2(p[1][0], p[1][1]); Pc[j][pp].w = pk2(p[1][2], p[1][3]); }
#pragma unroll
        for (int j = 0; j < 4; ++j) {
            const int idx = 22 + j;
            TILE_STORE(idx, pf0, pf1); LDS_WAIT(); __syncthreads(); if (j < 3) TILE_LOAD(idx + 1, pf0, pf1);
            const unsigned vb = ldsb + ((unsigned)(idx & 1) << 14);
#pragma unroll
            for (int pp = 0; pp < 2; ++pp) {
                const bf16x8 pfr = __builtin_bit_cast(bf16x8, Pc[j][pp]);
#pragma unroll
                for (int dh = 0; dh < 2; ++dh) { s16x4 o[8];
                    tr_read8(o, (vb + vb_ctx[pp][0]) ^ ((dh * 4 + 0) << 5), (vb + vb_ctx[pp][1]) ^ ((dh * 4 + 0) << 5), (vb + vb_ctx[pp][0]) ^ ((dh * 4 + 1) << 5), (vb + vb_ctx[pp][1]) ^ ((dh * 4 + 1) << 5),
                                (vb + vb_ctx[pp][0]) ^ ((dh * 4 + 2) << 5), (vb + vb_ctx[pp][1]) ^ ((dh * 4 + 2) << 5), (vb + vb_ctx[pp][0]) ^ ((dh * 4 + 3) << 5), (vb + vb_ctx[pp][1]) ^ ((dh * 4 + 3) << 5));
#pragma unroll
                    for (int jj = 0; jj < 4; ++jj) { const bf16x8 vf = __builtin_shufflevector(o[2 * jj], o[2 * jj + 1], 0, 1, 2, 3, 4, 5, 6, 7);
                        O[dh * 4 + jj] = __builtin_amdgcn_mfma_f32_16x16x32_bf16(vf, pfr, O[dh * 4 + jj], 0, 0, 0); } }
            }
        }
    }
#undef TILE_LOAD
#undef TILE_STORE
    l1 += __shfl_xor(l1, 16); l1 += __shfl_xor(l1, 32);
    const float inv = fast_rcp(l1);
#pragma unroll
    for (int dt = 0; dt < 8; ++dt) { const size_t off = (size_t)qtok * D + hd * HDIM + dt * 16 + 4 * g;
        const v2u gv = *(const GAS v2u*)(Gb + off);
        v2u w; w.x = pk2(O[dt][0] * inv * bflo(gv.x), O[dt][1] * inv * bfhi(gv.x)); w.y = pk2(O[dt][2] * inv * bflo(gv.y), O[dt][3] * inv * bfhi(gv.y));
        *(GAS v2u*)(Ob + off) = w; }
    __syncthreads();
}

__global__ void __launch_bounds__(NWAVES * 64, 2) mega_fwd(Args args) {
    extern __shared__ __attribute__((aligned(16))) unsigned char lds_raw[];
    LAS unsigned char* lds = (LAS unsigned char*)lds_raw;
    volatile LAS unsigned* MISC = (volatile LAS unsigned*)(lds + MISC_OFF);
    const int tid = threadIdx.x, lane = tid & 63, wave = __builtin_amdgcn_readfirstlane(tid >> 6);
    const int G = gridDim.x; const int bx = blockIdx.x; const int vcu = (G % 8 == 0) ? (bx % 8) * (G / 8) + bx / 8 : bx;
    unsigned char* ws = args.ws;
    if (tid < 32) MISC[tid] = 0u;
    __syncthreads();
    XcdBarrier bar; bar.bar = (unsigned*)(ws + WS_CTL) + CW_BAR; bar.x = 0; bar.st = nullptr;
    if (!MK_PER_PHASE) bar = xcd_barrier_post((unsigned*)(ws + WS_CTL) + CW_BAR, MISC + 8);
#if MK_PER_PHASE
    const int lo = args.ph_lo, hi = args.ph_hi;
#else
    constexpr int lo = 0, hi = NPHASE;
#endif
#ifndef SITE_MASK
#define SITE_MASK 0xffff
#endif
#define SITE(x) ((SITE_MASK >> (x)) & 1)
#define IN(k) (lo <= (k) && (k) < hi)
#define SEAM(k) do { if (IN(k) && IN((k) + 1)) xcd_barrier(bar); } while (0)
#define FRESH() int vcu_ = vcu, G_ = G; asm volatile("" : "+s"(vcu_), "+s"(G_))

    bf16* Hb = (bf16*)(ws + WS_H); bf16* Ab = (bf16*)(ws + WS_A); bf16* Bb = (bf16*)(ws + WS_B); bf16* Cb = (bf16*)(ws + WS_C); bf16* Db = (bf16*)(ws + WS_D);
    float* xres = (float*)(ws + WS_XRES); const float* mod = (const float*)(ws + WS_MOD);

    if (SITE(0) && IN(0)) { for (int rep = 0; rep < NREP(0); ++rep) { FRESH(); bg_run(args, lds, tid, wave, lane, vcu_, G_, BgTasks{0, 0, 0, -1}); } }
    SEAM(0);

    for (int lp = 0; lp < 2; ++lp) {
        const int pb = 1 + lp * 9;
        { const int layer = 2 * lp;
          if (SITE(1) && IN(pb + 0)) { FRESH(); norm_phase(args, layer, wave, lane, vcu_, G_); }
          SEAM(pb + 0);
          if (SITE(2) && IN(pb + 1)) {
              const int Gg = gemm_wgs((MT / 256) * (8192 / 256), G);
              pg8::Gemm g{Hb, (const bf16*)(ws + WS_WLIN) + (size_t)lp * 8192 * D, MT, 8192, D}; pg8::StaticOrder S; S.init(MT, 8192, Gg, bx);
              pg8::EpiRgIn E{Ab, Bb};
              for (int rep = 0; rep < NREP(2); ++rep) {
              if (bx < Gg) pg8::gemm_phase<pg8::EpiRgIn, pg8::StaticOrder, true, true>(lds, g, S, E);
              BG_SPARE(Gg, BgTasks{2 * lp + 1, -1, 2 + lp, -1});
              }
          }
          SEAM(pb + 1);
          if (SITE(3) && IN(pb + 2)) {
              for (int rep = 0; rep < NREP(3); ++rep) { FRESH();
              for (int u = vcu_; u < 68 * 16; u += G_)
                  rg_unit<1>(lds, u, lp, Ab, Bb, Hb, args.in[I_LCONVW], args.in[I_LCONVB], (const v4u*)(ws + WS_WGATE), args.in[I_LGATEB], args.in[I_LLAM], (float*)(ws + WS_AGG), tid, wave, lane); }
          }
          SEAM(pb + 2);
          if (SITE(4) && IN(pb + 3)) {
              for (int rep = 0; rep < NREP(4); ++rep) { FRESH();
              for (int u = vcu_; u < 68 * 16; u += G_)
                  rg_unit<2>(lds, u, lp, Ab, Bb, Hb, args.in[I_LCONVW], args.in[I_LCONVB], (const v4u*)(ws + WS_WGATE), args.in[I_LGATEB], args.in[I_LLAM], (float*)(ws + WS_AGG), tid, wave, lane); }
          }
          SEAM(pb + 3);
          if (SITE(5) && IN(pb + 4)) {
              const int Gg = gemm_wgs((MT / 256) * (D / 256), G);
              pg8::Gemm g{Hb, (const bf16*)(ws + WS_WLOUT) + (size_t)lp * D * D, MT, D, D}; pg8::StaticOrder S; S.init(MT, D, Gg, bx);
              pg8::EpiOut E{layer == 0 ? args.in[I_X] : xres, layer == 0 ? args.in[I_CTX] : xres + (size_t)ML * D, xres, mod + (size_t)layer * 3 * (3 * D) + 2 * D};
              if (bx < Gg) pg8::gemm_phase<pg8::EpiOut, pg8::StaticOrder, true, true>(lds, g, S, E);
              BG_SPARE(Gg, BgTasks{-1, -1, 4 + lp, -1});
          }
          SEAM(pb + 4);
        }
        { const int layer = 2 * lp + 1; const bool last = layer == DEPTH - 1;
          if (SITE(1) && IN(pb + 5)) { FRESH(); norm_phase(args, layer, wave, lane, vcu_, G_); }
          SEAM(pb + 5);
          if (SITE(6) && IN(pb + 6)) {
              const int Gg = gemm_wgs((MT / 256) * (16384 / 256), G);
              pg8::Gemm g{Hb, (const bf16*)(ws + WS_WNIN) + (size_t)lp * 16384 * D, MT, 16384, D}; pg8::StaticOrder S; S.init(MT, 16384, Gg, bx);
              pg8::EpiNaIn E{Ab, Bb, Cb, Db, args.in[I_NQKN] + (size_t)lp * 2 * HDIM, (LAS float*)(lds + EPI_P_OFF)};
              if (bx < Gg) pg8::gemm_phase<pg8::EpiNaIn, pg8::StaticOrder, true, true>(lds, g, S, E);
              BG_SPARE(Gg, BgTasks{-1, -1, 6 + lp, -1});
          }
          SEAM(pb + 6);
          if (SITE(7) && IN(pb + 7)) {
              { FRESH();
              const int per = (2048 + G_ - 1) / G_, nctx = last ? 0 : (128 - vcu_ + G_ - 1) / G_;
              for (int i2 = 0; i2 < (per + nctx) * NREP(7); ++i2) { const int i = i2 >= per + nctx ? i2 - (per + nctx) : i2; const int u = i < per ? vcu_ * per + i : 2048 + vcu_ + (i - per) * G_;
                  if (u < 2048 + 128 && (i >= per || u < 2048))
                      attn_unit(lds, u, Ab, Bb, Cb, Db, Hb, args.in[I_NRPB] + (size_t)lp * NHEAD * 15 * 31, tid, wave, lane); } }
          }
          SEAM(pb + 7);
          if (SITE(5) && IN(pb + 8)) {
              const int Mo = last ? ML : MT;
              const int Gg = gemm_wgs((Mo / 256) * (D / 256), G);
              pg8::Gemm g{Hb, (const bf16*)(ws + WS_WNOUT) + (size_t)lp * D * D, Mo, D, D}; pg8::StaticOrder S; S.init(Mo, D, Gg, bx);
              pg8::EpiOut E{xres, xres + (size_t)ML * D, last ? args.out : xres, mod + (size_t)layer * 3 * (3 * D) + 2 * D};
              if (bx < Gg) pg8::gemm_phase<pg8::EpiOut, pg8::StaticOrder, true, true>(lds, g, S, E);
              if (!last) BG_SPARE(Gg, BgTasks{2, 1, 1, -1});
          }
          SEAM(pb + 8);
        }
    }
#undef IN
#undef SEAM
}

extern "C" void kernel_launch(void* const* d_in, const int* in_sizes, int n_in, void* d_out, int out_size, void* d_ws, size_t ws_size, hipStream_t stream) {
    static int grid = 0;
    if (grid == 0) {
        if (n_in != 18 || ws_size < WS_END) { fprintf(stderr, "kernel_launch: unexpected inputs (n_in %d, ws %zu)\n", n_in, ws_size); grid = -1; return; }
        int dev = 0, cus = 0, per_cu = 0;
        if (hipGetDevice(&dev) != hipSuccess || hipDeviceGetAttribute(&cus, hipDeviceAttributeMultiprocessorCount, dev) != hipSuccess) { grid = -1; return; }
        if (hipFuncSetAttribute((const void*)mega_fwd, hipFuncAttributeMaxDynamicSharedMemorySize, LDS_BYTES) != hipSuccess) { fprintf(stderr, "kernel_launch: hipFuncSetAttribute failed\n"); grid = -1; return; }
        if (hipOccupancyMaxActiveBlocksPerMultiprocessor(&per_cu, (const void*)mega_fwd, NWAVES * 64, LDS_BYTES) != hipSuccess || per_cu < 1)
            fprintf(stderr, "kernel_launch: occupancy query reports %d workgroups per CU\n", per_cu);
        (void)hipGetLastError();
        grid = cus;
    }
    if (grid < 0) return;
    if (hipMemsetAsync((char*)d_ws + WS_CTL, 0, CTL_ZERO_BYTES, stream) != hipSuccess) return;
    Args a{};
    for (int i = 0; i < 18; ++i) a.in[i] = (const float*)d_in[i];
    a.out = (float*)d_out; a.ws = (unsigned char*)d_ws;
#if MK_PER_PHASE
    for (int p = 0; p < NPHASE; ++p) { a.ph_lo = p; a.ph_hi = p + 1; hipLaunchKernelGGL(mega_fwd, dim3(grid), dim3(NWAVES * 64), LDS_BYTES, stream, a); }
#else
    a.ph_lo = 0; a.ph_hi = NPHASE;
    hipLaunchKernelGGL(mega_fwd, dim3(grid), dim3(NWAVES * 64), LDS_BYTES, stream, a);
#endif
    (void)in_sizes; (void)out_size;
}
```

```cpp
#define RG_SGB 9
#define RG_SGP 4
#include <hip/hip_runtime.h>
#include <cstdio>
#include <cstdint>
#ifndef PG8_WGM
#define PG8_WGM 6
#endif
namespace pg8 {
#define PG8_LAS __attribute__((address_space(3)))
typedef unsigned short bf16_t;
typedef short bf16x8 __attribute__((ext_vector_type(8)));
typedef float f32x4 __attribute__((ext_vector_type(4)));
typedef unsigned u32x4 __attribute__((ext_vector_type(4)));
constexpr int BM = 256, BK = 64, HALF = 128, HTB = HALF * BK * 2  , STAGE_BYTES = 8 * HTB, NXCD = 8, WGM = PG8_WGM;

__host__ __device__ __forceinline__ int lds_byte(int r, int c) { const int st = (r >> 4) * 2 + (c >> 5), rr = r & 15, cc = c & 31, ob = rr * 64 + cc * 2; return st * 1024 + (ob ^ (((ob >> 9) & 1) << 5)); }
__host__ __device__ __forceinline__ void stage_rc(int b, int& R, int& C) { const int st = b / 1024, sb = b % 1024, swz = sb ^ (((sb >> 9) & 1) << 5); R = (st >> 1) * 16 + swz / 64; C = (st & 1) * 32 + (swz % 64) / 2; }
__host__ __device__ __forceinline__ int perm32(int rho) { const int n = rho >> 4, i = rho & 15; return 8 * (i >> 2) + 4 * n + (i & 3); }

struct Unit { int pm, pn; };
struct Gemm { const bf16_t* A; const bf16_t* Bt; int M, N, K; };

struct StaticOrder {
    int nM, nN, nwg, G, c, rep;
    __host__ __device__ void init(int M, int N, int G_, int c_) { nM = M / BM; nN = N / BM; nwg = nM * nN; G = G_; c = c_; rep = 1; }
    __host__ __device__ bool next(int i, Unit& u) const {
        long L = (long)i * G + c; if (L >= (long)nwg * rep) return false; if (rep > 1) L %= nwg;
        int wgid = (int)L; { const int q = nwg / NXCD, r = nwg % NXCD, xcd = wgid % NXCD, off = wgid / NXCD; wgid = (xcd < r ? xcd * (q + 1) : r * (q + 1) + (xcd - r) * q) + off; }
        const int nig = WGM * nN, gid = wgid / nig, fm = gid * WGM, gsz = (nM - fm) < WGM ? (nM - fm) : WGM;
        u.pm = fm + ((wgid % nig) % gsz); u.pn = (wgid % nig) / gsz; return true;
    }
    __device__ __forceinline__ void a_ready(const Unit&) const {}
    __device__ __forceinline__ void done(const Unit&) const {}
};

__device__ __forceinline__ unsigned cvt_pk_bf16(float lo, float hi) { unsigned r; asm volatile("v_cvt_pk_bf16_f32 %0, %1, %2" : "=v"(r) : "v"(lo), "v"(hi)); return r; }
__device__ __forceinline__ float silu_f(float v) { return v * __builtin_amdgcn_rcpf(1.0f + __builtin_amdgcn_exp2f(-1.4426950408889634f * v)); }
__device__ __forceinline__ f32x4 silu4(f32x4 v) { f32x4 o; o[0] = silu_f(v[0]); o[1] = silu_f(v[1]); o[2] = silu_f(v[2]); o[3] = silu_f(v[3]); return o; }
__device__ __forceinline__ float xrow16_sum(float x) {
    const auto s = __builtin_amdgcn_permlane16_swap(__float_as_uint(x), __float_as_uint(x), false, false); x = __uint_as_float(s[0]) + __uint_as_float(s[1]);
    const auto t = __builtin_amdgcn_permlane32_swap(__float_as_uint(x), __float_as_uint(x), false, false); return __uint_as_float(t[0]) + __uint_as_float(t[1]); }
__device__ __forceinline__ float xrow16_max(float x) {
    const auto s = __builtin_amdgcn_permlane16_swap(__float_as_uint(x), __float_as_uint(x), false, false); x = fmaxf(__uint_as_float(s[0]), __uint_as_float(s[1]));
    const auto t = __builtin_amdgcn_permlane32_swap(__float_as_uint(x), __float_as_uint(x), false, false); return fmaxf(__uint_as_float(t[0]), __uint_as_float(t[1])); }
constexpr int DM = 4096;

constexpr int NB2 = 16384;
typedef unsigned facc_t;
constexpr float RS_SCALE = 1024.0f;
constexpr float B2_SCALE = 1048576.0f;
__device__ __forceinline__ float rinv_of(const facc_t* rowss, int row) { return __builtin_amdgcn_rsqf((float)rowss[row] * (1.0f / (RS_SCALE * DM)) + 1e-6f); }
__device__ __forceinline__ f32x4 b2_load4(const facc_t* p) { typedef int i32x4 __attribute__((ext_vector_type(4))); const i32x4 a = *(const i32x4*)p;
    return (f32x4){(float)a.x * (1.0f / B2_SCALE), (float)a.y * (1.0f / B2_SCALE), (float)a.z * (1.0f / B2_SCALE), (float)a.w * (1.0f / B2_SCALE)}; }
#ifndef EPI_TWICE
#define EPI_TWICE 0
#endif
#define PG8_GAS __attribute__((address_space(1)))
__device__ __forceinline__ void epi_in_loads(const facc_t* rowss, const facc_t* b2, int row0, f32x4 (&bb)[2][2], float (&ri)[2][4]) {
    typedef int i32x4 __attribute__((ext_vector_type(4)));
    i32x4 br[2][2]; unsigned rs[2][4];
#pragma unroll
    for (int bj = 0; bj < 2; ++bj) { br[bj][0] = *(const PG8_GAS i32x4*)(b2 + bj * HALF); br[bj][1] = *(const PG8_GAS i32x4*)(b2 + bj * HALF + 4); }
#pragma unroll
    for (int ai = 0; ai < 2; ++ai)
#pragma unroll
        for (int m = 0; m < 4; ++m) rs[ai][m] = *(const PG8_GAS unsigned*)(rowss + row0 + ai * HALF + m * 16);
    asm volatile("" : "+v"(br[0][0]), "+v"(br[0][1]), "+v"(br[1][0]), "+v"(br[1][1]), "+v"(rs[0][0]), "+v"(rs[0][1]), "+v"(rs[0][2]), "+v"(rs[0][3]), "+v"(rs[1][0]), "+v"(rs[1][1]), "+v"(rs[1][2]), "+v"(rs[1][3]));
#pragma unroll
    for (int bj = 0; bj < 2; ++bj)
#pragma unroll
        for (int h = 0; h < 2; ++h) { const i32x4 a = br[bj][h]; bb[bj][h] = (f32x4){(float)a.x * (1.0f / B2_SCALE), (float)a.y * (1.0f / B2_SCALE), (float)a.z * (1.0f / B2_SCALE), (float)a.w * (1.0f / B2_SCALE)}; }
#pragma unroll
    for (int ai = 0; ai < 2; ++ai)
#pragma unroll
        for (int m = 0; m < 4; ++m) ri[ai][m] = __builtin_amdgcn_rsqf((float)rs[ai][m] * (1.0f / (RS_SCALE * DM)) + 1e-6f);
}
struct EpiRgIn {
    static constexpr bool PERM = true, AFTER_DRAIN = false, TWICE = (EPI_TWICE & 1) != 0;
    bf16_t* U; bf16_t* G; const facc_t* rowss; const facc_t* bias2;
    __device__ __forceinline__ void operator()(const f32x4 (&acc)[2][2][4][2], const Unit& u, int wr, int wc, int fr, int fq) const {
        const int row0 = u.pm * BM + wr * 64 + fr; const bool isg = u.pn >= 16; bf16_t* base = isg ? G : U; const int col0 = (u.pn & 15) * BM + wc * 32 + 8 * fq;
        const facc_t* b2 = bias2 + (size_t)(u.pm < 32 ? (u.pm >> 4) : 2) * NB2 + u.pn * BM + wc * 32 + 8 * fq;
        f32x4 bb[2][2]; float riv[2][4];
        epi_in_loads(rowss, b2, row0, bb, riv);
#pragma unroll
        for (int ai = 0; ai < 2; ++ai)
#pragma unroll
            for (int m = 0; m < 4; ++m) { bf16_t* rowp = base + (size_t)(row0 + ai * HALF + m * 16) * DM + col0; const float ri = riv[ai][m];
#pragma unroll
                for (int bj = 0; bj < 2; ++bj) { f32x4 v0 = acc[ai][bj][m][0] * ri + bb[bj][0], v1 = acc[ai][bj][m][1] * ri + bb[bj][1];
                    if (isg) { v0 = silu4(v0); v1 = silu4(v1); }
                    u32x4 w; w.x = cvt_pk_bf16(v0[0], v0[1]); w.y = cvt_pk_bf16(v0[2], v0[3]); w.z = cvt_pk_bf16(v1[0], v1[1]); w.w = cvt_pk_bf16(v1[2], v1[3]);
                    *(PG8_GAS u32x4*)(rowp + bj * HALF) = w; } }
    }
};
constexpr size_t HM_CTX = (size_t)2 * 32 * 4096 * 128;
__device__ __forceinline__ size_t hm_panel(int pm, int head) { return pm < 32 ? ((size_t)((pm >> 4) * 32 + head) * 4096 + (pm & 15) * 256) * 128 : HM_CTX + ((size_t)((pm - 32) * 32 + head) * 256) * 128; }
__device__ __forceinline__ size_t hm_head(int pm) { return pm < 32 ? (size_t)4096 * 128 : (size_t)256 * 128; }
struct EpiNaIn {
    static constexpr bool PERM = true, AFTER_DRAIN = false, TWICE = (EPI_TWICE & 2) != 0;
    bf16_t *Q, *K, *V, *G; const float* qkn; PG8_LAS float* P; const facc_t* rowss; const facc_t* bias2;
    __device__ __forceinline__ void operator()(const f32x4 (&acc0)[2][2][4][2], const Unit& u, int wr, int wc, int fr, int fq) const {
        const int t = u.pn >> 4; bf16_t* base = t == 0 ? Q : (t == 1 ? K : (t == 2 ? V : G));
        const int row0 = u.pm * BM + wr * 64 + fr, col0 = (u.pn & 15) * BM + wc * 32 + 8 * fq;
        bf16_t* hmb = base + hm_panel(u.pm, 2 * (u.pn & 15)) + (size_t)(wr * 64 + fr) * 128 + wc * 32 + 8 * fq; const size_t hmh = hm_head(u.pm);
        f32x4 acc[2][2][4][2];
        { const facc_t* b2 = bias2 + (size_t)(u.pm < 32 ? (u.pm >> 4) : 2) * NB2 + u.pn * BM + wc * 32 + 8 * fq;
          f32x4 bb[2][2]; float riv[2][4];
          epi_in_loads(rowss, b2, row0, bb, riv);
#pragma unroll
          for (int ai = 0; ai < 2; ++ai)
#pragma unroll
              for (int m = 0; m < 4; ++m) { const float ri = riv[ai][m];
#pragma unroll
                  for (int bj = 0; bj < 2; ++bj) { acc[ai][bj][m][0] = acc0[ai][bj][m][0] * ri + bb[bj][0]; acc[ai][bj][m][1] = acc0[ai][bj][m][1] * ri + bb[bj][1]; } } }
        if (t < 2) {
#pragma unroll
            for (int ai = 0; ai < 2; ++ai)
#pragma unroll
                for (int m = 0; m < 4; ++m)
#pragma unroll
                    for (int bj = 0; bj < 2; ++bj) { const f32x4 a = acc[ai][bj][m][0], b = acc[ai][bj][m][1];
                        float s = (a[0] * a[0] + a[1] * a[1]) + (a[2] * a[2] + a[3] * a[3]) + (b[0] * b[0] + b[1] * b[1]) + (b[2] * b[2] + b[3] * b[3]);
                        s = xrow16_sum(s);
                        if (fq == 0) P[((ai * HALF + wr * 64 + m * 16 + fr) * 2 + bj) * 4 + wc] = s; }
            asm volatile("s_waitcnt lgkmcnt(0)" ::: "memory"); __builtin_amdgcn_s_barrier(); asm volatile("" ::: "memory");
            const float* wg = qkn + t * 128 + wc * 32 + 8 * fq; const f32x4 w0 = *(const PG8_GAS f32x4*)wg, w1 = *(const PG8_GAS f32x4*)(wg + 4);
            float rq[2][4][2];
#pragma unroll
            for (int ai = 0; ai < 2; ++ai)
#pragma unroll
                for (int m = 0; m < 4; ++m)
#pragma unroll
                    for (int bj = 0; bj < 2; ++bj) { const f32x4 p = *(const PG8_LAS f32x4*)(P + ((ai * HALF + wr * 64 + m * 16 + fr) * 2 + bj) * 4);
                        rq[ai][m][bj] = __builtin_amdgcn_rsqf(((p[0] + p[1]) + (p[2] + p[3])) * (1.0f / 128.0f) + 1e-6f); }
#pragma unroll
            for (int ai = 0; ai < 2; ++ai)
#pragma unroll
                for (int m = 0; m < 4; ++m) { const int row = row0 + ai * HALF + m * 16;
                    bf16_t* rowp = t == 1 ? hmb + (size_t)(ai * HALF + m * 16) * 128 : base + (size_t)row * DM + col0;
#pragma unroll
                    for (int bj = 0; bj < 2; ++bj) { const float rinv = rq[ai][m][bj];
                        const f32x4 v0 = acc[ai][bj][m][0] * rinv * w0, v1 = acc[ai][bj][m][1] * rinv * w1;
                        u32x4 w; w.x = cvt_pk_bf16(v0[0], v0[1]); w.y = cvt_pk_bf16(v0[2], v0[3]); w.z = cvt_pk_bf16(v1[0], v1[1]); w.w = cvt_pk_bf16(v1[2], v1[3]);
                        *(PG8_GAS u32x4*)(rowp + (t == 1 ? bj * hmh : (size_t)(bj * HALF))) = w; } }
        } else {
#pragma unroll
            for (int ai = 0; ai < 2; ++ai)
#pragma unroll
                for (int m = 0; m < 4; ++m) { const int row = row0 + ai * HALF + m * 16;
                    bf16_t* rowp = t == 2 ? hmb + (size_t)(ai * HALF + m * 16) * 128 : base + (size_t)row * DM + col0;
#pragma unroll
                    for (int bj = 0; bj < 2; ++bj) { f32x4 v0 = acc[ai][bj][m][0], v1 = acc[ai][bj][m][1];
                        if (t == 3) { v0 = silu4(v0); v1 = silu4(v1); }
                        u32x4 w; w.x = cvt_pk_bf16(v0[0], v0[1]); w.y = cvt_pk_bf16(v0[2], v0[3]); w.z = cvt_pk_bf16(v1[0], v1[1]); w.w = cvt_pk_bf16(v1[2], v1[3]);
                        *(PG8_GAS u32x4*)(rowp + (t == 2 ? bj * hmh : (size_t)(bj * HALF))) = w; } }
        }
    }
};
template <bool SRC_BF16, bool DST_BF16>
struct EpiOut {
    static constexpr bool PERM = true, AFTER_DRAIN = false, TWICE = false;
    const void* src_lat; const void* src_ctx; void* dst; const float* gate;
    const float* rgs;
    bf16_t* XG; const float* gsn; facc_t* rowss_n; PG8_LAS float* P; float ssw;
    __device__ __forceinline__ void operator()(const f32x4 (&acc)[2][2][4][2], const Unit& u, int wr, int wc, int fr, int fq) const {
        const int row0 = u.pm * BM + wr * 64 + fr, col0 = u.pn * BM + wc * 32 + 8 * fq; const int r = u.pm < 32 ? (u.pm >> 4) : 2;
        const float* gp = gate + (size_t)r * (3 * DM) + col0;
        f32x4 gv[2][2], gs[2][2], rg[2][2];
#pragma unroll
        for (int bj = 0; bj < 2; ++bj)
#pragma unroll
            for (int n = 0; n < 2; ++n) { gv[bj][n] = *(const PG8_GAS f32x4*)(gp + bj * HALF + n * 4); gs[bj][n] = XG ? *(const PG8_GAS f32x4*)(gsn + (size_t)r * DM + col0 + bj * HALF + n * 4) : (f32x4){0.f, 0.f, 0.f, 0.f};
                rg[bj][n] = SRC_BF16 ? *(const PG8_GAS f32x4*)(rgs + (size_t)r * DM + col0 + bj * HALF + n * 4) : (f32x4){1.f, 1.f, 1.f, 1.f}; }
        f32x4 sv[4][2][2]; u32x4 sb[4][2];
#define EPIOUT_REQ(AIH) do { const int ai_ = (AIH) >> 1, mh_ = ((AIH) & 1) * 2; _Pragma("unroll") for (int m = mh_; m < mh_ + 2; ++m) { const int row = row0 + ai_ * HALF + m * 16; \
                const size_t so = (row < 8192 ? (size_t)row * DM : (size_t)(row - 8192) * DM) + col0; \
                _Pragma("unroll") for (int bj = 0; bj < 2; ++bj) { \
                    if (SRC_BF16) sb[m][bj] = *(const PG8_GAS u32x4*)((const bf16_t*)(row < 8192 ? src_lat : src_ctx) + so + bj * HALF); \
                    else { const float* sp = (const float*)(row < 8192 ? src_lat : src_ctx) + so + bj * HALF; sv[m][bj][0] = *(const PG8_GAS f32x4*)sp; sv[m][bj][1] = *(const PG8_GAS f32x4*)(sp + 4); } } } } while (0)
        if (SRC_BF16) EPIOUT_REQ(0);
#pragma unroll
        for (int aih = 0; aih < 4; ++aih) { const int ai = aih >> 1, mh = (aih & 1) * 2;
            if (SRC_BF16) { if (aih + 1 < 4) EPIOUT_REQ(aih + 1); } else EPIOUT_REQ(aih);
            asm volatile("" ::: "memory");
#pragma unroll
            for (int m = mh; m < mh + 2; ++m) { const int row = row0 + ai * HALF + m * 16;
                float ss = 0.f;
#pragma unroll
                for (int bj = 0; bj < 2; ++bj) {
                    if (SRC_BF16) { const u32x4 w = sb[m][bj];
                        sv[m][bj][0] = (f32x4){__uint_as_float(w.x << 16), __uint_as_float(w.x & 0xffff0000u), __uint_as_float(w.y << 16), __uint_as_float(w.y & 0xffff0000u)} * rg[bj][0];
                        sv[m][bj][1] = (f32x4){__uint_as_float(w.z << 16), __uint_as_float(w.z & 0xffff0000u), __uint_as_float(w.w << 16), __uint_as_float(w.w & 0xffff0000u)} * rg[bj][1]; }
                    const f32x4 o0 = sv[m][bj][0] + gv[bj][0] * acc[ai][bj][m][0], o1 = sv[m][bj][1] + gv[bj][1] * acc[ai][bj][m][1];
                    if (!DST_BF16) { float* dp = (float*)dst + (size_t)row * DM + col0 + bj * HALF; *(PG8_GAS f32x4*)dp = o0; *(PG8_GAS f32x4*)(dp + 4) = o1; }
                    if (XG) { ss += (o0[0] * o0[0] + o0[1] * o0[1]) + (o0[2] * o0[2] + o0[3] * o0[3]) + (o1[0] * o1[0] + o1[1] * o1[1]) + (o1[2] * o1[2] + o1[3] * o1[3]);
                        const f32x4 y0 = o0 * gs[bj][0], y1 = o1 * gs[bj][1];
                        u32x4 w; w.x = cvt_pk_bf16(y0[0], y0[1]); w.y = cvt_pk_bf16(y0[2], y0[3]); w.z = cvt_pk_bf16(y1[0], y1[1]); w.w = cvt_pk_bf16(y1[2], y1[3]);
                        *(PG8_GAS u32x4*)(XG + (size_t)row * DM + col0 + bj * HALF) = w; } }
                if (XG) { ss = xrow16_sum(ss); if (fq == 0) __hip_atomic_fetch_add((PG8_GAS facc_t*)(rowss_n + row), (facc_t)(ss * (ssw * RS_SCALE) + 0.5f), __ATOMIC_RELAXED, __HIP_MEMORY_SCOPE_AGENT); } }
        }
#undef EPIOUT_REQ
    }
};

template <class Epi, class Sched, bool ALIGN_EPI = false, bool SP2 = false>
__device__ __forceinline__ void gemm_phase(PG8_LAS unsigned char* lds, const Gemm g, const Sched& S, const Epi& E) {
    int tid_o = threadIdx.x; asm volatile("" : "+v"(tid_o));
    const int tid = tid_o, wid = __builtin_amdgcn_readfirstlane(tid >> 6), lane = tid & 63, wr = wid >> 2, wc = wid & 3, fr = lane & 15, fq = lane >> 4;
    const int K = g.K, nt = K / BK;
    unsigned voffA[2], voffB[2];
#pragma unroll
    for (int i = 0; i < 2; ++i) { int R, C; stage_rc(tid * 16 + i * 8192, R, C); const int Rb = Epi::PERM ? ((R & ~31) + perm32(R & 31)) : R;
        voffA[i] = (unsigned)(R * K + C) * 2u; voffB[i] = (unsigned)(Rb * K + C) * 2u; }
    const size_t kstep = (size_t)(BK * 2);
    const size_t hstep = (size_t)HALF * K * 2;
    const size_t tstep = 2 * hstep;
    const unsigned ldsw = (unsigned)wid * 1024u;
    const int aoff = lds_byte(wr * 64 + fr, fq * 8), boff = lds_byte(wc * 32 + fr, fq * 8);
#define PG8_SA(b, h) (((b) * 2 + (h)) * HTB)
#define PG8_SB(b, h) ((4 + (b) * 2 + (h)) * HTB)
#define PG8_STAGE(bufoff, gbase, voff) do { _Pragma("unroll") for (int _i = 0; _i < 2; ++_i) \
        __builtin_amdgcn_global_load_lds((const unsigned*)((const char*)(gbase) + (voff)[_i]), (PG8_LAS unsigned*)(lds + (bufoff) + ldsw + _i * 8192), 16, 0, 0); } while (0)
#define PG8_LDA(dst, b, h) do { _Pragma("unroll") for (int m = 0; m < 4; ++m) _Pragma("unroll") for (int k = 0; k < 2; ++k) dst[m][k] = *(const PG8_LAS bf16x8*)(lds + PG8_SA(b, h) + aoff + m * 2048 + k * 1024); } while (0)
#define PG8_LDB(dst, b, h) do { _Pragma("unroll") for (int n = 0; n < 2; ++n) _Pragma("unroll") for (int k = 0; k < 2; ++k) dst[n][k] = *(const PG8_LAS bf16x8*)(lds + PG8_SB(b, h) + boff + n * 2048 + k * 1024); } while (0)
#ifndef PG8_PRIO
#define PG8_PRIO 1
#endif
#define PG8_MMA(ai, bj, At, Bt) do { if (PG8_PRIO) __builtin_amdgcn_s_setprio(1); _Pragma("unroll") for (int m = 0; m < 4; ++m) _Pragma("unroll") for (int n = 0; n < 2; ++n) _Pragma("unroll") for (int k = 0; k < 2; ++k) \
        acc[ai][bj][m][n] = __builtin_amdgcn_mfma_f32_16x16x32_bf16(Bt[n][k], At[m][k], acc[ai][bj][m][n], 0, 0, 0); if (PG8_PRIO) __builtin_amdgcn_s_setprio(0); } while (0)
#define PG8_WAIT_V(n) asm volatile("s_waitcnt vmcnt(" #n ")" ::: "memory")
#define PG8_WAIT_L(n) asm volatile("s_waitcnt lgkmcnt(" #n ")" ::: "memory")
#define PG8_BAR __builtin_amdgcn_s_barrier()
#define PG8_SCHED __builtin_amdgcn_sched_barrier(0)
    Unit cur, nxt; int ui = 0;
    if (!S.next(0, cur)) return;
    f32x4 acc[2][2][4][2];
#pragma unroll
    for (int a = 0; a < 2; ++a)
#pragma unroll
        for (int b = 0; b < 2; ++b)
#pragma unroll
            for (int m = 0; m < 4; ++m)
#pragma unroll
                for (int n = 0; n < 2; ++n) acc[a][b][m][n] = (f32x4){0.f, 0.f, 0.f, 0.f};
    bf16x8 At[4][2], B0[2][2], B1[2][2];
    const char* cA = (const char*)g.A + (size_t)cur.pm * tstep; const char* cB = (const char*)g.Bt + (size_t)cur.pn * tstep;
    S.a_ready(cur);
    if constexpr (SP2) {
        PG8_STAGE(PG8_SB(0, 0), cB, voffB); PG8_STAGE(PG8_SB(0, 1), cB + hstep, voffB); PG8_STAGE(PG8_SA(0, 0), cA, voffA); PG8_STAGE(PG8_SA(0, 1), cA + hstep, voffA);
        if (wr == 1) PG8_BAR;
        PG8_WAIT_V(2); PG8_BAR;
        PG8_STAGE(PG8_SB(1, 0), cB + kstep, voffB); PG8_STAGE(PG8_SA(1, 0), cA + kstep, voffA); PG8_STAGE(PG8_SB(1, 1), cB + hstep + kstep, voffB);
        PG8_WAIT_V(6); PG8_BAR;
    } else {
        PG8_STAGE(PG8_SB(0, 0), cB, voffB); PG8_STAGE(PG8_SA(0, 0), cA, voffA); PG8_STAGE(PG8_SB(0, 1), cB + hstep, voffB); PG8_STAGE(PG8_SA(0, 1), cA + hstep, voffA);
        if (wr == 1) PG8_BAR;
        PG8_WAIT_V(4); PG8_BAR;
        PG8_STAGE(PG8_SB(1, 0), cB + kstep, voffB); PG8_STAGE(PG8_SA(1, 0), cA + kstep, voffA); PG8_STAGE(PG8_SB(1, 1), cB + hstep + kstep, voffB);
        PG8_WAIT_V(6); PG8_BAR;
    }
    for (;;) {
        const bool has_next = S.next(ui + 1, nxt);
        const char* nA = has_next ? (const char*)g.A + (size_t)nxt.pm * tstep : cA; const char* nB = has_next ? (const char*)g.Bt + (size_t)nxt.pn * tstep : cB;
        for (int t = 0; t < nt; t += 2) {
            const bool last = (t == nt - 2);
            const char* a1 = cA + (size_t)(t + 1) * kstep;
            const char* a2 = last ? nA : cA + (size_t)(t + 2) * kstep; const char* b2 = last ? nB : cB + (size_t)(t + 2) * kstep;
            const char* a3 = a2 + kstep; const char* b3 = b2 + kstep;
            if (last && has_next) S.a_ready(nxt);
            if constexpr (SP2) {
            PG8_LDB(B0, 0, 0); PG8_LDB(B1, 0, 1); PG8_SCHED; PG8_LDA(At, 0, 0); PG8_STAGE(PG8_SA(1, 1), a1 + hstep, voffA);
            PG8_WAIT_V(8); PG8_WAIT_L(0); PG8_BAR; PG8_MMA(0, 0, At, B0); PG8_MMA(0, 1, At, B1); PG8_BAR; PG8_SCHED;
            PG8_LDA(At, 0, 1); PG8_STAGE(PG8_SB(0, 0), b2, voffB); PG8_STAGE(PG8_SB(0, 1), b2 + hstep, voffB); PG8_STAGE(PG8_SA(0, 0), a2, voffA);
            PG8_WAIT_V(8); PG8_WAIT_L(0); PG8_BAR; PG8_MMA(1, 0, At, B0); PG8_MMA(1, 1, At, B1); PG8_BAR; PG8_SCHED;
            PG8_LDB(B0, 1, 0); PG8_LDB(B1, 1, 1); PG8_SCHED; PG8_LDA(At, 1, 0); PG8_STAGE(PG8_SA(0, 1), a2 + hstep, voffA);
            PG8_WAIT_V(8); PG8_WAIT_L(0); PG8_BAR; PG8_MMA(0, 0, At, B0); PG8_MMA(0, 1, At, B1); PG8_BAR; PG8_SCHED;
            PG8_LDA(At, 1, 1); PG8_STAGE(PG8_SB(1, 0), b3, voffB); PG8_STAGE(PG8_SB(1, 1), b3 + hstep, voffB); PG8_STAGE(PG8_SA(1, 0), a3, voffA);
            PG8_WAIT_V(8); PG8_WAIT_L(0); PG8_BAR; PG8_MMA(1, 0, At, B0); PG8_MMA(1, 1, At, B1); PG8_BAR; PG8_SCHED;
            } else {
            PG8_LDB(B0, 0, 0); PG8_SCHED; PG8_LDA(At, 0, 0); PG8_STAGE(PG8_SA(1, 1), a1 + hstep, voffA);
            PG8_WAIT_L(8); PG8_BAR; PG8_WAIT_L(0); PG8_MMA(0, 0, At, B0); PG8_BAR; PG8_SCHED;
            PG8_LDB(B1, 0, 1); PG8_STAGE(PG8_SB(0, 0), b2, voffB);
            PG8_BAR; PG8_WAIT_L(0); PG8_MMA(0, 1, At, B1); PG8_BAR;
            PG8_LDA(At, 0, 1); PG8_STAGE(PG8_SA(0, 0), a2, voffA);
            PG8_BAR; PG8_WAIT_L(0); PG8_MMA(1, 0, At, B0); PG8_BAR; PG8_SCHED;
            PG8_STAGE(PG8_SB(0, 1), b2 + hstep, voffB);
            PG8_WAIT_V(6); PG8_BAR; PG8_MMA(1, 1, At, B1); PG8_BAR;
            PG8_LDB(B0, 1, 0); PG8_SCHED; PG8_LDA(At, 1, 0); PG8_STAGE(PG8_SA(0, 1), a2 + hstep, voffA);
            PG8_WAIT_L(8); PG8_BAR; PG8_WAIT_L(0); PG8_MMA(0, 0, At, B0); PG8_BAR; PG8_SCHED;
            PG8_LDB(B1, 1, 1); PG8_STAGE(PG8_SB(1, 0), b3, voffB);
            PG8_BAR; PG8_WAIT_L(0); PG8_MMA(0, 1, At, B1); PG8_BAR;
            PG8_LDA(At, 1, 1); PG8_STAGE(PG8_SA(1, 0), a3, voffA);
            PG8_BAR; PG8_WAIT_L(0); PG8_MMA(1, 0, At, B0); PG8_BAR; PG8_SCHED;
            PG8_STAGE(PG8_SB(1, 1), b3 + hstep, voffB);
            PG8_WAIT_V(6); PG8_BAR; PG8_MMA(1, 1, At, B1); PG8_BAR;
            }
        }
        if constexpr (ALIGN_EPI) { if (wr == 0) PG8_BAR; }
        if constexpr (!Epi::AFTER_DRAIN) { if constexpr (Epi::TWICE) { int ne_ = 2; asm volatile("" : "+s"(ne_)); _Pragma("unroll 1") for (int e_ = 0; e_ < ne_; ++e_) { asm volatile("" ::: "memory"); E(acc, cur, wr, wc, fr, fq); } } else E(acc, cur, wr, wc, fr, fq); S.done(cur); }
        if (!has_next) break;
#pragma unroll
        for (int a = 0; a < 2; ++a)
#pragma unroll
            for (int b = 0; b < 2; ++b)
#pragma unroll
                for (int m = 0; m < 4; ++m)
#pragma unroll
                    for (int n = 0; n < 2; ++n) acc[a][b][m][n] = (f32x4){0.f, 0.f, 0.f, 0.f};
        cur = nxt; cA = nA; cB = nB; ++ui;
        if constexpr (ALIGN_EPI) { if (wr == 1) PG8_BAR; }
    }
    PG8_WAIT_V(0);
    if constexpr (!ALIGN_EPI) { if (wr == 0) PG8_BAR; }
    PG8_BAR;
    if constexpr (Epi::AFTER_DRAIN) { E.fused(acc, cur, wr, wc, fr, fq, lds, wid, lane); S.done(cur); }
#undef PG8_SA
#undef PG8_SB
#undef PG8_STAGE
#undef PG8_LDA
#undef PG8_LDB
#undef PG8_MMA
#undef PG8_WAIT_V
#undef PG8_WAIT_L
#undef PG8_BAR
#undef PG8_SCHED
}
}

#ifndef EPIOUT_ALIGN
#define EPIOUT_ALIGN true
#endif
#ifndef PG8_SP2V
#define PG8_SP2V true
#endif
constexpr int NWAVES = 8;
constexpr int D = 4096, NBATCH = 2, SEQ = 4096, CTXL = 256, DEPTH = 4, NHEAD = 32, HDIM = 128;
constexpr int ML = NBATCH * SEQ;
constexpr int MC = NBATCH * CTXL;
constexpr int MT = ML + MC;
constexpr float EPS = 1e-6f;
constexpr float LOG2E = 1.4426950408889634f;
constexpr float ATTN_C1 = 0.08838834764831845f * LOG2E;

#ifndef DUP_MASK
#define DUP_MASK 0
#endif
#define NREP(x) (1 + ((DUP_MASK >> (x)) & 1))
#ifndef MK_PER_PHASE
#define MK_PER_PHASE 0
#endif
constexpr int NPHASE = 18;

constexpr size_t MiB = 1u << 20;
constexpr size_t WS_CTL = 0, CTL_ZERO_BYTES = 4 * MiB;
constexpr size_t WS_MOD = 1 * MiB;
constexpr size_t WS_WGATE = 8 * MiB;
constexpr size_t WS_WLIN = 24 * MiB;
constexpr size_t WS_WLOUT = 152 * MiB;
constexpr size_t WS_WNIN = 216 * MiB;
constexpr size_t WS_WNOUT = 472 * MiB;
constexpr size_t WS_H = 672 * MiB;
constexpr size_t WS_A = 740 * MiB, WS_B = 808 * MiB, WS_C = 876 * MiB, WS_D = 944 * MiB;
constexpr size_t WS_AGG2 = 1012 * MiB;
constexpr size_t WS_CARRY = 1022 * MiB;
constexpr size_t WS_E = 1028 * MiB;
constexpr size_t WS_GS = 1096 * MiB;
constexpr size_t WS_COEF = 1097 * MiB;
constexpr size_t WS_RGS = 1370 * MiB;
constexpr size_t WS_END = 1371 * MiB;
constexpr size_t CTL_ROWSS = 2 * MiB;
constexpr size_t CTL_BIAS2 = 2 * MiB + 512 * 1024;
constexpr int CW_BAR = 4096;

constexpr int RING_BYTES = 131072;
constexpr int EPI_P_OFF = RING_BYTES;
constexpr int MISC_OFF = RING_BYTES + 8192 + 320;
constexpr int LDS_BYTES = 147456;

#define GAS __attribute__((address_space(1)))
#define LAS __attribute__((address_space(3)))
#define DI __device__ __forceinline__
typedef unsigned short bf16;
typedef unsigned v4u __attribute__((ext_vector_type(4)));
typedef unsigned v2u __attribute__((ext_vector_type(2)));
typedef float f32x4 __attribute__((ext_vector_type(4)));
typedef float f32x16 __attribute__((ext_vector_type(16)));
typedef short bf16x8 __attribute__((ext_vector_type(8)));
typedef short s16x4 __attribute__((ext_vector_type(4)));
#define LDS_WAIT() asm volatile("s_waitcnt lgkmcnt(0)" ::: "memory")
#define VM_WAIT() asm volatile("s_waitcnt vmcnt(0)" ::: "memory")
DI unsigned pk2(float lo, float hi) { return pg8::cvt_pk_bf16(lo, hi); }
DI float bflo(unsigned w) { return __uint_as_float(w << 16); }
DI float bfhi(unsigned w) { return __uint_as_float(w & 0xffff0000u); }
DI float fast_exp2(float x) { return __builtin_amdgcn_exp2f(x); }
DI float fast_rcp(float x) { return __builtin_amdgcn_rcpf(x); }

#define XB_TMO      128
#define XB_XCNT(j)  (256  + 64 * (j))
#define XB_XSUB(j)  (1280 + 64 * (j))
#define XB_XGEN(j)  (2304 + 64 * (j))
#define XB_TOP      3328
#define XB_TOPGEN   3392
#define XCD_BAR_WORDS 3456
#define XB_SPIN_CAP (1u << 18)
__device__ __forceinline__ unsigned xb_ld(unsigned* p)              { return __hip_atomic_load(p, __ATOMIC_RELAXED, __HIP_MEMORY_SCOPE_AGENT); }
__device__ __forceinline__ unsigned xb_add(unsigned* p, unsigned v) { return __hip_atomic_fetch_add(p, v, __ATOMIC_RELAXED, __HIP_MEMORY_SCOPE_AGENT); }
__device__ __forceinline__ unsigned xb_xcc_id() { return (unsigned)__builtin_amdgcn_s_getreg((3 << 11) | 20) & 0xFu; }
#define XB_SPIN(cond, bar) do { unsigned _sp = 0; while (cond) { __builtin_amdgcn_s_sleep(1); \
    if ((++_sp & 255u) == 0u) { if (xb_ld(&(bar)[XB_TMO])) break; if (_sp > XB_SPIN_CAP) { atomicAdd(&(bar)[XB_TMO], 1u); break; } } } } while (0)
struct XcdBarrier { unsigned* bar; unsigned x; volatile LAS unsigned* st; };
__device__ __forceinline__ XcdBarrier xcd_barrier_post(unsigned* bar, volatile LAS unsigned* st) {
    XcdBarrier b; b.bar = bar; b.x = xb_xcc_id(); b.st = st;
    if (threadIdx.x == 0) (void)xb_add(&bar[XB_XCNT(b.x)], 1u);
    return b;
}
__device__ __forceinline__ void xcd_barrier_complete(unsigned* bar, unsigned x, unsigned& nloc, unsigned& nx) {
    const unsigned G = gridDim.x * gridDim.y * gridDim.z;
    unsigned sum, cnt, mine, sp = 0u;
    for (;;) {
        sum = 0u; cnt = 0u; mine = 0u;
#pragma unroll
        for (unsigned j0 = 0; j0 < 16; j0 += 8) {
            unsigned c8[8];
#pragma unroll
            for (unsigned j = 0; j < 8; ++j) c8[j] = xb_ld(&bar[XB_XCNT(j0 + j)]);
            asm volatile("" : "+v"(c8[0]), "+v"(c8[1]), "+v"(c8[2]), "+v"(c8[3]), "+v"(c8[4]), "+v"(c8[5]), "+v"(c8[6]), "+v"(c8[7]));
#pragma unroll
            for (unsigned j = 0; j < 8; ++j) { const unsigned c = c8[j]; sum += c; cnt += (c > 0u) ? 1u : 0u; mine = (j0 + j == x) ? c : mine; } }
        if (sum == G) break;
        __builtin_amdgcn_s_sleep(1);
        if ((++sp & 255u) == 0u) { if (xb_ld(&bar[XB_TMO])) break; if (sp > XB_SPIN_CAP) { atomicAdd(&bar[XB_TMO], 1u); break; } }
    }
    nloc = mine > 0u ? mine : 1u; nx = cnt > 0u ? cnt : 1u;
}
__device__ __forceinline__ void xcd_barrier(const XcdBarrier& b) {
    asm volatile("s_waitcnt vmcnt(0)" ::: "memory");
    __syncthreads();
    if (threadIdx.x == 0) {
        unsigned* bar = b.bar;
        __builtin_amdgcn_s_waitcnt(0);
        const unsigned bx_ = xb_xcc_id();
        unsigned nloc = b.st[0], nx = b.st[1];
        if (nloc == 0u) { xcd_barrier_complete(bar, bx_, nloc, nx); b.st[0] = nloc; b.st[1] = nx; }
        const unsigned old = xb_add(&bar[XB_XSUB(bx_)], 1u);
        const unsigned gen = old / nloc;
        if (old + 1u == (gen + 1u) * nloc) {
            __builtin_amdgcn_fence(__ATOMIC_RELEASE, "agent");
            asm volatile("s_waitcnt vmcnt(0)" ::: "memory");
            const unsigned og = xb_add(&bar[XB_TOP], 1u);
            const unsigned tg = og / nx;
            if (og + 1u == (tg + 1u) * nx) xb_add(&bar[XB_TOPGEN], 1u);
            else XB_SPIN(xb_ld(&bar[XB_TOPGEN]) == tg, bar);
            __builtin_amdgcn_fence(__ATOMIC_ACQUIRE, "agent");
            xb_add(&bar[XB_XGEN(bx_)], 1u);
            asm volatile("s_waitcnt vmcnt(0)" ::: "memory");
        } else {
            XB_SPIN(xb_ld(&bar[XB_XGEN(bx_)]) == gen, bar);
            __builtin_amdgcn_fence(__ATOMIC_ACQUIRE, "agent");
            asm volatile("s_waitcnt vmcnt(0)" ::: "memory");
        }
    }
    __syncthreads();
}

struct Args { const float* in[18]; float* out; unsigned char* ws; int ph_lo, ph_hi; };
enum { I_X = 0, I_C, I_CTX, I_CCTX, I_ADAW, I_ADAB, I_NORMG, I_LIN, I_LCONVW, I_LCONVB, I_LGATEW, I_LGATEB, I_LLAM, I_LOUT, I_NIN, I_NQKN, I_NRPB, I_NOUT };

DI float wave_sum(float v) {
#pragma unroll
    for (int o = 1; o < 64; o <<= 1) v += __shfl_xor(v, o);
    return v;
}

DI void tr_load(const float* W, int N, int item, int lane, f32x4 (&v)[16]) {
    const int nblk = N >> 6, kb = item / nblk, nb = item - kb * nblk;
    const GAS float* p = (const GAS float*)W + (size_t)(64 * kb + (lane >> 4)) * N + 64 * nb + 4 * (lane & 15);
#pragma unroll
    for (int i = 0; i < 16; ++i) v[i] = __builtin_nontemporal_load((const GAS f32x4*)(p + (size_t)(4 * i) * N));
}
DI void tr_store(bf16* WT, int K, int N, int item, int lane, LAS float* scr, const f32x4 (&v)[16], const float* shift, pg8::facc_t* bias2) {
    const int nblk = N >> 6, kb = item / nblk, nb = item - kb * nblk;
    { LAS float* w = scr + (lane >> 4) * 65 + 4 * (lane & 15);
#pragma unroll
      for (int i = 0; i < 16; ++i) { w[(4 * i) * 65 + 0] = v[i][0]; w[(4 * i) * 65 + 1] = v[i][1]; w[(4 * i) * 65 + 2] = v[i][2]; w[(4 * i) * 65 + 3] = v[i][3]; } }
    LDS_WAIT(); asm volatile("" ::: "memory");
    if (shift) {
        const float h0 = shift[64 * kb + lane], h1 = shift[3 * D + 64 * kb + lane], h2 = shift[6 * D + 64 * kb + lane];
        float s0 = 0.f, s1 = 0.f, s2 = 0.f;
#pragma unroll
        for (int k = 0; k < 64; ++k) { const float w = scr[k * 65 + lane];
            s0 += __builtin_bit_cast(float, __builtin_amdgcn_readlane(__builtin_bit_cast(int, h0), k)) * w;
            s1 += __builtin_bit_cast(float, __builtin_amdgcn_readlane(__builtin_bit_cast(int, h1), k)) * w;
            s2 += __builtin_bit_cast(float, __builtin_amdgcn_readlane(__builtin_bit_cast(int, h2), k)) * w; }
        pg8::facc_t* bp = bias2 + 64 * nb + lane;
        atomicAdd(bp, (pg8::facc_t)(int)rintf(s0 * pg8::B2_SCALE)); atomicAdd(bp + pg8::NB2, (pg8::facc_t)(int)rintf(s1 * pg8::B2_SCALE)); atomicAdd(bp + 2 * pg8::NB2, (pg8::facc_t)(int)rintf(s2 * pg8::B2_SCALE));
    }
    const int c = lane & 7;
#pragma unroll
    for (int j = 0; j < 8; ++j) { const int n = (lane >> 3) + 8 * j; const LAS float* q = scr + (8 * c) * 65 + n;
        v4u o; o.x = pk2(q[0 * 65], q[1 * 65]); o.y = pk2(q[2 * 65], q[3 * 65]); o.z = pk2(q[4 * 65], q[5 * 65]); o.w = pk2(q[6 * 65], q[7 * 65]);
        __builtin_nontemporal_store(o, (GAS v4u*)(WT + (size_t)(64 * nb + n) * K + 64 * kb + 8 * c)); }
    LDS_WAIT(); asm volatile("" ::: "memory");
}

struct BgTasks { int ada_layer, gate_lj, tr0, tr1, ada_lo = 0, ada_hi = 192; };
DI void bg_run(const Args& a, LAS unsigned char* lds, int tid, int wave, int lane, int widx, int nw, const BgTasks t) {
    asm volatile("" : "+v"(tid), "+v"(lane));
    unsigned char* ws = a.ws;
    if (t.ada_layer >= 0) {
        const int i = t.ada_layer;
        LAS f32x4* condL = (LAS f32x4*)lds;
        LAS float* red = (LAS float*)(lds + 65536);
        const float* c = a.in[I_C]; const float* cc = a.in[I_CCTX];
        for (int k = tid; k < D; k += NWAVES * 64) { f32x4 v; v[0] = pg8::silu_f(c[k]); v[1] = pg8::silu_f(c[D + k]); v[2] = pg8::silu_f(cc[k]); v[3] = 0.f; condL[k] = v; }
        __syncthreads();
        float* mod = (float*)(ws + WS_MOD);
        const int cw = nw >= 256 ? 48 : 64, ilo = nw >= 256 ? 0 : t.ada_lo, ihi = nw >= 256 ? (3 * D) / 48 : t.ada_hi;
        for (int item = ilo + widx; item < ihi; item += nw) {
            const int n0 = item * cw;
            const float* wp = a.in[I_ADAW] + ((size_t)i * D + wave * 512) * (3 * D) + n0 + lane;
            float a0 = 0.f, a1 = 0.f, a2 = 0.f;
            if (lane < cw) for (int kk = 0; kk < 512; kk += 32) {
                float w[32];
#pragma unroll
                for (int j = 0; j < 32; ++j) w[j] = __builtin_nontemporal_load(wp + (size_t)(kk + j) * (3 * D));
#pragma unroll
                for (int j = 0; j < 32; ++j) { const f32x4 cv = condL[wave * 512 + kk + j]; a0 += cv[0] * w[j]; a1 += cv[1] * w[j]; a2 += cv[2] * w[j]; }
            }
            red[(wave * 3 + 0) * 64 + lane] = a0; red[(wave * 3 + 1) * 64 + lane] = a1; red[(wave * 3 + 2) * 64 + lane] = a2;
            __syncthreads();
            if (tid < 192 && (tid & 63) < cw) { const int r = tid >> 6, l = tid & 63, n = n0 + l; float s = 0.f;
#pragma unroll
                for (int w8 = 0; w8 < 8; ++w8) s += red[(w8 * 3 + r) * 64 + l];
                const float val = s + a.in[I_ADAB][(size_t)i * (3 * D) + n];
                mod[((size_t)i * 3 + r) * (3 * D) + n] = val;
                if (n >= D && n < 2 * D) { float gsx = a.in[I_NORMG][(size_t)i * D + n - D] * (1.0f + val);
                    if (!(fabsf(gsx) >= 1e-18f)) gsx = gsx < 0.f ? -1e-18f : 1e-18f;
                    ((float*)(ws + WS_GS))[((size_t)i * 3 + r) * D + n - D] = gsx; ((float*)(ws + WS_RGS))[((size_t)i * 3 + r) * D + n - D] = 1.0f / gsx; } }
            __syncthreads();
        }
    }
    if (t.gate_lj >= 0) {
        const float* gw = a.in[I_LGATEW]; v4u* dst = (v4u*)(ws + WS_WGATE);
        for (int f0 = widx * (NWAVES * 64) + tid; f0 < 16 * 2 * 8 * 2 * 16 * 64; f0 += nw * NWAVES * 64) {
            const int f = f0 + (t.gate_lj << 19);
            const int ln = f & 63, ks = (f >> 6) & 15, gate = (f >> 10) & 1, jt = (f >> 11) & 7, dir = (f >> 14) & 1, nb = (f >> 15) & 15, lj = f >> 19;
            const int k0 = ks * 16 + 8 * (ln >> 5), j = jt * 32 + (ln & 31);
            const float* s = gw + ((((size_t)(lj * 2 + dir) * 2 + gate) * 16 + nb) * 256 + k0) * 256 + j;
            v4u o; o.x = pk2(s[0], s[256]); o.y = pk2(s[512], s[768]); o.z = pk2(s[1024], s[1280]); o.w = pk2(s[1536], s[1792]);
            dst[f] = o;
        }
    }
    {
        LAS float* scr = (LAS float*)(lds + wave * 16640);
#ifndef BG_WAVES
#define BG_WAVES 8
#endif
        const int nwv = nw >= 256 ? NWAVES : BG_WAVES;
        const int gw = widx * nwv + wave, NGW = nw * nwv;
#pragma unroll 1
        for (int q = 0; q < 2; ++q) { const int id = q == 0 ? t.tr0 : t.tr1; if (id < 0 || wave >= nwv) continue;
            const int kind = id >> 1, lj = id & 1; const int N = kind == 0 ? 8192 : (kind == 2 ? 16384 : D);
            const float* W = a.in[kind == 0 ? I_LIN : (kind == 1 ? I_LOUT : (kind == 2 ? I_NIN : I_NOUT))] + (size_t)lj * D * N;
            bf16* WT = (bf16*)(ws + (kind == 0 ? WS_WLIN : (kind == 1 ? WS_WLOUT : (kind == 2 ? WS_WNIN : WS_WNOUT)))) + (size_t)lj * N * D;
            const int nitems = 64 * (N / 64);
            const int lay = kind == 0 ? 2 * lj : 2 * lj + 1;
            const float* shift = (kind == 0 || kind == 2) ? (const float*)(ws + WS_MOD) + (size_t)lay * 3 * (3 * D) : nullptr;
            pg8::facc_t* bias2 = (pg8::facc_t*)(ws + CTL_BIAS2) + (size_t)lay * 3 * pg8::NB2;
            f32x4 va[16], vb[16];
            if (gw < nitems) tr_load(W, N, gw, lane, va);
            for (int it = gw; it < nitems; it += 2 * NGW) {
                if (it + NGW < nitems) tr_load(W, N, it + NGW, lane, vb);
                tr_store(WT, D, N, it, lane, scr, va, shift, bias2);
                if (it + 2 * NGW < nitems) tr_load(W, N, it + 2 * NGW, lane, va);
                if (it + NGW < nitems) tr_store(WT, D, N, it + NGW, lane, scr, vb, shift, bias2);
            }
        }
    }
    __syncthreads();
}
constexpr DI int gemm_wgs(int nunits, int G) { const int rounds = (nunits + G - 1) / G; return (nunits + rounds - 1) / rounds; }
#define BG_SPARE(Gg, ...) do { const BgTasks _t = __VA_ARGS__; if ((Gg) >= G) bg_run(args, lds, tid, wave, lane, bx, G, _t); else if (bx >= (Gg)) bg_run(args, lds, tid, wave, lane, bx - (Gg), G - (Gg), _t); } while (0)

DI void prescale_phase(const Args& a, int wave, int lane, int vcu, int G) {
    asm volatile("" : "+v"(lane));
    unsigned char* ws = a.ws;
    const float* gs = (const float*)(ws + WS_GS);
    pg8::facc_t* rowss = (pg8::facc_t*)(ws + CTL_ROWSS);
    bf16* E = (bf16*)(ws + WS_E);
    const int gw = vcu * NWAVES + wave, NGW = G * NWAVES;
    for (int m2 = gw; m2 < MT * NREP(1); m2 += NGW) { const int m = m2 >= MT ? m2 - MT : m2;
        const float* src = m < ML ? a.in[I_X] + (size_t)m * D : a.in[I_CTX] + (size_t)(m - ML) * D;
        const float* g = gs + (size_t)(m < ML ? (m >> 12) : 2) * D;
        const GAS f32x4* xr = (const GAS f32x4*)src + lane;
        GAS v2u* o8 = (GAS v2u*)(E + (size_t)m * D) + lane;
        float s = 0.f;
        f32x4 xv[16], gv[16];
#pragma unroll
        for (int j = 0; j < 16; ++j) xv[j] = xr[64 * j];
#pragma unroll
        for (int j = 0; j < 16; ++j) gv[j] = *((const GAS f32x4*)g + lane + 64 * j);
        asm volatile("" ::: "memory");
#pragma unroll
        for (int j = 0; j < 16; ++j) { const f32x4 v = xv[j]; s += (v[0] * v[0] + v[1] * v[1]) + (v[2] * v[2] + v[3] * v[3]);
            const f32x4 y = v * gv[j];
            v2u w; w.x = pk2(y[0], y[1]); w.y = pk2(y[2], y[3]); o8[64 * j] = w; }
        s = wave_sum(s);
        if (lane == 0) rowss[m] = (pg8::facc_t)(s * pg8::RS_SCALE + 0.5f);
    }
}

DI int rg_rmap(int t) { return ((t >> 4) & 3) * 32 + ((t >> 2) & 3) * 8 + (t >> 6) * 4 + (t & 3); }
template <int PASS, int DIR>
DI void rg_dir(LAS unsigned char* lds, bf16x8 (&bwr)[16], bf16x8 (&bwi)[16], const GAS bf16x8* wpn, const float gbr2, const float gbi2, const float kk2,
               const unsigned abase, const unsigned ubase, GAS unsigned* coef, float& S2, float& h) {
    f32x16 nr, ni;
#pragma unroll
    for (int i = 0; i < 16; ++i) { nr[i] = 0.f; ni[i] = 0.f; }
    { const LAS unsigned char* at = lds + (DIR == 0 ? 0 : 3) * 16384;
#pragma unroll
      for (int ks = 0; ks < 16; ++ks) { const bf16x8 av = *(const LAS bf16x8*)(at + (abase ^ ((unsigned)ks << 5)));
          nr = __builtin_amdgcn_mfma_f32_32x32x16_bf16(av, bwr[ks], nr, 0, 0, 0); ni = __builtin_amdgcn_mfma_f32_32x32x16_bf16(av, bwi[ks], ni, 0, 0, 0); } }
#pragma unroll
    for (int ti = 0; ti < 4; ++ti) {
        const int mt = DIR == 0 ? ti : 3 - ti, mtn = DIR == 0 ? ti + 1 : 2 - ti;
        const f32x16 zr = nr, zi = ni;
        if (ti < 3) {
#pragma unroll
            for (int i = 0; i < 16; ++i) { nr[i] = 0.f; ni[i] = 0.f; } }
        else if (wpn) {
#pragma unroll
            for (int ks = 0; ks < 16; ++ks) { bwr[ks] = wpn[ks * 64]; bwi[ks] = wpn[(16 + ks) * 64]; } }

        const LAS unsigned char* at = lds + mt * 16384; const LAS unsigned char* atn = lds + mtn * 16384;
        v4u cpk;
        bf16x8 avn = *(const LAS bf16x8*)((ti < 3 ? atn : at) + abase);
        unsigned short upn = *(const LAS unsigned short*)(at + (ubase ^ ((unsigned)((((DIR == 0 ? 0 : 15) >> 2) & 1) * 8 + ((DIR == 0 ? 0 : 15) & 3)) << 4)) + ((DIR == 0 ? 0 : 15) >> 2) * 4096 + ((DIR == 0 ? 0 : 15) & 3) * 512);
#pragma unroll
        for (int rr = 0; rr < 16; ++rr) {
            const bf16x8 av = avn; const unsigned short upc = upn;
            if (rr < 15) { if (ti < 3) avn = *(const LAS bf16x8*)(atn + (abase ^ ((unsigned)(rr + 1) << 5)));
                const int r1 = DIR == 0 ? rr + 1 : 14 - rr; const unsigned cr1 = (unsigned)(((r1 >> 2) & 1) * 8 + (r1 & 3));
                upn = *(const LAS unsigned short*)(at + (ubase ^ (cr1 << 4)) + (r1 >> 2) * 4096 + (r1 & 3) * 512); }
            if (ti < 3) { nr = __builtin_amdgcn_mfma_f32_32x32x16_bf16(av, bwr[rr], nr, 0, 0, 0); ni = __builtin_amdgcn_mfma_f32_32x32x16_bf16(av, bwi[rr], ni, 0, 0, 0); }

            const int r = DIR == 0 ? rr : 15 - rr;
            const float up = __uint_as_float((unsigned)upc << 16);
            const float rg = fast_rcp(1.0f + fast_exp2(__builtin_fmaf(zr[r], -LOG2E, gbr2)));
            const float ig = fast_rcp(1.0f + fast_exp2(__builtin_fmaf(zi[r], -LOG2E, gbi2)));
            const float la2 = kk2 * rg, av_ = fast_exp2(la2);
            const float em = __builtin_fmaf(-av_, av_, 1.0f);
            const float bv = __builtin_amdgcn_sqrtf(em) * (ig * up);
            h = __builtin_fmaf(av_, h, bv);
            S2 += la2; cpk[r & 3] = pk2(la2, bv);
            if ((rr & 3) == 3) __builtin_nontemporal_store(cpk, (GAS v4u*)coef + (size_t)(mt * 4 + (r >> 2)) * 512);
#ifndef RG_SB_EVERY
#define RG_SB_EVERY 16
#endif
#ifndef RG_SGB
#define RG_SGB 0
#endif
#if RG_SGB
#ifndef RG_SGP
#define RG_SGP 1
#endif
            if (ti < 3) {
                if (RG_SGP == 1) { __builtin_amdgcn_sched_group_barrier(0x8, 1, 0); __builtin_amdgcn_sched_group_barrier(0x402, RG_SGB, 0);
                                   __builtin_amdgcn_sched_group_barrier(0x8, 1, 0); __builtin_amdgcn_sched_group_barrier(0x402, RG_SGB, 0); __builtin_amdgcn_sched_group_barrier(0x100, 2, 0); }
                if (RG_SGP == 2) { __builtin_amdgcn_sched_group_barrier(0x100, 2, 0); __builtin_amdgcn_sched_group_barrier(0x8, 1, 0); __builtin_amdgcn_sched_group_barrier(0x402, RG_SGB, 0);
                                   __builtin_amdgcn_sched_group_barrier(0x8, 1, 0); __builtin_amdgcn_sched_group_barrier(0x402, RG_SGB, 0); }
                if (RG_SGP == 3) { __builtin_amdgcn_sched_group_barrier(0x8, 2, 0); __builtin_amdgcn_sched_group_barrier(0x402, 2 * RG_SGB, 0); __builtin_amdgcn_sched_group_barrier(0x100, 2, 0); }
                if (RG_SGP == 4) { __builtin_amdgcn_sched_group_barrier(0x8, 1, 0); __builtin_amdgcn_sched_group_barrier(0x402, 6, 0); __builtin_amdgcn_sched_group_barrier(0x100, 1, 0);
                                   __builtin_amdgcn_sched_group_barrier(0x8, 1, 0); __builtin_amdgcn_sched_group_barrier(0x402, 6, 0); __builtin_amdgcn_sched_group_barrier(0x100, 1, 0);
                                   __builtin_amdgcn_sched_group_barrier(0x402, 6, 0); }
            }
#endif
            if ((rr % RG_SB_EVERY) == RG_SB_EVERY - 1) __builtin_amdgcn_sched_barrier(0);
        }
    }
}
#ifndef STAMP_SEL
#define STAMP_SEL 0
#endif
#ifndef STAMP_WG
#define STAMP_WG 0
#endif
#ifndef STAMP_WAVE
#define STAMP_WAVE 0
#endif
#if STAMP_SEL
#define STAMP_T(v) const unsigned long long v = __builtin_amdgcn_s_memtime()
#define STAMP_ACC(k, a, b) do { if (STAMP_SEL == (k) && tid == STAMP_WAVE * 64) *(volatile LAS unsigned*)(lds + MISC_OFF + 80) += (unsigned)((b) - (a)); } while (0)
#else
#define STAMP_T(v) do {} while (0)
#define STAMP_ACC(k, a, b) do {} while (0)
#endif
template <int PASS>
DI void rg_unit(LAS unsigned char* lds, int unit, int lj, const bf16* U, const bf16* Gb, bf16* HS, const float* conv_w, const float* conv_b, const v4u* wgt, const float* gate_b, const float* lam,
                float* agg, const float* carry, unsigned* coefb, int tid, int wave, int lane) {
    asm volatile("" : "+v"(tid), "+v"(lane));
    const int nb = unit / 68, gc = unit - nb * 68, m0 = gc * 128;
    const bool has_left = gc < 64 ? ((gc & 31) != 0) : ((gc & 1) != 0);
    const bool has_right = gc < 64 ? ((gc & 31) != 31) : ((gc & 1) != 1);
#ifndef RG_BWI_EARLY
#define RG_BWI_EARLY 1
#endif
    unsigned lo_ = (unsigned)lane; asm volatile("" : "+v"(lo_));
    const GAS bf16x8* wp0 = (const GAS bf16x8*)wgt + ((((size_t)(lj * 16 + nb) * 2 + 0) * 8 + wave) * 2) * (16 * 64) + lo_;
    const GAS bf16x8* wp1 = wp0 + (size_t)8 * 2 * 16 * 64;
    bf16x8 bwr[16], bwi[16];
#ifndef RG_BWR_PRE
#define RG_BWR_PRE 0
#endif
#pragma unroll
    for (int ks = 0; ks < RG_BWR_PRE; ++ks) bwr[ks] = wp0[ks * 64];
    asm volatile("" ::: "memory");
    STAMP_T(st0);
#ifndef RGP
#define RGP 0
#endif
#if RGP == 1
    int nrepA = 2; asm volatile("" : "+s"(nrepA));
#pragma unroll 1
    for (int repA = 0; repA < nrepA; ++repA)
#endif
    {
        asm volatile("" ::: "memory");
        const int cg = tid & 31, run = tid >> 5, ch0 = nb * 256 + cg * 8;
        float xin[11][8];
#pragma unroll
        for (int rr = 0; rr < 11; ++rr) { const int lr = run * 8 - 2 + rr; const bool valid = (lr >= 0 || has_left) && (lr < 128 || has_right);
            v4u raw = (v4u){0u, 0u, 0u, 0u}; if (valid) raw = *(const GAS v4u*)(U + (size_t)(m0 + lr) * D + ch0);
            xin[rr][0] = bflo(raw.x); xin[rr][1] = bfhi(raw.x); xin[rr][2] = bflo(raw.y); xin[rr][3] = bfhi(raw.y); xin[rr][4] = bflo(raw.z); xin[rr][5] = bfhi(raw.z); xin[rr][6] = bflo(raw.w); xin[rr][7] = bfhi(raw.w); }
        float cw[4][8], cb[8];
#pragma unroll
        for (int k = 0; k < 4; ++k) { const f32x4 w0 = *(const GAS f32x4*)(conv_w + ((size_t)lj * 4 + k) * D + ch0), w1 = *(const GAS f32x4*)(conv_w + ((size_t)lj * 4 + k) * D + ch0 + 4);
#pragma unroll
            for (int e = 0; e < 4; ++e) { cw[k][e] = w0[e]; cw[k][4 + e] = w1[e]; } }
        { const f32x4 b0 = *(const GAS f32x4*)(conv_b + (size_t)lj * D + ch0), b1 = *(const GAS f32x4*)(conv_b + (size_t)lj * D + ch0 + 4);
#pragma unroll
          for (int e = 0; e < 4; ++e) { cb[e] = b0[e]; cb[4 + e] = b1[e]; } }
#pragma unroll
        for (int ks = RG_BWR_PRE; ks < 16; ++ks) bwr[ks] = wp0[ks * 64];
#pragma unroll
        for (int tt = 0; tt < 8; ++tt) { float o[8];
#pragma unroll
            for (int e = 0; e < 8; ++e) { float sacc = cb[e];
#pragma unroll
                for (int k = 0; k < 4; ++k) sacc += cw[k][e] * xin[tt + k][e];
                o[e] = sacc; }
            v4u w; w.x = pk2(o[0], o[1]); w.y = pk2(o[2], o[3]); w.z = pk2(o[4], o[5]); w.w = pk2(o[6], o[7]);
            const int R = rg_rmap(run * 8 + tt);
            *(LAS v4u*)(lds + R * 512 + ((cg ^ (R & 15)) << 4)) = w;
#if RG_BWI_EARLY
            if (tt == 3) { asm volatile("" ::: "memory");
#pragma unroll
                for (int ks = 0; ks < 8; ++ks) bwi[ks] = wp0[(16 + ks) * 64]; asm volatile("" ::: "memory"); }
            if (tt == 6) { asm volatile("" ::: "memory");
#pragma unroll
                for (int ks = 8; ks < 16; ++ks) bwi[ks] = wp0[(16 + ks) * 64]; asm volatile("" ::: "memory"); }
#endif
        }
    }
    STAMP_T(st1); STAMP_ACC(1, st0, st1);
    asm volatile("" ::: "memory");
#if !RG_BWI_EARLY
#pragma unroll
    for (int ks = 0; ks < 16; ++ks) bwi[ks] = wp0[(16 + ks) * 64];
#endif
#if RGP == 2
    asm volatile("s_waitcnt vmcnt(0)" ::: "memory");
#pragma unroll
    for (int ks = 0; ks < 16; ++ks) { asm volatile("" : "+v"(bwr[ks]), "+v"(bwi[ks])); }
    { const GAS bf16x8* wq = wp0; asm volatile("" : "+v"(wq));
#pragma unroll
    for (int ks = 0; ks < 16; ++ks) { bwr[ks] = wq[ks * 64]; bwi[ks] = wq[(16 + ks) * 64]; } }
#endif
    LDS_WAIT(); __syncthreads();
    STAMP_T(st2); STAMP_ACC(2, st1, st2);
#if STAMP_SEL == 6
    asm volatile("s_waitcnt vmcnt(0)" ::: "memory");
    STAMP_T(st2b); STAMP_ACC(6, st2, st2b);
#endif
#if RG_SETPRIO
    if (wave < 4) __builtin_amdgcn_s_setprio(1);
#endif
    const unsigned c_ = lo_ & 31u, hh_ = lo_ >> 5, chl_ = (unsigned)wave * 32u + c_;
    const int ch = nb * 256 + (int)chl_, sc = gc * 2 + (int)hh_;
    const unsigned abase = c_ * 512u + ((hh_ ^ (c_ & 15u)) << 4);
    const unsigned ubase = hh_ * 2048u + ((((chl_ >> 3) ^ (hh_ << 2))) << 4) + (chl_ & 7u) * 2u;
    LAS unsigned short* hst = (LAS unsigned short*)(lds + 65536) + chl_ + hh_ * (64 * 256);
    {
        const float gbr2 = -LOG2E * gate_b[((size_t)(lj * 2 + 0) * 2 + 0) * D + ch], gbi2 = -LOG2E * gate_b[((size_t)(lj * 2 + 0) * 2 + 1) * D + ch];
        const float kk2 = -8.0f * LOG2E * log1pf(__expf(-lam[(size_t)(lj * 2 + 0) * D + ch]));
        float S2 = 0.f, h = PASS == 2 ? carry[(size_t)(sc * 2 + 0) * D + ch] : 0.f;
        rg_dir<PASS, 0>(lds, bwr, bwi, wp1, gbr2, gbi2, kk2, abase, ubase, (GAS unsigned*)coefb + ((size_t)unit * 2 + 0) * 64 * 512 + (wave * 64 + lo_) * 4, S2, h);
        if (PASS == 1) { float* ap = agg + ((size_t)(sc * 2 + 0) * 2) * D + ch; ap[0] = fast_exp2(S2); ap[D] = h; }
    }
    __builtin_amdgcn_sched_barrier(0);
    STAMP_T(st3); STAMP_ACC(3, st2, st3);
    {
        const float gbr2 = -LOG2E * gate_b[((size_t)(lj * 2 + 1) * 2 + 0) * D + ch], gbi2 = -LOG2E * gate_b[((size_t)(lj * 2 + 1) * 2 + 1) * D + ch];
        const float kk2 = -8.0f * LOG2E * log1pf(__expf(-lam[(size_t)(lj * 2 + 1) * D + ch]));
        float S2 = 0.f, h = PASS == 2 ? carry[(size_t)(sc * 2 + 1) * D + ch] : 0.f;
        rg_dir<PASS, 1>(lds, bwr, bwi, (const GAS bf16x8*)nullptr, gbr2, gbi2, kk2, abase, ubase, (GAS unsigned*)coefb + ((size_t)unit * 2 + 1) * 64 * 512 + (wave * 64 + lo_) * 4, S2, h);
        if (PASS == 1) { float* ap = agg + ((size_t)(sc * 2 + 1) * 2) * D + ch; ap[0] = fast_exp2(S2); ap[D] = h; }
    }
    __builtin_amdgcn_s_setprio(0);
    STAMP_T(st4); STAMP_ACC(4, st3, st4);
    if (PASS == 2) {
        LDS_WAIT(); __syncthreads();
        int tid2 = tid; asm volatile("" : "+v"(tid2));
        const int cg = tid2 & 31, run = tid2 >> 5, ch0 = nb * 256 + cg * 8;
#pragma unroll
        for (int tt = 0; tt < 8; ++tt) { const int t = run * 8 + tt;
            const v4u hv = *(const LAS v4u*)(lds + 65536 + t * 512 + cg * 16); const v4u gv = *(const GAS v4u*)(Gb + (size_t)(m0 + t) * D + ch0);
            v4u o; o.x = pk2(bflo(hv.x) * bflo(gv.x), bfhi(hv.x) * bfhi(gv.x)); o.y = pk2(bflo(hv.y) * bflo(gv.y), bfhi(hv.y) * bfhi(gv.y));
            o.z = pk2(bflo(hv.z) * bflo(gv.z), bfhi(hv.z) * bfhi(gv.z)); o.w = pk2(bflo(hv.w) * bflo(gv.w), bfhi(hv.w) * bfhi(gv.w));
            *(GAS v4u*)(HS + (size_t)(m0 + t) * D + ch0) = o; }
    }
    LDS_WAIT(); __syncthreads();
    STAMP_T(st5); STAMP_ACC(5, st4, st5); STAMP_ACC(9, st0, st5);
}
DI void rg_unit2(int unit, const bf16* __restrict__ Gb, bf16* __restrict__ HS, const float* __restrict__ carry, const unsigned* __restrict__ coefb, int wave, int lane) {
    asm volatile("" : "+v"(lane));
    const int nb = unit / 68, gc = unit - nb * 68;
    const int hh = wave >> 2, chl = (wave & 3) * 64 + lane, ch = nb * 256 + chl, sc = gc * 2 + hh;
    const GAS v4u* cf = (const GAS v4u*)coefb + (size_t)unit * 2 * 16 * 512 + (chl >> 5) * 64 + hh * 32 + (chl & 31);
    const size_t row0 = (size_t)(gc * 128 + hh * 64) * D + ch;
    float hf[64];
    const GAS v4u* cb = cf + (size_t)16 * 512;
    unsigned wa[16], wb[16]; unsigned short ga[16], gb[16];
#define P2_LOADF(WV, t0) do { _Pragma("unroll") for (int j = 0; j < 4; ++j) { const v4u _q = __builtin_nontemporal_load(cf + (size_t)((t0) / 4 + j) * 512); WV[4 * j] = _q[0]; WV[4 * j + 1] = _q[1]; WV[4 * j + 2] = _q[2]; WV[4 * j + 3] = _q[3]; } } while (0)
#define P2_LOADB(WV, gq, t0) do { _Pragma("unroll") for (int j = 0; j < 4; ++j) { const v4u _q = __builtin_nontemporal_load(cb + (size_t)((t0) / 4 + j) * 512); WV[4 * j] = _q[0]; WV[4 * j + 1] = _q[1]; WV[4 * j + 2] = _q[2]; WV[4 * j + 3] = _q[3]; } \
        _Pragma("unroll") for (int j = 0; j < 16; ++j) gq[j] = *(const GAS unsigned short*)(Gb + row0 + (size_t)((t0) + j) * D); } while (0)
#define P2_FWD(w, t0) do { _Pragma("unroll") for (int j = 0; j < 16; ++j) { h = __builtin_fmaf(fast_exp2(bflo(w[j])), h, bfhi(w[j])); hf[(t0) + j] = h; } } while (0)
#define P2_BWD(w, gq, t0) do { _Pragma("unroll") for (int j = 15; j >= 0; --j) { h = __builtin_fmaf(fast_exp2(bflo(w[j])), h, bfhi(w[j])); \
        *(GAS unsigned short*)(HS + row0 + (size_t)((t0) + j) * D) = (unsigned short)(pk2((hf[(t0) + j] + h) * __uint_as_float((unsigned)gq[j] << 16), 0.f) & 0xffffu); } } while (0)
    float h = carry[(size_t)(sc * 2 + 0) * D + ch]; const float hb0 = carry[(size_t)(sc * 2 + 1) * D + ch];
    P2_LOADF(wa, 0); P2_LOADF(wb, 16); P2_FWD(wa, 0); P2_LOADF(wa, 32); P2_FWD(wb, 16); P2_LOADF(wb, 48); P2_FWD(wa, 32); P2_LOADB(wa, ga, 48); P2_FWD(wb, 48);
    h = hb0;
    P2_LOADB(wb, gb, 32); asm volatile("" ::: "memory"); P2_BWD(wa, ga, 48); P2_LOADB(wa, ga, 16); asm volatile("" ::: "memory"); P2_BWD(wb, gb, 32);
    P2_LOADB(wb, gb, 0); asm volatile("" ::: "memory"); P2_BWD(wa, ga, 16); asm volatile("" ::: "memory"); P2_BWD(wb, gb, 0);
#undef P2_LOADF
#undef P2_LOADB
#undef P2_FWD
#undef P2_BWD
}
DI void rg_carry(LAS unsigned char* lds, int item, const float* agg, float* carry, int tid, int wave, int lane) {
    asm volatile("" : "+v"(tid), "+v"(lane));
    const int b = item >> 7, d = (item >> 6) & 1, ch = (item & 63) * 64 + lane;
    float A[9], H[9]; int scs[9];
#pragma unroll
    for (int e9 = 0; e9 < 9; ++e9) { const int e0 = wave * 9 + e9; const bool valid = e0 < 68; const int e = valid ? e0 : 67;
        const int sq = d == 0 ? (e < 4 ? 128 + b * 4 + e : b * 64 + (e - 4)) : (e < 4 ? 128 + b * 4 + 3 - e : b * 64 + 63 - (e - 4));
        scs[e9] = valid ? sq : -1;
        const GAS float* ap = (const GAS float*)agg + ((size_t)(sq * 2 + d) * 2) * D + ch; A[e9] = ap[0]; H[e9] = ap[D]; }
    asm volatile("" : "+v"(A[0]), "+v"(A[1]), "+v"(A[2]), "+v"(A[3]), "+v"(A[4]), "+v"(A[5]), "+v"(A[6]), "+v"(A[7]), "+v"(A[8]),
                      "+v"(H[0]), "+v"(H[1]), "+v"(H[2]), "+v"(H[3]), "+v"(H[4]), "+v"(H[5]), "+v"(H[6]), "+v"(H[7]), "+v"(H[8]));
#pragma unroll
    for (int e9 = 0; e9 < 9; ++e9) if (scs[e9] < 0) { A[e9] = 1.f; H[e9] = 0.f; }
    float Ac = 1.f, Hc = 0.f;
#pragma unroll
    for (int e9 = 0; e9 < 9; ++e9) { Hc = A[e9] * Hc + H[e9]; Ac *= A[e9]; }
    LAS float* comp = (LAS float*)lds;
    comp[(wave * 64 + lane) * 2 + 0] = Ac; comp[(wave * 64 + lane) * 2 + 1] = Hc;
    LDS_WAIT(); __syncthreads();
    float h = 0.f;
    for (int w2 = 0; w2 < wave; ++w2) h = comp[(w2 * 64 + lane) * 2 + 0] * h + comp[(w2 * 64 + lane) * 2 + 1];
#pragma unroll
    for (int e9 = 0; e9 < 9; ++e9) { if (scs[e9] >= 0) carry[(size_t)(scs[e9] * 2 + d) * D + ch] = h; h = A[e9] * h + H[e9]; }
    LDS_WAIT(); __syncthreads();
}

DI unsigned off_b(unsigned row, unsigned ch) { return 256u * row + 16u * (ch ^ (((row & 3u) << 2) | ((row >> 2) & 3u))); }
DI int clampi(int v, int lo, int hi) { return v < lo ? lo : (v > hi ? hi : v); }
constexpr int VT_DT = 3104, VT_KG = 384, TILE_BUF = 8 * VT_DT;
DI unsigned off_v(unsigned row, unsigned ch) { return (ch >> 1) * VT_DT + (row >> 3) * VT_KG + (row & 7u) * 32u + (ch & 1u) * 16u; }
#define TRS(n) "ds_read_b64_tr_b16 %" #n ", %16 offset:"
DI void tr_read16(s16x4 (&o)[16], unsigned a) {
    asm volatile(TRS(0) "0\n\t" TRS(1) "128\n\t" TRS(2) "3104\n\t" TRS(3) "3232\n\t" TRS(4) "6208\n\t" TRS(5) "6336\n\t" TRS(6) "9312\n\t" TRS(7) "9440\n\t"
                 TRS(8) "12416\n\t" TRS(9) "12544\n\t" TRS(10) "15520\n\t" TRS(11) "15648\n\t" TRS(12) "18624\n\t" TRS(13) "18752\n\t" TRS(14) "21728\n\t" TRS(15) "21856\n\t"
                 "s_waitcnt lgkmcnt(0)"
                 : "=&v"(o[0]), "=&v"(o[1]), "=&v"(o[2]), "=&v"(o[3]), "=&v"(o[4]), "=&v"(o[5]), "=&v"(o[6]), "=&v"(o[7]),
                   "=&v"(o[8]), "=&v"(o[9]), "=&v"(o[10]), "=&v"(o[11]), "=&v"(o[12]), "=&v"(o[13]), "=&v"(o[14]), "=&v"(o[15])
                 : "v"(a) : "memory");
}
DI void tr_issue16(s16x4 (&o)[16], unsigned a) {
    asm volatile(TRS(0) "0\n\t" TRS(1) "128\n\t" TRS(2) "3104\n\t" TRS(3) "3232\n\t" TRS(4) "6208\n\t" TRS(5) "6336\n\t" TRS(6) "9312\n\t" TRS(7) "9440\n\t"
                 TRS(8) "12416\n\t" TRS(9) "12544\n\t" TRS(10) "15520\n\t" TRS(11) "15648\n\t" TRS(12) "18624\n\t" TRS(13) "18752\n\t" TRS(14) "21728\n\t" TRS(15) "21856"
                 : "=&v"(o[0]), "=&v"(o[1]), "=&v"(o[2]), "=&v"(o[3]), "=&v"(o[4]), "=&v"(o[5]), "=&v"(o[6]), "=&v"(o[7]),
                   "=&v"(o[8]), "=&v"(o[9]), "=&v"(o[10]), "=&v"(o[11]), "=&v"(o[12]), "=&v"(o[13]), "=&v"(o[14]), "=&v"(o[15])
                 : "v"(a) : "memory");
}
#undef TRS
DI void lds_read8(bf16x8 (&o)[8], unsigned a0, unsigned a1, unsigned a2, unsigned a3, unsigned a4, unsigned a5, unsigned a6, unsigned a7) {
    asm volatile("ds_read_b128 %0, %8\n\tds_read_b128 %1, %9\n\tds_read_b128 %2, %10\n\tds_read_b128 %3, %11\n\tds_read_b128 %4, %12\n\tds_read_b128 %5, %13\n\tds_read_b128 %6, %14\n\tds_read_b128 %7, %15\n\ts_waitcnt lgkmcnt(0)"
                 : "=&v"(o[0]), "=&v"(o[1]), "=&v"(o[2]), "=&v"(o[3]), "=&v"(o[4]), "=&v"(o[5]), "=&v"(o[6]), "=&v"(o[7])
                 : "v"(a0), "v"(a1), "v"(a2), "v"(a3), "v"(a4), "v"(a5), "v"(a6), "v"(a7) : "memory");
}
constexpr int ATT_BUF = 16384 + TILE_BUF;
constexpr float ATT_THR = 10.0f;
#ifndef ATT_PROBE
#define ATT_PROBE 0
#endif
DI void lds_bias16(float (&o0)[8], float (&o1)[8], unsigned a0, unsigned a1, unsigned a2, unsigned a3, unsigned a4, unsigned a5, unsigned a6, unsigned a7) {
    asm volatile("ds_read_b32 %0, %16 offset:128\n\tds_read_b32 %1, %17 offset:128\n\tds_read_b32 %2, %18 offset:128\n\tds_read_b32 %3, %19 offset:128\n\t"
                 "ds_read_b32 %4, %20 offset:128\n\tds_read_b32 %5, %21 offset:128\n\tds_read_b32 %6, %22 offset:128\n\tds_read_b32 %7, %23 offset:128\n\t"
                 "ds_read_b32 %8, %16\n\tds_read_b32 %9, %17\n\tds_read_b32 %10, %18\n\tds_read_b32 %11, %19\n\t"
                 "ds_read_b32 %12, %20\n\tds_read_b32 %13, %21\n\tds_read_b32 %14, %22\n\tds_read_b32 %15, %23\n\ts_waitcnt lgkmcnt(0)"
                 : "=&v"(o0[0]), "=&v"(o0[1]), "=&v"(o0[2]), "=&v"(o0[3]), "=&v"(o0[4]), "=&v"(o0[5]), "=&v"(o0[6]), "=&v"(o0[7]),
                   "=&v"(o1[0]), "=&v"(o1[1]), "=&v"(o1[2]), "=&v"(o1[3]), "=&v"(o1[4]), "=&v"(o1[5]), "=&v"(o1[6]), "=&v"(o1[7])
                 : "v"(a0), "v"(a1), "v"(a2), "v"(a3), "v"(a4), "v"(a5), "v"(a6), "v"(a7) : "memory");
}
template <bool MASKED>
DI void att_softmax(f32x4 (&S)[2], const float (&bv)[8], const float (&madd)[2][4], const bool rowok, float& m, float& l, f32x4 (&O)[8], v4u& P) {
    float v[2][4]; float lm = -__builtin_inff();
#pragma unroll
    for (int t = 0; t < 2; ++t)
#pragma unroll
        for (int r = 0; r < 4; ++r) { v[t][r] = MASKED ? __builtin_fmaf(S[t][r], ATTN_C1, rowok ? bv[t * 4 + r] + madd[t][r] : -__builtin_inff()) : S[t][r] * ATTN_C1; lm = fmaxf(lm, v[t][r]); }
    if (__any(lm > m + ATT_THR)) {
        const float mx = pg8::xrow16_max(lm);
        const float mn = fmaxf(m, mx), alpha = fast_exp2(m - mn);
#pragma unroll
        for (int dt = 0; dt < 8; ++dt) O[dt] = O[dt] * alpha;
        l *= alpha; m = mn;
    }
    float p[2][4];
#pragma unroll
    for (int t = 0; t < 2; ++t)
#pragma unroll
        for (int r = 0; r < 4; ++r) { p[t][r] = fast_exp2(v[t][r] - m); l += p[t][r]; }
    P.x = pk2(p[0][0], p[0][1]); P.y = pk2(p[0][2], p[0][3]); P.z = pk2(p[1][0], p[1][1]); P.w = pk2(p[1][2], p[1][3]);
}
#ifndef ATT_PRIO
#define ATT_PRIO 1
#endif
#define ATT_PRIO_UP() do { if (ATT_PRIO) __builtin_amdgcn_s_setprio(1); } while (0)
#define ATT_PRIO_DN() do { if (ATT_PRIO) __builtin_amdgcn_s_setprio(0); } while (0)
DI void attn_unit(LAS unsigned char* lds, int unit, const bf16* Qb, const bf16* Kb, const bf16* Vb, const bf16* Gb, bf16* Ob, const float* rpb, int tid, int wave, int lane) {
    asm volatile("" : "+v"(tid), "+v"(lane));
    const bool lat = unit < 1024;
    int b, hd, R0 = 0;
    if (lat) { b = unit >> 9; hd = (unit >> 4) & 31; R0 = (unit & 15) * 4; } else { const int u2 = unit - 1024; b = u2 >> 5; hd = u2 & 31; }
    const int n = wave & 3, rp = wave >> 2, ql = lane & 15, g = lane >> 4;
    const int rw0 = R0 + 2 * rp;
    int qtok[2];
#pragma unroll
    for (int j = 0; j < 2; ++j) qtok[j] = lat ? b * SEQ + (rw0 + j) * 64 + n * 16 + ql : ML + b * CTXL + (2 * rp + j) * 64 + n * 16 + ql;
    const int rs0 = clampi(R0 - 4, 0, 56);
    const int rot = (11 - rs0 % 11) % 11;
    const int bs = n == 0 ? 0 : (n == 1 ? 8 : (n == 2 ? 24 : 32));
    const int qc = n * 16 + ql, qcs = clampi(qc - 8, 0, 48);
    LAS unsigned char* rpbL = lds + 2 * ATT_BUF;
    bf16x8 qf[2][4];
#pragma unroll
    for (int j = 0; j < 2; ++j)
#pragma unroll
        for (int ks = 0; ks < 4; ++ks) qf[j][ks] = *(const GAS bf16x8*)(Qb + (size_t)qtok[j] * D + hd * HDIM + ks * 32 + 8 * g);
    if (lat) for (int i = tid; i < 15 * 31; i += NWAVES * 64) { const int r1 = i / 31, c1 = i - r1 * 31; ((LAS float*)rpbL)[r1 * 32 + c1] = rpb[((size_t)hd * 15 + r1) * 31 + c1] * LOG2E; }
    float madd[2][4]; unsigned bptr[2][4];
#pragma unroll
    for (int t = 0; t < 2; ++t)
#pragma unroll
        for (int r = 0; r < 4; ++r) { const int kc = bs + 8 * g + 4 * t + r; madd[t][r] = (kc >= qcs && kc < qcs + 16) ? 0.f : -__builtin_inff();
            bptr[t][r] = (unsigned)(size_t)rpbL + (unsigned)(((rs0 - rw0 + 7) * 32 + clampi(kc - qc + 15, 0, 30)) * 4); }
    const int crow = tid >> 4, cch = tid & 15;
    const unsigned stK0 = off_b(crow, cch), stK1 = off_b(crow + 32, cch), stV0 = 16384u + off_v(crow, cch), stV1 = 16384u + off_v(crow + 32, cch);
#define TILE_LOAD(st, p) do { const int _s = (st); size_t _t0; if (_s < 11) { int _l = _s + rot; _l = _l >= 11 ? _l - 11 : _l; const int _kr = (rs0 + _l) > 63 ? 63 : (rs0 + _l); _t0 = ((size_t)(b * NHEAD + hd) * SEQ + _kr * 64) * HDIM; } else _t0 = pg8::HM_CTX + ((size_t)(b * NHEAD + hd) * CTXL + (_s - 11) * 64) * HDIM; \
        const size_t _o0 = _t0 + (size_t)tid * 8, _o1 = _o0 + (size_t)32 * HDIM;     \
        p[0] = *(const GAS v4u*)(Kb + _o0); p[1] = *(const GAS v4u*)(Kb + _o1); p[2] = *(const GAS v4u*)(Vb + _o0); p[3] = *(const GAS v4u*)(Vb + _o1); } while (0)
#define TILE_STORE(st, p) do { LAS unsigned char* _b = lds + ((st) & 1) * ATT_BUF; *(LAS v4u*)(_b + stK0) = p[0]; *(LAS v4u*)(_b + stK1) = p[1]; *(LAS v4u*)(_b + stV0) = p[2]; *(LAS v4u*)(_b + stV1) = p[3]; } while (0)
    v4u PF[4];
    if (lat) { TILE_LOAD(0, PF); TILE_STORE(0, PF); TILE_LOAD(1, PF); }
    else { TILE_LOAD(11, PF); TILE_STORE(11, PF); TILE_LOAD(12, PF); }
    f32x4 O[2][8];
#pragma unroll
    for (int j = 0; j < 2; ++j)
#pragma unroll
        for (int dt = 0; dt < 8; ++dt) O[j][dt] = (f32x4){0.f, 0.f, 0.f, 0.f};
    float mrun[2] = {-1e30f, -1e30f}, lrun[2] = {0.f, 0.f};
    unsigned kb_lat[2], kb_ctx[2][2];
#pragma unroll
    for (int t = 0; t < 2; ++t) { kb_lat[t] = off_b((unsigned)(bs + 8 * (ql >> 2) + 4 * t + (ql & 3)), (unsigned)g);
#pragma unroll
        for (int pp = 0; pp < 2; ++pp) kb_ctx[pp][t] = off_b((unsigned)(32 * pp + 8 * (ql >> 2) + 4 * t + (ql & 3)), (unsigned)g); }
    const unsigned ldsb = (unsigned)(size_t)lds;
    const unsigned vlane = 16384u + (unsigned)(g * VT_KG + (ql >> 2) * 32 + (lane & 3) * 8);
    if (lat) {
#pragma unroll
        for (int st = 0; st < 11; ++st) {
            LDS_WAIT(); __syncthreads();
            TILE_STORE(st + 1, PF); TILE_LOAD(st + 2, PF);
            int sts = st + rot; sts = sts >= 11 ? sts - 11 : sts;
            const int kr = rs0 + sts;
            const bool ok0 = kr >= clampi(rw0 - 4, 0, 56) && kr < clampi(rw0 - 4, 0, 56) + 8, ok1 = kr >= clampi(rw0 - 3, 0, 56) && kr < clampi(rw0 - 3, 0, 56) + 8;
            if (ok0 || ok1) {
                const unsigned kbuf = ldsb + (unsigned)(st & 1) * ATT_BUF;
                bf16x8 kf[8];
                lds_read8(kf, kbuf + kb_lat[0], kbuf + (kb_lat[0] ^ 64u), kbuf + (kb_lat[0] ^ 128u), kbuf + (kb_lat[0] ^ 192u), kbuf + kb_lat[1], kbuf + (kb_lat[1] ^ 64u), kbuf + (kb_lat[1] ^ 128u), kbuf + (kb_lat[1] ^ 192u));
                f32x4 S0[2], S1[2];
#if ATT_PROBE == 2
                for (int rep_ = 0; rep_ < 2; ++rep_) { asm volatile("" ::: "memory");
                lds_read8(kf, kbuf + kb_lat[0], kbuf + (kb_lat[0] ^ 64u), kbuf + (kb_lat[0] ^ 128u), kbuf + (kb_lat[0] ^ 192u), kbuf + kb_lat[1], kbuf + (kb_lat[1] ^ 64u), kbuf + (kb_lat[1] ^ 128u), kbuf + (kb_lat[1] ^ 192u));
#endif
                ATT_PRIO_UP();
#pragma unroll
                for (int t = 0; t < 2; ++t) { f32x4 a0 = (f32x4){0.f, 0.f, 0.f, 0.f}, a1 = (f32x4){0.f, 0.f, 0.f, 0.f};
#pragma unroll
                    for (int ks = 0; ks < 4; ++ks) { a0 = __builtin_amdgcn_mfma_f32_16x16x32_bf16(kf[t * 4 + ks], qf[0][ks], a0, 0, 0, 0); a1 = __builtin_amdgcn_mfma_f32_16x16x32_bf16(kf[t * 4 + ks], qf[1][ks], a1, 0, 0, 0); }
                    S0[t] = a0; S1[t] = a1; }
                ATT_PRIO_DN();
#if ATT_PROBE == 2
                asm volatile("" : "+v"(S0[0]), "+v"(S0[1]), "+v"(S1[0]), "+v"(S1[1])); }
#endif
                v4u P0, P1;
                s16x4 o[16];
                tr_issue16(o, ldsb + (unsigned)(st & 1) * ATT_BUF + vlane + (unsigned)(bs >> 3) * VT_KG);
                float bv0[8], bv1[8];
                { const unsigned bo = (unsigned)((sts - 1) * 128);
                  lds_bias16(bv0, bv1, bptr[0][0] + bo, bptr[0][1] + bo, bptr[0][2] + bo, bptr[0][3] + bo, bptr[1][0] + bo, bptr[1][1] + bo, bptr[1][2] + bo, bptr[1][3] + bo); }
                att_softmax<true>(S0, bv0, madd, ok0, mrun[0], lrun[0], O[0], P0);
                att_softmax<true>(S1, bv1, madd, ok1, mrun[1], lrun[1], O[1], P1);
                const bf16x8 p0 = __builtin_bit_cast(bf16x8, P0), p1 = __builtin_bit_cast(bf16x8, P1);
                ATT_PRIO_UP();
#pragma unroll
                for (int dt = 0; dt < 8; ++dt) { const bf16x8 vf = __builtin_shufflevector(o[2 * dt], o[2 * dt + 1], 0, 1, 2, 3, 4, 5, 6, 7);
                    O[0][dt] = __builtin_amdgcn_mfma_f32_16x16x32_bf16(vf, p0, O[0][dt], 0, 0, 0);
                    O[1][dt] = __builtin_amdgcn_mfma_f32_16x16x32_bf16(vf, p1, O[1][dt], 0, 0, 0); }
                ATT_PRIO_DN();
            }
        }
    }
#pragma unroll
    for (int st = 11; st < 15; ++st) {
        LDS_WAIT(); __syncthreads();
        if (st + 1 < 15) { TILE_STORE(st + 1, PF); if (st + 2 < 15) TILE_LOAD(st + 2, PF); }
        const unsigned kbuf = ldsb + (unsigned)(st & 1) * ATT_BUF;
#pragma unroll
        for (int pp = 0; pp < 2; ++pp) {
            bf16x8 kf[8];
            lds_read8(kf, kbuf + kb_ctx[pp][0], kbuf + (kb_ctx[pp][0] ^ 64u), kbuf + (kb_ctx[pp][0] ^ 128u), kbuf + (kb_ctx[pp][0] ^ 192u), kbuf + kb_ctx[pp][1], kbuf + (kb_ctx[pp][1] ^ 64u), kbuf + (kb_ctx[pp][1] ^ 128u), kbuf + (kb_ctx[pp][1] ^ 192u));
            f32x4 S0[2], S1[2];
            ATT_PRIO_UP();
#pragma unroll
            for (int t = 0; t < 2; ++t) { f32x4 a0 = (f32x4){0.f, 0.f, 0.f, 0.f}, a1 = (f32x4){0.f, 0.f, 0.f, 0.f};
#pragma unroll
                for (int ks = 0; ks < 4; ++ks) { a0 = __builtin_amdgcn_mfma_f32_16x16x32_bf16(kf[t * 4 + ks], qf[0][ks], a0, 0, 0, 0); a1 = __builtin_amdgcn_mfma_f32_16x16x32_bf16(kf[t * 4 + ks], qf[1][ks], a1, 0, 0, 0); }
                S0[t] = a0; S1[t] = a1; }
            ATT_PRIO_DN();
            v4u P0, P1;
            const float bvz[8] = {0.f, 0.f, 0.f, 0.f, 0.f, 0.f, 0.f, 0.f};
            att_softmax<false>(S0, bvz, madd, true, mrun[0], lrun[0], O[0], P0);
            att_softmax<false>(S1, bvz, madd, true, mrun[1], lrun[1], O[1], P1);
            s16x4 o[16];
            tr_read16(o, ldsb + (unsigned)(st & 1) * ATT_BUF + vlane + (unsigned)(4 * pp) * VT_KG);
            const bf16x8 p0 = __builtin_bit_cast(bf16x8, P0), p1 = __builtin_bit_cast(bf16x8, P1);
            ATT_PRIO_UP();
#pragma unroll
            for (int dt = 0; dt < 8; ++dt) { const bf16x8 vf = __builtin_shufflevector(o[2 * dt], o[2 * dt + 1], 0, 1, 2, 3, 4, 5, 6, 7);
                O[0][dt] = __builtin_amdgcn_mfma_f32_16x16x32_bf16(vf, p0, O[0][dt], 0, 0, 0);
                O[1][dt] = __builtin_amdgcn_mfma_f32_16x16x32_bf16(vf, p1, O[1][dt], 0, 0, 0); }
            ATT_PRIO_DN();
        }
    }
#undef TILE_LOAD
#undef TILE_STORE
    v4u gvs[2][4];
#pragma unroll
    for (int j = 0; j < 2; ++j)
#pragma unroll
        for (int dp = 0; dp < 4; ++dp) gvs[j][dp] = *(const GAS v4u*)(Gb + (size_t)qtok[j] * D + hd * HDIM + 16 * (g & 1) + 8 * (g >> 1) + dp * 32);
    asm volatile("" ::: "memory");
#pragma unroll
    for (int j = 0; j < 2; ++j) {
        const float l1 = pg8::xrow16_sum(lrun[j]);
        const float inv = fast_rcp(l1);
        const size_t rowoff = (size_t)qtok[j] * D + hd * HDIM + 16 * (g & 1) + 8 * (g >> 1);
#pragma unroll
        for (int dp = 0; dp < 4; ++dp) {
            float na[4], nb[4];
#pragma unroll
            for (int c = 0; c < 4; ++c) { const auto r = __builtin_amdgcn_permlane16_swap(__float_as_uint(O[j][2 * dp][c]), __float_as_uint(O[j][2 * dp + 1][c]), false, false);
                na[c] = __uint_as_float(r[0]); nb[c] = __uint_as_float(r[1]); }
            const size_t off = rowoff + dp * 32;
            const v4u gv = gvs[j][dp];
            v4u w; w.x = pk2(na[0] * inv * bflo(gv.x), na[1] * inv * bfhi(gv.x)); w.y = pk2(na[2] * inv * bflo(gv.y), na[3] * inv * bfhi(gv.y));
            w.z = pk2(nb[0] * inv * bflo(gv.z), nb[1] * inv * bfhi(gv.z)); w.w = pk2(nb[2] * inv * bflo(gv.w), nb[3] * inv * bfhi(gv.w));
            *(GAS v4u*)(Ob + off) = w; }
    }
    __syncthreads();
}

__global__ void __launch_bounds__(NWAVES * 64, 2) mega_fwd(Args args) {
    extern __shared__ __attribute__((aligned(16))) unsigned char lds_raw[];
    LAS unsigned char* lds = (LAS unsigned char*)lds_raw;
    volatile LAS unsigned* MISC = (volatile LAS unsigned*)(lds + MISC_OFF);
    const int tid = threadIdx.x, lane = tid & 63, wave = __builtin_amdgcn_readfirstlane(tid >> 6);
    constexpr int G = 256;
    const int bx = blockIdx.x; const int vcu = (bx % 8) * (G / 8) + bx / 8;
    unsigned char* ws = args.ws;
    if (tid < 32) MISC[tid] = 0u;
    __syncthreads();
    XcdBarrier bar; bar.bar = (unsigned*)(ws + WS_CTL) + CW_BAR; bar.x = 0; bar.st = nullptr;
    if (!MK_PER_PHASE) bar = xcd_barrier_post((unsigned*)(ws + WS_CTL) + CW_BAR, MISC + 8);
#if MK_PER_PHASE
    const int lo = args.ph_lo, hi = args.ph_hi;
#else
    constexpr int lo = 0, hi = NPHASE;
#endif
#ifndef SITE_MASK
#define SITE_MASK 0xffff
#endif
#define SITE(x) ((SITE_MASK >> (x)) & 1)
#define IN(k) (lo <= (k) && (k) < hi)
#define SEAM(k) do { if (IN(k) && IN((k) + 1)) xcd_barrier(bar); } while (0)
#define FRESH() int vcu_ = vcu; constexpr int G_ = G; asm volatile("" : "+s"(vcu_))

#define PTRS() unsigned char* ws_ = ws; asm volatile("" : "+s"(ws_)); bf16* Hb = (bf16*)(ws_ + WS_H); bf16* Ab = (bf16*)(ws_ + WS_A); bf16* Bb = (bf16*)(ws_ + WS_B); bf16* Cb = (bf16*)(ws_ + WS_C); bf16* Db = (bf16*)(ws_ + WS_D); \
    bf16* Eb = (bf16*)(ws_ + WS_E); const float* mod = (const float*)(ws_ + WS_MOD); const float* gsv = (const float*)(ws_ + WS_GS); \
    pg8::facc_t* rowss = (pg8::facc_t*)(ws_ + CTL_ROWSS); const pg8::facc_t* bias2 = (const pg8::facc_t*)(ws_ + CTL_BIAS2); \
    (void)Hb; (void)Ab; (void)Bb; (void)Cb; (void)Db; (void)Eb; (void)mod; (void)gsv; (void)rowss; (void)bias2

    if (SITE(0) && IN(0)) { FRESH(); bg_run(args, lds, tid, wave, lane, vcu_, G_, BgTasks{0, -1, -1, -1}); }
    SEAM(0);
    if (SITE(0) && IN(1)) { for (int rep = 0; rep < NREP(0); ++rep) { FRESH(); bg_run(args, lds, tid, wave, lane, vcu_, G_, BgTasks{-1, 0, 0, -1}); prescale_phase(args, wave, lane, vcu_, G_); } }
    SEAM(1);

    for (int lp = 0; lp < 2; ++lp) {
        const int pb = 2 + lp * 8;
        { const int layer = 2 * lp;
          if (SITE(2) && IN(pb + 0)) { PTRS();
              constexpr int Gg = gemm_wgs((MT / 256) * (8192 / 256), G);
              pg8::Gemm g{Eb, (const bf16*)(ws_ + WS_WLIN) + (size_t)lp * 8192 * D, MT, 8192, D}; pg8::StaticOrder S; S.init(MT, 8192, Gg, bx);
              pg8::EpiRgIn E{Ab, Bb, rowss + (size_t)layer * MT, bias2 + (size_t)layer * 3 * pg8::NB2};
              S.rep = NREP(2);
              if (bx < Gg) pg8::gemm_phase<pg8::EpiRgIn, pg8::StaticOrder, true, PG8_SP2V>(lds, g, S, E);
              BG_SPARE(Gg, BgTasks{2 * lp + 1, -1, 2 + lp, -1});
          }
          SEAM(pb + 0);
          constexpr int GS = 218; const int sw = (bx & 7) * (GS / 8) + ((bx & 7) < (GS & 7) ? (bx & 7) : (GS & 7)) + (bx >> 3);
          if (SITE(3) && IN(pb + 1)) { PTRS();
              { int sw_ = sw; asm volatile("" : "+s"(sw_));
              if (bx < GS) for (int u2 = sw_; u2 < 68 * 16 * NREP(3); u2 += GS) { const int u = (NREP(3) == 2 && u2 >= 68 * 16) ? u2 - 68 * 16 : u2;
                  rg_unit<1>(lds, u, lp, Ab, Bb, Hb, args.in[I_LCONVW], args.in[I_LCONVB], (const v4u*)(ws_ + WS_WGATE), args.in[I_LGATEB], args.in[I_LLAM], (float*)(ws_ + WS_AGG2), (const float*)(ws_ + WS_CARRY), (unsigned*)(ws_ + WS_COEF), tid, wave, lane); } }
              if (lp == 0) BG_SPARE(GS, BgTasks{2, -1, -1, -1, 0, 96});
          }
          SEAM(pb + 1);
          if (SITE(3) && IN(pb + 2)) { PTRS(); FRESH();
              for (int it = vcu_; it < 256; it += G_) rg_carry(lds, it, (const float*)(ws_ + WS_AGG2), (float*)(ws_ + WS_CARRY), tid, wave, lane);
          }
          SEAM(pb + 2);
          if (SITE(4) && IN(pb + 3)) { PTRS();
              for (int rep = 0; rep < NREP(4); ++rep) { int sw_ = sw; asm volatile("" : "+s"(sw_));
              if (bx < GS) for (int u = sw_; u < 68 * 16; u += GS)
                  rg_unit2(u, Bb, Hb, (const float*)(ws_ + WS_CARRY), (const unsigned*)(ws_ + WS_COEF), wave, lane); }
          }
          SEAM(pb + 3);
          if (SITE(5) && IN(pb + 4)) { PTRS();
              constexpr int Gg = gemm_wgs((MT / 256) * (D / 256), G);
              pg8::Gemm g{Hb, (const bf16*)(ws_ + WS_WLOUT) + (size_t)lp * D * D, MT, D, D}; pg8::StaticOrder S; S.init(MT, D, Gg, bx);
              const float* rgsv = (const float*)(ws_ + WS_RGS) + (size_t)layer * 3 * D;
              if (layer == 0) {
                  pg8::EpiOut<false, true> E{args.in[I_X], args.in[I_CTX], nullptr, mod + (size_t)layer * 3 * (3 * D) + 2 * D, rgsv,
                            Eb, gsv + (size_t)(layer + 1) * 3 * D, rowss + (size_t)(layer + 1) * MT, (LAS float*)(lds + EPI_P_OFF), NREP(5) == 2 ? 0.5f : 1.0f};
                  S.rep = NREP(5);
                  if (bx < Gg) pg8::gemm_phase<pg8::EpiOut<false, true>, pg8::StaticOrder, EPIOUT_ALIGN, PG8_SP2V>(lds, g, S, E);
              } else {
                  pg8::EpiOut<true, true> E{Eb, Eb + (size_t)ML * D, nullptr, mod + (size_t)layer * 3 * (3 * D) + 2 * D, rgsv,
                            Eb, gsv + (size_t)(layer + 1) * 3 * D, rowss + (size_t)(layer + 1) * MT, (LAS float*)(lds + EPI_P_OFF), 1.0f};
                  if (bx < Gg) pg8::gemm_phase<pg8::EpiOut<true, true>, pg8::StaticOrder, EPIOUT_ALIGN, PG8_SP2V>(lds, g, S, E);
              }
              BG_SPARE(Gg, BgTasks{-1, -1, 4 + lp, -1});
          }
          SEAM(pb + 4);
        }
        { const int layer = 2 * lp + 1; const bool last = layer == DEPTH - 1;
          if (SITE(6) && IN(pb + 5)) { PTRS();
              constexpr int Gg = gemm_wgs((MT / 256) * (16384 / 256), G);
              pg8::Gemm g{Eb, (const bf16*)(ws_ + WS_WNIN) + (size_t)lp * 16384 * D, MT, 16384, D}; pg8::StaticOrder S; S.init(MT, 16384, Gg, bx);
              pg8::EpiNaIn E{Ab, Bb, Cb, Db, args.in[I_NQKN] + (size_t)lp * 2 * HDIM, (LAS float*)(lds + EPI_P_OFF), rowss + (size_t)layer * MT, bias2 + (size_t)layer * 3 * pg8::NB2};
              S.rep = NREP(6);
              if (bx < Gg) pg8::gemm_phase<pg8::EpiNaIn, pg8::StaticOrder, true, PG8_SP2V>(lds, g, S, E);
              BG_SPARE(Gg, BgTasks{lp == 0 ? 2 : -1, -1, 6 + lp, -1, 96, 192});
          }
          SEAM(pb + 5);
          if (SITE(7) && IN(pb + 6)) { PTRS();
              { FRESH();
              const int nun = (4 + ((!last && vcu_ < 64) ? 1 : 0)) * NREP(7);
              for (int i2 = 0; i2 < nun; ++i2) { const int i = NREP(7) == 2 ? (i2 >> 1) : i2;
                  const int u = i < 4 ? ((vcu_ >> 5) * 8 + 2 * i + ((vcu_ >> 4) & 1)) * 16 + (vcu_ & 15) : 1024 + vcu_;
                  attn_unit(lds, u, Ab, Bb, Cb, Db, Hb, args.in[I_NRPB] + (size_t)lp * NHEAD * 15 * 31, tid, wave, lane); } }
          }
          SEAM(pb + 6);
          if (SITE(5) && IN(pb + 7)) { PTRS();
              const int Mo = last ? ML : MT;
              const int Gg = last ? gemm_wgs((ML / 256) * (D / 256), G) : gemm_wgs((MT / 256) * (D / 256), G);
              pg8::Gemm g{Hb, (const bf16*)(ws_ + WS_WNOUT) + (size_t)lp * D * D, Mo, D, D}; pg8::StaticOrder S; S.init(Mo, D, Gg, bx);
              const float* rgsv = (const float*)(ws_ + WS_RGS) + (size_t)layer * 3 * D;
              if (!last) {
                  pg8::EpiOut<true, true> E{Eb, Eb + (size_t)ML * D, nullptr, mod + (size_t)layer * 3 * (3 * D) + 2 * D, rgsv,
                            Eb, gsv + (size_t)(layer + 1) * 3 * D, rowss + (size_t)(layer + 1) * MT, (LAS float*)(lds + EPI_P_OFF), 1.0f};
                  if (bx < Gg) pg8::gemm_phase<pg8::EpiOut<true, true>, pg8::StaticOrder, EPIOUT_ALIGN, PG8_SP2V>(lds, g, S, E);
              } else {
                  pg8::EpiOut<true, false> E{Eb, Eb + (size_t)ML * D, args.out, mod + (size_t)layer * 3 * (3 * D) + 2 * D, rgsv,
                            (bf16*)nullptr, gsv, rowss, (LAS float*)(lds + EPI_P_OFF), 1.0f};
                  if (bx < Gg) pg8::gemm_phase<pg8::EpiOut<true, false>, pg8::StaticOrder, EPIOUT_ALIGN, PG8_SP2V>(lds, g, S, E);
              }
              if (!last) BG_SPARE(Gg, BgTasks{-1, 1, 1, -1});
          }
          SEAM(pb + 7);
        }
    }
#if STAMP_SEL
    xcd_barrier(bar);
    if (bx == STAMP_WG && tid == 0) args.out[0] = (float)MISC[20] * 1e-3f;
#endif
#undef IN
#undef SEAM
}

extern "C" void kernel_launch(void* const* d_in, const int* in_sizes, int n_in, void* d_out, int out_size, void* d_ws, size_t ws_size, hipStream_t stream) {
    static int grid = 0;
    if (grid == 0) {
        if (n_in != 18 || ws_size < WS_END) { fprintf(stderr, "kernel_launch: unexpected inputs (n_in %d, ws %zu)\n", n_in, ws_size); grid = -1; return; }
        int dev = 0, cus = 0, per_cu = 0;
        if (hipGetDevice(&dev) != hipSuccess || hipDeviceGetAttribute(&cus, hipDeviceAttributeMultiprocessorCount, dev) != hipSuccess) { grid = -1; return; }
        if (hipFuncSetAttribute((const void*)mega_fwd, hipFuncAttributeMaxDynamicSharedMemorySize, LDS_BYTES) != hipSuccess) { fprintf(stderr, "kernel_launch: hipFuncSetAttribute failed\n"); grid = -1; return; }
        if (hipOccupancyMaxActiveBlocksPerMultiprocessor(&per_cu, (const void*)mega_fwd, NWAVES * 64, LDS_BYTES) != hipSuccess || per_cu < 1)
            fprintf(stderr, "kernel_launch: occupancy query reports %d workgroups per CU\n", per_cu);
        (void)hipGetLastError();
        if (cus != 256) fprintf(stderr, "kernel_launch: built for a 256-CU device (one workgroup per CU), found %d CUs\n", cus);
        grid = 256;
    }
    if (grid < 0) return;
    if (hipMemsetAsync((char*)d_ws + WS_CTL, 0, CTL_ZERO_BYTES, stream) != hipSuccess) return;
    Args a{};
    for (int i = 0; i < 18; ++i) a.in[i] = (const float*)d_in[i];
    a.out = (float*)d_out; a.ws = (unsigned char*)d_ws;
#if MK_PER_PHASE
    for (int p = 0; p < NPHASE; ++p) { a.ph_lo = p; a.ph_hi = p + 1; hipLaunchKernelGGL(mega_fwd, dim3(grid), dim3(NWAVES * 64), LDS_BYTES, stream, a); }
#else
    a.ph_lo = 0; a.ph_hi = NPHASE;
    hipLaunchKernelGGL(mega_fwd, dim3(grid), dim3(NWAVES * 64), LDS_BYTES, stream, a);
#endif
    (void)in_sizes; (void)out_size;
}
```

```cpp
#define RG_SGB 9
#define RG_SGP 2
#include <hip/hip_runtime.h>
#include <cstdio>
#include <cstdint>
#ifndef PG8_WGM
#define PG8_WGM 6
#endif
namespace pg8 {
#define PG8_LAS __attribute__((address_space(3)))
typedef unsigned short bf16_t;
typedef short bf16x8 __attribute__((ext_vector_type(8)));
typedef float f32x4 __attribute__((ext_vector_type(4)));
typedef unsigned u32x4 __attribute__((ext_vector_type(4)));
constexpr int BM = 256, BK = 64, HALF = 128, HTB = HALF * BK * 2  , STAGE_BYTES = 8 * HTB, NXCD = 8, WGM = PG8_WGM;

__host__ __device__ __forceinline__ int lds_byte(int r, int c) { const int st = (r >> 4) * 2 + (c >> 5), rr = r & 15, cc = c & 31, ob = rr * 64 + cc * 2; return st * 1024 + (ob ^ (((ob >> 9) & 1) << 5)); }
__host__ __device__ __forceinline__ void stage_rc(int b, int& R, int& C) { const int st = b / 1024, sb = b % 1024, swz = sb ^ (((sb >> 9) & 1) << 5); R = (st >> 1) * 16 + swz / 64; C = (st & 1) * 32 + (swz % 64) / 2; }
__host__ __device__ __forceinline__ int perm32(int rho) { const int n = rho >> 4, i = rho & 15; return 8 * (i >> 2) + 4 * n + (i & 3); }

struct Unit { int pm, pn; };
struct Gemm { const bf16_t* A; const bf16_t* Bt; int M, N, K; };

struct StaticOrder {
    int nM, nN, nwg, G, c, rep;
    __host__ __device__ void init(int M, int N, int G_, int c_) { nM = M / BM; nN = N / BM; nwg = nM * nN; G = G_; c = c_; rep = 1; }
    __host__ __device__ bool next(int i, Unit& u) const {
        long L = (long)i * G + c; if (L >= (long)nwg * rep) return false; if (rep > 1) L %= nwg;
        int wgid = (int)L; { const int q = nwg / NXCD, r = nwg % NXCD, xcd = wgid % NXCD, off = wgid / NXCD; wgid = (xcd < r ? xcd * (q + 1) : r * (q + 1) + (xcd - r) * q) + off; }
        const int nig = WGM * nN, gid = wgid / nig, fm = gid * WGM, gsz = (nM - fm) < WGM ? (nM - fm) : WGM;
        u.pm = fm + ((wgid % nig) % gsz); u.pn = (wgid % nig) / gsz; return true;
    }
    __device__ __forceinline__ void a_ready(const Unit&) const {}
    __device__ __forceinline__ void done(const Unit&) const {}
};

__device__ __forceinline__ unsigned cvt_pk_bf16(float lo, float hi) { unsigned r; asm volatile("v_cvt_pk_bf16_f32 %0, %1, %2" : "=v"(r) : "v"(lo), "v"(hi)); return r; }
__device__ __forceinline__ float silu_f(float v) { return v * __builtin_amdgcn_rcpf(1.0f + __builtin_amdgcn_exp2f(-1.4426950408889634f * v)); }
__device__ __forceinline__ f32x4 silu4(f32x4 v) { f32x4 o; o[0] = silu_f(v[0]); o[1] = silu_f(v[1]); o[2] = silu_f(v[2]); o[3] = silu_f(v[3]); return o; }
__device__ __forceinline__ float xrow16_sum(float x) {
    const auto s = __builtin_amdgcn_permlane16_swap(__float_as_uint(x), __float_as_uint(x), false, false); x = __uint_as_float(s[0]) + __uint_as_float(s[1]);
    const auto t = __builtin_amdgcn_permlane32_swap(__float_as_uint(x), __float_as_uint(x), false, false); return __uint_as_float(t[0]) + __uint_as_float(t[1]); }
__device__ __forceinline__ float xrow16_max(float x) {
    const auto s = __builtin_amdgcn_permlane16_swap(__float_as_uint(x), __float_as_uint(x), false, false); x = fmaxf(__uint_as_float(s[0]), __uint_as_float(s[1]));
    const auto t = __builtin_amdgcn_permlane32_swap(__float_as_uint(x), __float_as_uint(x), false, false); return fmaxf(__uint_as_float(t[0]), __uint_as_float(t[1])); }
constexpr int DM = 4096;

constexpr int NB2 = 16384;
typedef unsigned facc_t;
constexpr float RS_SCALE = 1024.0f;
constexpr float B2_SCALE = 1048576.0f;
__device__ __forceinline__ float rinv_of(const facc_t* rowss, int row) { return __builtin_amdgcn_rsqf((float)rowss[row] * (1.0f / (RS_SCALE * DM)) + 1e-6f); }
__device__ __forceinline__ f32x4 b2_load4(const facc_t* p) { typedef int i32x4 __attribute__((ext_vector_type(4))); const i32x4 a = *(const i32x4*)p;
    return (f32x4){(float)a.x * (1.0f / B2_SCALE), (float)a.y * (1.0f / B2_SCALE), (float)a.z * (1.0f / B2_SCALE), (float)a.w * (1.0f / B2_SCALE)}; }
#ifndef EPI_TWICE
#define EPI_TWICE 0
#endif
#define PG8_GAS __attribute__((address_space(1)))
__device__ __forceinline__ void epi_in_loads(const facc_t* rowss, const facc_t* b2, int row0, f32x4 (&bb)[2][2], float (&ri)[2][4]) {
    typedef int i32x4 __attribute__((ext_vector_type(4)));
    i32x4 br[2][2]; unsigned rs[2][4];
#pragma unroll
    for (int bj = 0; bj < 2; ++bj) { br[bj][0] = *(const PG8_GAS i32x4*)(b2 + bj * HALF); br[bj][1] = *(const PG8_GAS i32x4*)(b2 + bj * HALF + 4); }
#pragma unroll
    for (int ai = 0; ai < 2; ++ai)
#pragma unroll
        for (int m = 0; m < 4; ++m) rs[ai][m] = *(const PG8_GAS unsigned*)(rowss + row0 + ai * HALF + m * 16);
    asm volatile("" : "+v"(br[0][0]), "+v"(br[0][1]), "+v"(br[1][0]), "+v"(br[1][1]), "+v"(rs[0][0]), "+v"(rs[0][1]), "+v"(rs[0][2]), "+v"(rs[0][3]), "+v"(rs[1][0]), "+v"(rs[1][1]), "+v"(rs[1][2]), "+v"(rs[1][3]));
#pragma unroll
    for (int bj = 0; bj < 2; ++bj)
#pragma unroll
        for (int h = 0; h < 2; ++h) { const i32x4 a = br[bj][h]; bb[bj][h] = (f32x4){(float)a.x * (1.0f / B2_SCALE), (float)a.y * (1.0f / B2_SCALE), (float)a.z * (1.0f / B2_SCALE), (float)a.w * (1.0f / B2_SCALE)}; }
#pragma unroll
    for (int ai = 0; ai < 2; ++ai)
#pragma unroll
        for (int m = 0; m < 4; ++m) ri[ai][m] = __builtin_amdgcn_rsqf((float)rs[ai][m] * (1.0f / (RS_SCALE * DM)) + 1e-6f);
}
struct EpiRgIn {
    static constexpr bool PERM = true, AFTER_DRAIN = false, TWICE = (EPI_TWICE & 1) != 0;
    bf16_t* U; bf16_t* G; const facc_t* rowss; const facc_t* bias2;
    __device__ __forceinline__ void operator()(const f32x4 (&acc)[2][2][4][2], const Unit& u, int wr, int wc, int fr, int fq) const {
        const int row0 = u.pm * BM + wr * 64 + fr; const bool isg = u.pn >= 16; bf16_t* base = isg ? G : U; const int col0 = (u.pn & 15) * BM + wc * 32 + 8 * fq;
        const facc_t* b2 = bias2 + (size_t)(u.pm < 32 ? (u.pm >> 4) : 2) * NB2 + u.pn * BM + wc * 32 + 8 * fq;
        f32x4 bb[2][2]; float riv[2][4];
        epi_in_loads(rowss, b2, row0, bb, riv);
#pragma unroll
        for (int ai = 0; ai < 2; ++ai)
#pragma unroll
            for (int m = 0; m < 4; ++m) { bf16_t* rowp = base + (size_t)(row0 + ai * HALF + m * 16) * DM + col0; const float ri = riv[ai][m];
#pragma unroll
                for (int bj = 0; bj < 2; ++bj) { f32x4 v0 = acc[ai][bj][m][0] * ri + bb[bj][0], v1 = acc[ai][bj][m][1] * ri + bb[bj][1];
                    if (isg) { v0 = silu4(v0); v1 = silu4(v1); }
                    u32x4 w; w.x = cvt_pk_bf16(v0[0], v0[1]); w.y = cvt_pk_bf16(v0[2], v0[3]); w.z = cvt_pk_bf16(v1[0], v1[1]); w.w = cvt_pk_bf16(v1[2], v1[3]);
                    *(PG8_GAS u32x4*)(rowp + bj * HALF) = w; } }
    }
};
constexpr size_t HM_CTX = (size_t)2 * 32 * 4096 * 128;
__device__ __forceinline__ size_t hm_panel(int pm, int head) { return pm < 32 ? ((size_t)((pm >> 4) * 32 + head) * 4096 + (pm & 15) * 256) * 128 : HM_CTX + ((size_t)((pm - 32) * 32 + head) * 256) * 128; }
__device__ __forceinline__ size_t hm_head(int pm) { return pm < 32 ? (size_t)4096 * 128 : (size_t)256 * 128; }
struct EpiNaIn {
    static constexpr bool PERM = true, AFTER_DRAIN = false, TWICE = (EPI_TWICE & 2) != 0;
    bf16_t *Q, *K, *V, *G; const float* qkn; PG8_LAS float* P; const facc_t* rowss; const facc_t* bias2;
    __device__ __forceinline__ void operator()(const f32x4 (&acc0)[2][2][4][2], const Unit& u, int wr, int wc, int fr, int fq) const {
        const int t = u.pn >> 4; bf16_t* base = t == 0 ? Q : (t == 1 ? K : (t == 2 ? V : G));
        const int row0 = u.pm * BM + wr * 64 + fr, col0 = (u.pn & 15) * BM + wc * 32 + 8 * fq;
        bf16_t* hmb = base + hm_panel(u.pm, 2 * (u.pn & 15)) + (size_t)(wr * 64 + fr) * 128 + wc * 32 + 8 * fq; const size_t hmh = hm_head(u.pm);
        f32x4 acc[2][2][4][2];
        { const facc_t* b2 = bias2 + (size_t)(u.pm < 32 ? (u.pm >> 4) : 2) * NB2 + u.pn * BM + wc * 32 + 8 * fq;
          f32x4 bb[2][2]; float riv[2][4];
          epi_in_loads(rowss, b2, row0, bb, riv);
#pragma unroll
          for (int ai = 0; ai < 2; ++ai)
#pragma unroll
              for (int m = 0; m < 4; ++m) { const float ri = riv[ai][m];
#pragma unroll
                  for (int bj = 0; bj < 2; ++bj) { acc[ai][bj][m][0] = acc0[ai][bj][m][0] * ri + bb[bj][0]; acc[ai][bj][m][1] = acc0[ai][bj][m][1] * ri + bb[bj][1]; } } }
        if (t < 2) {
#pragma unroll
            for (int ai = 0; ai < 2; ++ai)
#pragma unroll
                for (int m = 0; m < 4; ++m)
#pragma unroll
                    for (int bj = 0; bj < 2; ++bj) { const f32x4 a = acc[ai][bj][m][0], b = acc[ai][bj][m][1];
                        float s = (a[0] * a[0] + a[1] * a[1]) + (a[2] * a[2] + a[3] * a[3]) + (b[0] * b[0] + b[1] * b[1]) + (b[2] * b[2] + b[3] * b[3]);
                        s = xrow16_sum(s);
                        if (fq == 0) P[((ai * HALF + wr * 64 + m * 16 + fr) * 2 + bj) * 4 + wc] = s; }
            asm volatile("s_waitcnt lgkmcnt(0)" ::: "memory"); __builtin_amdgcn_s_barrier(); asm volatile("" ::: "memory");
            const float* wg = qkn + t * 128 + wc * 32 + 8 * fq; const f32x4 w0 = *(const PG8_GAS f32x4*)wg, w1 = *(const PG8_GAS f32x4*)(wg + 4);
            float rq[2][4][2];
#pragma unroll
            for (int ai = 0; ai < 2; ++ai)
#pragma unroll
                for (int m = 0; m < 4; ++m)
#pragma unroll
                    for (int bj = 0; bj < 2; ++bj) { const f32x4 p = *(const PG8_LAS f32x4*)(P + ((ai * HALF + wr * 64 + m * 16 + fr) * 2 + bj) * 4);
                        rq[ai][m][bj] = __builtin_amdgcn_rsqf(((p[0] + p[1]) + (p[2] + p[3])) * (1.0f / 128.0f) + 1e-6f); }
#pragma unroll
            for (int ai = 0; ai < 2; ++ai)
#pragma unroll
                for (int m = 0; m < 4; ++m) { const int row = row0 + ai * HALF + m * 16;
                    bf16_t* rowp = t == 1 ? hmb + (size_t)(ai * HALF + m * 16) * 128 : base + (size_t)row * DM + col0;
#pragma unroll
                    for (int bj = 0; bj < 2; ++bj) { const float rinv = rq[ai][m][bj];
                        const f32x4 v0 = acc[ai][bj][m][0] * rinv * w0, v1 = acc[ai][bj][m][1] * rinv * w1;
                        u32x4 w; w.x = cvt_pk_bf16(v0[0], v0[1]); w.y = cvt_pk_bf16(v0[2], v0[3]); w.z = cvt_pk_bf16(v1[0], v1[1]); w.w = cvt_pk_bf16(v1[2], v1[3]);
                        *(PG8_GAS u32x4*)(rowp + (t == 1 ? bj * hmh : (size_t)(bj * HALF))) = w; } }
        } else {
#pragma unroll
            for (int ai = 0; ai < 2; ++ai)
#pragma unroll
                for (int m = 0; m < 4; ++m) { const int row = row0 + ai * HALF + m * 16;
                    bf16_t* rowp = t == 2 ? hmb + (size_t)(ai * HALF + m * 16) * 128 : base + (size_t)row * DM + col0;
#pragma unroll
                    for (int bj = 0; bj < 2; ++bj) { f32x4 v0 = acc[ai][bj][m][0], v1 = acc[ai][bj][m][1];
                        if (t == 3) { v0 = silu4(v0); v1 = silu4(v1); }
                        u32x4 w; w.x = cvt_pk_bf16(v0[0], v0[1]); w.y = cvt_pk_bf16(v0[2], v0[3]); w.z = cvt_pk_bf16(v1[0], v1[1]); w.w = cvt_pk_bf16(v1[2], v1[3]);
                        *(PG8_GAS u32x4*)(rowp + (t == 2 ? bj * hmh : (size_t)(bj * HALF))) = w; } }
        }
    }
};
template <bool SRC_BF16, bool DST_BF16>
struct EpiOut {
    static constexpr bool PERM = true, AFTER_DRAIN = false, TWICE = false;
    const void* src_lat; const void* src_ctx; void* dst; const float* gate;
    const float* rgs;
    bf16_t* XG; const float* gsn; facc_t* rowss_n; PG8_LAS float* P; float ssw;
    __device__ __forceinline__ void operator()(const f32x4 (&acc)[2][2][4][2], const Unit& u, int wr, int wc, int fr, int fq) const {
        const int row0 = u.pm * BM + wr * 64 + fr, col0 = u.pn * BM + wc * 32 + 8 * fq; const int r = u.pm < 32 ? (u.pm >> 4) : 2;
        const float* gp = gate + (size_t)r * (3 * DM) + col0;
        f32x4 gv[2][2], gs[2][2], rg[2][2];
#pragma unroll
        for (int bj = 0; bj < 2; ++bj)
#pragma unroll
            for (int n = 0; n < 2; ++n) { gv[bj][n] = *(const PG8_GAS f32x4*)(gp + bj * HALF + n * 4); gs[bj][n] = XG ? *(const PG8_GAS f32x4*)(gsn + (size_t)r * DM + col0 + bj * HALF + n * 4) : (f32x4){0.f, 0.f, 0.f, 0.f};
                rg[bj][n] = SRC_BF16 ? *(const PG8_GAS f32x4*)(rgs + (size_t)r * DM + col0 + bj * HALF + n * 4) : (f32x4){1.f, 1.f, 1.f, 1.f}; }
        f32x4 sv[4][2][2]; u32x4 sb[4][2];
#define EPIOUT_REQ(AIH) do { const int ai_ = (AIH) >> 1, mh_ = ((AIH) & 1) * 2; _Pragma("unroll") for (int m = mh_; m < mh_ + 2; ++m) { const int row = row0 + ai_ * HALF + m * 16; \
                const size_t so = (row < 8192 ? (size_t)row * DM : (size_t)(row - 8192) * DM) + col0; \
                _Pragma("unroll") for (int bj = 0; bj < 2; ++bj) { \
                    if (SRC_BF16) sb[m][bj] = *(const PG8_GAS u32x4*)((const bf16_t*)(row < 8192 ? src_lat : src_ctx) + so + bj * HALF); \
                    else { const float* sp = (const float*)(row < 8192 ? src_lat : src_ctx) + so + bj * HALF; sv[m][bj][0] = *(const PG8_GAS f32x4*)sp; sv[m][bj][1] = *(const PG8_GAS f32x4*)(sp + 4); } } } } while (0)
        if (SRC_BF16) EPIOUT_REQ(0);
#pragma unroll
        for (int aih = 0; aih < 4; ++aih) { const int ai = aih >> 1, mh = (aih & 1) * 2;
            if (SRC_BF16) { if (aih + 1 < 4) EPIOUT_REQ(aih + 1); } else EPIOUT_REQ(aih);
            asm volatile("" ::: "memory");
#pragma unroll
            for (int m = mh; m < mh + 2; ++m) { const int row = row0 + ai * HALF + m * 16;
                float ss = 0.f;
#pragma unroll
                for (int bj = 0; bj < 2; ++bj) {
                    if (SRC_BF16) { const u32x4 w = sb[m][bj];
                        sv[m][bj][0] = (f32x4){__uint_as_float(w.x << 16), __uint_as_float(w.x & 0xffff0000u), __uint_as_float(w.y << 16), __uint_as_float(w.y & 0xffff0000u)} * rg[bj][0];
                        sv[m][bj][1] = (f32x4){__uint_as_float(w.z << 16), __uint_as_float(w.z & 0xffff0000u), __uint_as_float(w.w << 16), __uint_as_float(w.w & 0xffff0000u)} * rg[bj][1]; }
                    const f32x4 o0 = sv[m][bj][0] + gv[bj][0] * acc[ai][bj][m][0], o1 = sv[m][bj][1] + gv[bj][1] * acc[ai][bj][m][1];
                    if (!DST_BF16) { float* dp = (float*)dst + (size_t)row * DM + col0 + bj * HALF; *(PG8_GAS f32x4*)dp = o0; *(PG8_GAS f32x4*)(dp + 4) = o1; }
                    if (XG) { ss += (o0[0] * o0[0] + o0[1] * o0[1]) + (o0[2] * o0[2] + o0[3] * o0[3]) + (o1[0] * o1[0] + o1[1] * o1[1]) + (o1[2] * o1[2] + o1[3] * o1[3]);
                        const f32x4 y0 = o0 * gs[bj][0], y1 = o1 * gs[bj][1];
                        u32x4 w; w.x = cvt_pk_bf16(y0[0], y0[1]); w.y = cvt_pk_bf16(y0[2], y0[3]); w.z = cvt_pk_bf16(y1[0], y1[1]); w.w = cvt_pk_bf16(y1[2], y1[3]);
                        *(PG8_GAS u32x4*)(XG + (size_t)row * DM + col0 + bj * HALF) = w; } }
                if (XG) { ss = xrow16_sum(ss); if (fq == 0) __hip_atomic_fetch_add((PG8_GAS facc_t*)(rowss_n + row), (facc_t)(ss * (ssw * RS_SCALE) + 0.5f), __ATOMIC_RELAXED, __HIP_MEMORY_SCOPE_AGENT); } }
        }
#undef EPIOUT_REQ
    }
};

template <class Epi, class Sched, bool ALIGN_EPI = false, bool SP2 = false>
__device__ __forceinline__ void gemm_phase(PG8_LAS unsigned char* lds, const Gemm g, const Sched& S, const Epi& E) {
    int tid_o = threadIdx.x; asm volatile("" : "+v"(tid_o));
    const int tid = tid_o, wid = __builtin_amdgcn_readfirstlane(tid >> 6), lane = tid & 63, wr = wid >> 2, wc = wid & 3, fr = lane & 15, fq = lane >> 4;
    const int K = g.K, nt = K / BK;
    unsigned voffA[2], voffB[2];
#pragma unroll
    for (int i = 0; i < 2; ++i) { int R, C; stage_rc(tid * 16 + i * 8192, R, C); const int Rb = Epi::PERM ? ((R & ~31) + perm32(R & 31)) : R;
        voffA[i] = (unsigned)(R * K + C) * 2u; voffB[i] = (unsigned)(Rb * K + C) * 2u; }
    const size_t kstep = (size_t)(BK * 2);
    const size_t hstep = (size_t)HALF * K * 2;
    const size_t tstep = 2 * hstep;
    const unsigned ldsw = (unsigned)wid * 1024u;
    const int aoff = lds_byte(wr * 64 + fr, fq * 8), boff = lds_byte(wc * 32 + fr, fq * 8);
#define PG8_SA(b, h) (((b) * 2 + (h)) * HTB)
#define PG8_SB(b, h) ((4 + (b) * 2 + (h)) * HTB)
#define PG8_STAGE(bufoff, gbase, voff) do { _Pragma("unroll") for (int _i = 0; _i < 2; ++_i) \
        __builtin_amdgcn_global_load_lds((const unsigned*)((const char*)(gbase) + (voff)[_i]), (PG8_LAS unsigned*)(lds + (bufoff) + ldsw + _i * 8192), 16, 0, 0); } while (0)
#define PG8_LDA(dst, b, h) do { _Pragma("unroll") for (int m = 0; m < 4; ++m) _Pragma("unroll") for (int k = 0; k < 2; ++k) dst[m][k] = *(const PG8_LAS bf16x8*)(lds + PG8_SA(b, h) + aoff + m * 2048 + k * 1024); } while (0)
#define PG8_LDB(dst, b, h) do { _Pragma("unroll") for (int n = 0; n < 2; ++n) _Pragma("unroll") for (int k = 0; k < 2; ++k) dst[n][k] = *(const PG8_LAS bf16x8*)(lds + PG8_SB(b, h) + boff + n * 2048 + k * 1024); } while (0)
#ifndef PG8_PRIO
#define PG8_PRIO 1
#endif
#define PG8_MMA(ai, bj, At, Bt) do { if (PG8_PRIO) __builtin_amdgcn_s_setprio(1); _Pragma("unroll") for (int m = 0; m < 4; ++m) _Pragma("unroll") for (int n = 0; n < 2; ++n) _Pragma("unroll") for (int k = 0; k < 2; ++k) \
        acc[ai][bj][m][n] = __builtin_amdgcn_mfma_f32_16x16x32_bf16(Bt[n][k], At[m][k], acc[ai][bj][m][n], 0, 0, 0); if (PG8_PRIO) __builtin_amdgcn_s_setprio(0); } while (0)
#define PG8_WAIT_V(n) asm volatile("s_waitcnt vmcnt(" #n ")" ::: "memory")
#define PG8_WAIT_L(n) asm volatile("s_waitcnt lgkmcnt(" #n ")" ::: "memory")
#define PG8_BAR __builtin_amdgcn_s_barrier()
#define PG8_SCHED __builtin_amdgcn_sched_barrier(0)
    Unit cur, nxt; int ui = 0;
    if (!S.next(0, cur)) return;
    f32x4 acc[2][2][4][2];
#pragma unroll
    for (int a = 0; a < 2; ++a)
#pragma unroll
        for (int b = 0; b < 2; ++b)
#pragma unroll
            for (int m = 0; m < 4; ++m)
#pragma unroll
                for (int n = 0; n < 2; ++n) acc[a][b][m][n] = (f32x4){0.f, 0.f, 0.f, 0.f};
    bf16x8 At[4][2], B0[2][2], B1[2][2];
    const char* cA = (const char*)g.A + (size_t)cur.pm * tstep; const char* cB = (const char*)g.Bt + (size_t)cur.pn * tstep;
    S.a_ready(cur);
    if constexpr (SP2) {
        PG8_STAGE(PG8_SB(0, 0), cB, voffB); PG8_STAGE(PG8_SB(0, 1), cB + hstep, voffB); PG8_STAGE(PG8_SA(0, 0), cA, voffA); PG8_STAGE(PG8_SA(0, 1), cA + hstep, voffA);
        if (wr == 1) PG8_BAR;
        PG8_WAIT_V(2); PG8_BAR;
        PG8_STAGE(PG8_SB(1, 0), cB + kstep, voffB); PG8_STAGE(PG8_SA(1, 0), cA + kstep, voffA); PG8_STAGE(PG8_SB(1, 1), cB + hstep + kstep, voffB);
        PG8_WAIT_V(6); PG8_BAR;
    } else {
        PG8_STAGE(PG8_SB(0, 0), cB, voffB); PG8_STAGE(PG8_SA(0, 0), cA, voffA); PG8_STAGE(PG8_SB(0, 1), cB + hstep, voffB); PG8_STAGE(PG8_SA(0, 1), cA + hstep, voffA);
        if (wr == 1) PG8_BAR;
        PG8_WAIT_V(4); PG8_BAR;
        PG8_STAGE(PG8_SB(1, 0), cB + kstep, voffB); PG8_STAGE(PG8_SA(1, 0), cA + kstep, voffA); PG8_STAGE(PG8_SB(1, 1), cB + hstep + kstep, voffB);
        PG8_WAIT_V(6); PG8_BAR;
    }
    for (;;) {
        const bool has_next = S.next(ui + 1, nxt);
        const char* nA = has_next ? (const char*)g.A + (size_t)nxt.pm * tstep : cA; const char* nB = has_next ? (const char*)g.Bt + (size_t)nxt.pn * tstep : cB;
        for (int t = 0; t < nt; t += 2) {
            const bool last = (t == nt - 2);
            const char* a1 = cA + (size_t)(t + 1) * kstep;
            const char* a2 = last ? nA : cA + (size_t)(t + 2) * kstep; const char* b2 = last ? nB : cB + (size_t)(t + 2) * kstep;
            const char* a3 = a2 + kstep; const char* b3 = b2 + kstep;
            if (last && has_next) S.a_ready(nxt);
            if constexpr (SP2) {
            PG8_LDB(B0, 0, 0); PG8_LDB(B1, 0, 1); PG8_SCHED; PG8_LDA(At, 0, 0); PG8_STAGE(PG8_SA(1, 1), a1 + hstep, voffA);
            PG8_WAIT_V(8); PG8_WAIT_L(0); PG8_BAR; PG8_MMA(0, 0, At, B0); PG8_MMA(0, 1, At, B1); PG8_BAR; PG8_SCHED;
            PG8_LDA(At, 0, 1); PG8_STAGE(PG8_SB(0, 0), b2, voffB); PG8_STAGE(PG8_SB(0, 1), b2 + hstep, voffB); PG8_STAGE(PG8_SA(0, 0), a2, voffA);
            PG8_WAIT_V(8); PG8_WAIT_L(0); PG8_BAR; PG8_MMA(1, 0, At, B0); PG8_MMA(1, 1, At, B1); PG8_BAR; PG8_SCHED;
            PG8_LDB(B0, 1, 0); PG8_LDB(B1, 1, 1); PG8_SCHED; PG8_LDA(At, 1, 0); PG8_STAGE(PG8_SA(0, 1), a2 + hstep, voffA);
            PG8_WAIT_V(8); PG8_WAIT_L(0); PG8_BAR; PG8_MMA(0, 0, At, B0); PG8_MMA(0, 1, At, B1); PG8_BAR; PG8_SCHED;
            PG8_LDA(At, 1, 1); PG8_STAGE(PG8_SB(1, 0), b3, voffB); PG8_STAGE(PG8_SB(1, 1), b3 + hstep, voffB); PG8_STAGE(PG8_SA(1, 0), a3, voffA);
            PG8_WAIT_V(8); PG8_WAIT_L(0); PG8_BAR; PG8_MMA(1, 0, At, B0); PG8_MMA(1, 1, At, B1); PG8_BAR; PG8_SCHED;
            } else {
            PG8_LDB(B0, 0, 0); PG8_SCHED; PG8_LDA(At, 0, 0); PG8_STAGE(PG8_SA(1, 1), a1 + hstep, voffA);
            PG8_WAIT_L(8); PG8_BAR; PG8_WAIT_L(0); PG8_MMA(0, 0, At, B0); PG8_BAR; PG8_SCHED;
            PG8_LDB(B1, 0, 1); PG8_STAGE(PG8_SB(0, 0), b2, voffB);
            PG8_BAR; PG8_WAIT_L(0); PG8_MMA(0, 1, At, B1); PG8_BAR;
            PG8_LDA(At, 0, 1); PG8_STAGE(PG8_SA(0, 0), a2, voffA);
            PG8_BAR; PG8_WAIT_L(0); PG8_MMA(1, 0, At, B0); PG8_BAR; PG8_SCHED;
            PG8_STAGE(PG8_SB(0, 1), b2 + hstep, voffB);
            PG8_WAIT_V(6); PG8_BAR; PG8_MMA(1, 1, At, B1); PG8_BAR;
            PG8_LDB(B0, 1, 0); PG8_SCHED; PG8_LDA(At, 1, 0); PG8_STAGE(PG8_SA(0, 1), a2 + hstep, voffA);
            PG8_WAIT_L(8); PG8_BAR; PG8_WAIT_L(0); PG8_MMA(0, 0, At, B0); PG8_BAR; PG8_SCHED;
            PG8_LDB(B1, 1, 1); PG8_STAGE(PG8_SB(1, 0), b3, voffB);
            PG8_BAR; PG8_WAIT_L(0); PG8_MMA(0, 1, At, B1); PG8_BAR;
            PG8_LDA(At, 1, 1); PG8_STAGE(PG8_SA(1, 0), a3, voffA);
            PG8_BAR; PG8_WAIT_L(0); PG8_MMA(1, 0, At, B0); PG8_BAR; PG8_SCHED;
            PG8_STAGE(PG8_SB(1, 1), b3 + hstep, voffB);
            PG8_WAIT_V(6); PG8_BAR; PG8_MMA(1, 1, At, B1); PG8_BAR;
            }
        }
        if constexpr (ALIGN_EPI) { if (wr == 0) PG8_BAR; }
        if constexpr (!Epi::AFTER_DRAIN) { if constexpr (Epi::TWICE) { int ne_ = 2; asm volatile("" : "+s"(ne_)); _Pragma("unroll 1") for (int e_ = 0; e_ < ne_; ++e_) { asm volatile("" ::: "memory"); E(acc, cur, wr, wc, fr, fq); } } else E(acc, cur, wr, wc, fr, fq); S.done(cur); }
        if (!has_next) break;
#pragma unroll
        for (int a = 0; a < 2; ++a)
#pragma unroll
            for (int b = 0; b < 2; ++b)
#pragma unroll
                for (int m = 0; m < 4; ++m)
#pragma unroll
                    for (int n = 0; n < 2; ++n) acc[a][b][m][n] = (f32x4){0.f, 0.f, 0.f, 0.f};
        cur = nxt; cA = nA; cB = nB; ++ui;
        if constexpr (ALIGN_EPI) { if (wr == 1) PG8_BAR; }
    }
    PG8_WAIT_V(0);
    if constexpr (!ALIGN_EPI) { if (wr == 0) PG8_BAR; }
    PG8_BAR;
    if constexpr (Epi::AFTER_DRAIN) { E.fused(acc, cur, wr, wc, fr, fq, lds, wid, lane); S.done(cur); }
#undef PG8_SA
#undef PG8_SB
#undef PG8_STAGE
#undef PG8_LDA
#undef PG8_LDB
#undef PG8_MMA
#undef PG8_WAIT_V
#undef PG8_WAIT_L
#undef PG8_BAR
#undef PG8_SCHED
}
}

#ifndef EPIOUT_ALIGN
#define EPIOUT_ALIGN true
#endif
#ifndef PG8_SP2V
#define PG8_SP2V true
#endif
constexpr int NWAVES = 8;
constexpr int D = 4096, NBATCH = 2, SEQ = 4096, CTXL = 256, DEPTH = 4, NHEAD = 32, HDIM = 128;
constexpr int ML = NBATCH * SEQ;
constexpr int MC = NBATCH * CTXL;
constexpr int MT = ML + MC;
constexpr float EPS = 1e-6f;
constexpr float LOG2E = 1.4426950408889634f;
constexpr float ATTN_C1 = 0.08838834764831845f * LOG2E;

#ifndef DUP_MASK
#define DUP_MASK 0
#endif
#define NREP(x) (1 + ((DUP_MASK >> (x)) & 1))
#ifndef MK_PER_PHASE
#define MK_PER_PHASE 0
#endif
constexpr int NPHASE = 18;

constexpr size_t MiB = 1u << 20;
constexpr size_t WS_CTL = 0, CTL_ZERO_BYTES = 4 * MiB;
constexpr size_t WS_MOD = 1 * MiB;
constexpr size_t WS_WGATE = 8 * MiB;
constexpr size_t WS_WLIN = 24 * MiB;
constexpr size_t WS_WLOUT = 152 * MiB;
constexpr size_t WS_WNIN = 216 * MiB;
constexpr size_t WS_WNOUT = 472 * MiB;
constexpr size_t WS_H = 672 * MiB;
constexpr size_t WS_A = 740 * MiB, WS_B = 808 * MiB, WS_C = 876 * MiB, WS_D = 944 * MiB;
constexpr size_t WS_AGG2 = 1012 * MiB;
constexpr size_t WS_CARRY = 1022 * MiB;
constexpr size_t WS_E = 1028 * MiB;
constexpr size_t WS_GS = 1096 * MiB;
constexpr size_t WS_COEF = 1097 * MiB;
constexpr size_t WS_RGS = 1370 * MiB;
constexpr size_t WS_END = 1371 * MiB;
constexpr size_t CTL_ROWSS = 2 * MiB;
constexpr size_t CTL_BIAS2 = 2 * MiB + 512 * 1024;
constexpr int CW_BAR = 4096;

constexpr int RING_BYTES = 131072;
constexpr int EPI_P_OFF = RING_BYTES;
constexpr int MISC_OFF = RING_BYTES + 8192 + 320;
constexpr int LDS_BYTES = 147456;

#define GAS __attribute__((address_space(1)))
#define LAS __attribute__((address_space(3)))
#define DI __device__ __forceinline__
typedef unsigned short bf16;
typedef unsigned v4u __attribute__((ext_vector_type(4)));
typedef unsigned v2u __attribute__((ext_vector_type(2)));
typedef float f32x4 __attribute__((ext_vector_type(4)));
typedef float f32x16 __attribute__((ext_vector_type(16)));
typedef short bf16x8 __attribute__((ext_vector_type(8)));
typedef short s16x4 __attribute__((ext_vector_type(4)));
#define LDS_WAIT() asm volatile("s_waitcnt lgkmcnt(0)" ::: "memory")
#define VM_WAIT() asm volatile("s_waitcnt vmcnt(0)" ::: "memory")
DI unsigned pk2(float lo, float hi) { return pg8::cvt_pk_bf16(lo, hi); }
DI float bflo(unsigned w) { return __uint_as_float(w << 16); }
DI float bfhi(unsigned w) { return __uint_as_float(w & 0xffff0000u); }
DI float fast_exp2(float x) { return __builtin_amdgcn_exp2f(x); }
DI float fast_rcp(float x) { return __builtin_amdgcn_rcpf(x); }

#define XB_TMO      128
#define XB_XCNT(j)  (256  + 64 * (j))
#define XB_XSUB(j)  (1280 + 64 * (j))
#define XB_XGEN(j)  (2304 + 64 * (j))
#define XB_TOP      3328
#define XB_TOPGEN   3392
#define XCD_BAR_WORDS 3456
#define XB_SPIN_CAP (1u << 18)
__device__ __forceinline__ unsigned xb_ld(unsigned* p)              { return __hip_atomic_load(p, __ATOMIC_RELAXED, __HIP_MEMORY_SCOPE_AGENT); }
__device__ __forceinline__ unsigned xb_add(unsigned* p, unsigned v) { return __hip_atomic_fetch_add(p, v, __ATOMIC_RELAXED, __HIP_MEMORY_SCOPE_AGENT); }
__device__ __forceinline__ unsigned xb_xcc_id() { return (unsigned)__builtin_amdgcn_s_getreg((3 << 11) | 20) & 0xFu; }
#define XB_SPIN(cond, bar) do { unsigned _sp = 0; while (cond) { __builtin_amdgcn_s_sleep(1); \
    if ((++_sp & 255u) == 0u) { if (xb_ld(&(bar)[XB_TMO])) break; if (_sp > XB_SPIN_CAP) { atomicAdd(&(bar)[XB_TMO], 1u); break; } } } } while (0)
struct XcdBarrier { unsigned* bar; unsigned x; volatile LAS unsigned* st; };
__device__ __forceinline__ XcdBarrier xcd_barrier_post(unsigned* bar, volatile LAS unsigned* st) {
    XcdBarrier b; b.bar = bar; b.x = xb_xcc_id(); b.st = st;
    if (threadIdx.x == 0) (void)xb_add(&bar[XB_XCNT(b.x)], 1u);
    return b;
}
__device__ __forceinline__ void xcd_barrier_complete(unsigned* bar, unsigned x, unsigned& nloc, unsigned& nx) {
    const unsigned G = gridDim.x * gridDim.y * gridDim.z;
    unsigned sum, cnt, mine, sp = 0u;
    for (;;) {
        sum = 0u; cnt = 0u; mine = 0u;
#pragma unroll
        for (unsigned j0 = 0; j0 < 16; j0 += 8) {
            unsigned c8[8];
#pragma unroll
            for (unsigned j = 0; j < 8; ++j) c8[j] = xb_ld(&bar[XB_XCNT(j0 + j)]);
            asm volatile("" : "+v"(c8[0]), "+v"(c8[1]), "+v"(c8[2]), "+v"(c8[3]), "+v"(c8[4]), "+v"(c8[5]), "+v"(c8[6]), "+v"(c8[7]));
#pragma unroll
            for (unsigned j = 0; j < 8; ++j) { const unsigned c = c8[j]; sum += c; cnt += (c > 0u) ? 1u : 0u; mine = (j0 + j == x) ? c : mine; } }
        if (sum == G) break;
        __builtin_amdgcn_s_sleep(1);
        if ((++sp & 255u) == 0u) { if (xb_ld(&bar[XB_TMO])) break; if (sp > XB_SPIN_CAP) { atomicAdd(&bar[XB_TMO], 1u); break; } }
    }
    nloc = mine > 0u ? mine : 1u; nx = cnt > 0u ? cnt : 1u;
}
__device__ __forceinline__ void xcd_barrier(const XcdBarrier& b) {
    asm volatile("s_waitcnt vmcnt(0)" ::: "memory");
    __syncthreads();
    if (threadIdx.x == 0) {
        unsigned* bar = b.bar;
        __builtin_amdgcn_s_waitcnt(0);
        const unsigned bx_ = xb_xcc_id();
        unsigned nloc = b.st[0], nx = b.st[1];
        if (nloc == 0u) { xcd_barrier_complete(bar, bx_, nloc, nx); b.st[0] = nloc; b.st[1] = nx; }
        const unsigned old = xb_add(&bar[XB_XSUB(bx_)], 1u);
        const unsigned gen = old / nloc;
        if (old + 1u == (gen + 1u) * nloc) {
            __builtin_amdgcn_fence(__ATOMIC_RELEASE, "agent");
            asm volatile("s_waitcnt vmcnt(0)" ::: "memory");
            const unsigned og = xb_add(&bar[XB_TOP], 1u);
            const unsigned tg = og / nx;
            if (og + 1u == (tg + 1u) * nx) xb_add(&bar[XB_TOPGEN], 1u);
            else XB_SPIN(xb_ld(&bar[XB_TOPGEN]) == tg, bar);
            __builtin_amdgcn_fence(__ATOMIC_ACQUIRE, "agent");
            xb_add(&bar[XB_XGEN(bx_)], 1u);
            asm volatile("s_waitcnt vmcnt(0)" ::: "memory");
        } else {
            XB_SPIN(xb_ld(&bar[XB_XGEN(bx_)]) == gen, bar);
            __builtin_amdgcn_fence(__ATOMIC_ACQUIRE, "agent");
            asm volatile("s_waitcnt vmcnt(0)" ::: "memory");
        }
    }
    __syncthreads();
}

struct Args { const float* in[18]; float* out; unsigned char* ws; int ph_lo, ph_hi; };
enum { I_X = 0, I_C, I_CTX, I_CCTX, I_ADAW, I_ADAB, I_NORMG, I_LIN, I_LCONVW, I_LCONVB, I_LGATEW, I_LGATEB, I_LLAM, I_LOUT, I_NIN, I_NQKN, I_NRPB, I_NOUT };

DI float wave_sum(float v) {
#pragma unroll
    for (int o = 1; o < 64; o <<= 1) v += __shfl_xor(v, o);
    return v;
}

DI void tr_load(const float* W, int N, int item, int lane, f32x4 (&v)[16]) {
    const int nblk = N >> 6, kb = item / nblk, nb = item - kb * nblk;
    const GAS float* p = (const GAS float*)W + (size_t)(64 * kb + (lane >> 4)) * N + 64 * nb + 4 * (lane & 15);
#pragma unroll
    for (int i = 0; i < 16; ++i) v[i] = __builtin_nontemporal_load((const GAS f32x4*)(p + (size_t)(4 * i) * N));
}
DI void tr_store(bf16* WT, int K, int N, int item, int lane, LAS float* scr, const f32x4 (&v)[16], const float* shift, pg8::facc_t* bias2) {
    const int nblk = N >> 6, kb = item / nblk, nb = item - kb * nblk;
    { LAS float* w = scr + (lane >> 4) * 65 + 4 * (lane & 15);
#pragma unroll
      for (int i = 0; i < 16; ++i) { w[(4 * i) * 65 + 0] = v[i][0]; w[(4 * i) * 65 + 1] = v[i][1]; w[(4 * i) * 65 + 2] = v[i][2]; w[(4 * i) * 65 + 3] = v[i][3]; } }
    LDS_WAIT(); asm volatile("" ::: "memory");
    if (shift) {
        const float h0 = shift[64 * kb + lane], h1 = shift[3 * D + 64 * kb + lane], h2 = shift[6 * D + 64 * kb + lane];
        float s0 = 0.f, s1 = 0.f, s2 = 0.f;
#pragma unroll
        for (int k = 0; k < 64; ++k) { const float w = scr[k * 65 + lane];
            s0 += __builtin_bit_cast(float, __builtin_amdgcn_readlane(__builtin_bit_cast(int, h0), k)) * w;
            s1 += __builtin_bit_cast(float, __builtin_amdgcn_readlane(__builtin_bit_cast(int, h1), k)) * w;
            s2 += __builtin_bit_cast(float, __builtin_amdgcn_readlane(__builtin_bit_cast(int, h2), k)) * w; }
        pg8::facc_t* bp = bias2 + 64 * nb + lane;
        atomicAdd(bp, (pg8::facc_t)(int)rintf(s0 * pg8::B2_SCALE)); atomicAdd(bp + pg8::NB2, (pg8::facc_t)(int)rintf(s1 * pg8::B2_SCALE)); atomicAdd(bp + 2 * pg8::NB2, (pg8::facc_t)(int)rintf(s2 * pg8::B2_SCALE));
    }
    const int c = lane & 7;
#pragma unroll
    for (int j = 0; j < 8; ++j) { const int n = (lane >> 3) + 8 * j; const LAS float* q = scr + (8 * c) * 65 + n;
        v4u o; o.x = pk2(q[0 * 65], q[1 * 65]); o.y = pk2(q[2 * 65], q[3 * 65]); o.z = pk2(q[4 * 65], q[5 * 65]); o.w = pk2(q[6 * 65], q[7 * 65]);
        __builtin_nontemporal_store(o, (GAS v4u*)(WT + (size_t)(64 * nb + n) * K + 64 * kb + 8 * c)); }
    LDS_WAIT(); asm volatile("" ::: "memory");
}

struct BgTasks { int ada_layer, gate_lj, tr0, tr1, ada_lo = 0, ada_hi = 192; };
DI void bg_run(const Args& a, LAS unsigned char* lds, int tid, int wave, int lane, int widx, int nw, const BgTasks t) {
    asm volatile("" : "+v"(tid), "+v"(lane));
    unsigned char* ws = a.ws;
    if (t.ada_layer >= 0) {
        const int i = t.ada_layer;
        LAS f32x4* condL = (LAS f32x4*)lds;
        LAS float* red = (LAS float*)(lds + 65536);
        const float* c = a.in[I_C]; const float* cc = a.in[I_CCTX];
        for (int k = tid; k < D; k += NWAVES * 64) { f32x4 v; v[0] = pg8::silu_f(c[k]); v[1] = pg8::silu_f(c[D + k]); v[2] = pg8::silu_f(cc[k]); v[3] = 0.f; condL[k] = v; }
        __syncthreads();
        float* mod = (float*)(ws + WS_MOD);
        const int cw = nw >= 256 ? 48 : 64, ilo = nw >= 256 ? 0 : t.ada_lo, ihi = nw >= 256 ? (3 * D) / 48 : t.ada_hi;
        for (int item = ilo + widx; item < ihi; item += nw) {
            const int n0 = item * cw;
            const float* wp = a.in[I_ADAW] + ((size_t)i * D + wave * 512) * (3 * D) + n0 + lane;
            float a0 = 0.f, a1 = 0.f, a2 = 0.f;
            if (lane < cw) for (int kk = 0; kk < 512; kk += 32) {
                float w[32];
#pragma unroll
                for (int j = 0; j < 32; ++j) w[j] = __builtin_nontemporal_load(wp + (size_t)(kk + j) * (3 * D));
#pragma unroll
                for (int j = 0; j < 32; ++j) { const f32x4 cv = condL[wave * 512 + kk + j]; a0 += cv[0] * w[j]; a1 += cv[1] * w[j]; a2 += cv[2] * w[j]; }
            }
            red[(wave * 3 + 0) * 64 + lane] = a0; red[(wave * 3 + 1) * 64 + lane] = a1; red[(wave * 3 + 2) * 64 + lane] = a2;
            __syncthreads();
            if (tid < 192 && (tid & 63) < cw) { const int r = tid >> 6, l = tid & 63, n = n0 + l; float s = 0.f;
#pragma unroll
                for (int w8 = 0; w8 < 8; ++w8) s += red[(w8 * 3 + r) * 64 + l];
                const float val = s + a.in[I_ADAB][(size_t)i * (3 * D) + n];
                mod[((size_t)i * 3 + r) * (3 * D) + n] = val;
                if (n >= D && n < 2 * D) { float gsx = a.in[I_NORMG][(size_t)i * D + n - D] * (1.0f + val);
                    if (!(fabsf(gsx) >= 1e-18f)) gsx = gsx < 0.f ? -1e-18f : 1e-18f;
                    ((float*)(ws + WS_GS))[((size_t)i * 3 + r) * D + n - D] = gsx; ((float*)(ws + WS_RGS))[((size_t)i * 3 + r) * D + n - D] = 1.0f / gsx; } }
            __syncthreads();
        }
    }
    if (t.gate_lj >= 0) {
        const float* gw = a.in[I_LGATEW]; v4u* dst = (v4u*)(ws + WS_WGATE);
        for (int f0 = widx * (NWAVES * 64) + tid; f0 < 16 * 2 * 8 * 2 * 16 * 64; f0 += nw * NWAVES * 64) {
            const int f = f0 + (t.gate_lj << 19);
            const int ln = f & 63, ks = (f >> 6) & 15, gate = (f >> 10) & 1, jt = (f >> 11) & 7, dir = (f >> 14) & 1, nb = (f >> 15) & 15, lj = f >> 19;
            const int k0 = ks * 16 + 8 * (ln >> 5), j = jt * 32 + (ln & 31);
            const float* s = gw + ((((size_t)(lj * 2 + dir) * 2 + gate) * 16 + nb) * 256 + k0) * 256 + j;
            v4u o; o.x = pk2(s[0], s[256]); o.y = pk2(s[512], s[768]); o.z = pk2(s[1024], s[1280]); o.w = pk2(s[1536], s[1792]);
            dst[f] = o;
        }
    }
    {
        LAS float* scr = (LAS float*)(lds + wave * 16640);
#ifndef BG_WAVES
#define BG_WAVES 8
#endif
        const int nwv = nw >= 256 ? NWAVES : BG_WAVES;
        const int gw = widx * nwv + wave, NGW = nw * nwv;
#pragma unroll 1
        for (int q = 0; q < 2; ++q) { const int id = q == 0 ? t.tr0 : t.tr1; if (id < 0 || wave >= nwv) continue;
            const int kind = id >> 1, lj = id & 1; const int N = kind == 0 ? 8192 : (kind == 2 ? 16384 : D);
            const float* W = a.in[kind == 0 ? I_LIN : (kind == 1 ? I_LOUT : (kind == 2 ? I_NIN : I_NOUT))] + (size_t)lj * D * N;
            bf16* WT = (bf16*)(ws + (kind == 0 ? WS_WLIN : (kind == 1 ? WS_WLOUT : (kind == 2 ? WS_WNIN : WS_WNOUT)))) + (size_t)lj * N * D;
            const int nitems = 64 * (N / 64);
            const int lay = kind == 0 ? 2 * lj : 2 * lj + 1;
            const float* shift = (kind == 0 || kind == 2) ? (const float*)(ws + WS_MOD) + (size_t)lay * 3 * (3 * D) : nullptr;
            pg8::facc_t* bias2 = (pg8::facc_t*)(ws + CTL_BIAS2) + (size_t)lay * 3 * pg8::NB2;
            f32x4 va[16], vb[16];
            if (gw < nitems) tr_load(W, N, gw, lane, va);
            for (int it = gw; it < nitems; it += 2 * NGW) {
                if (it + NGW < nitems) tr_load(W, N, it + NGW, lane, vb);
                tr_store(WT, D, N, it, lane, scr, va, shift, bias2);
                if (it + 2 * NGW < nitems) tr_load(W, N, it + 2 * NGW, lane, va);
                if (it + NGW < nitems) tr_store(WT, D, N, it + NGW, lane, scr, vb, shift, bias2);
            }
        }
    }
    __syncthreads();
}
constexpr DI int gemm_wgs(int nunits, int G) { const int rounds = (nunits + G - 1) / G; return (nunits + rounds - 1) / rounds; }
#define BG_SPARE(Gg, ...) do { const BgTasks _t = __VA_ARGS__; if ((Gg) >= G) bg_run(args, lds, tid, wave, lane, bx, G, _t); else if (bx >= (Gg)) bg_run(args, lds, tid, wave, lane, bx - (Gg), G - (Gg), _t); } while (0)

DI void prescale_phase(const Args& a, int wave, int lane, int vcu, int G) {
    asm volatile("" : "+v"(lane));
    unsigned char* ws = a.ws;
    const float* gs = (const float*)(ws + WS_GS);
    pg8::facc_t* rowss = (pg8::facc_t*)(ws + CTL_ROWSS);
    bf16* E = (bf16*)(ws + WS_E);
    const int gw = vcu * NWAVES + wave, NGW = G * NWAVES;
    for (int m2 = gw; m2 < MT * NREP(1); m2 += NGW) { const int m = m2 >= MT ? m2 - MT : m2;
        const float* src = m < ML ? a.in[I_X] + (size_t)m * D : a.in[I_CTX] + (size_t)(m - ML) * D;
        const float* g = gs + (size_t)(m < ML ? (m >> 12) : 2) * D;
        const GAS f32x4* xr = (const GAS f32x4*)src + lane;
        GAS v2u* o8 = (GAS v2u*)(E + (size_t)m * D) + lane;
        float s = 0.f;
        f32x4 xv[16], gv[16];
#pragma unroll
        for (int j = 0; j < 16; ++j) xv[j] = xr[64 * j];
#pragma unroll
        for (int j = 0; j < 16; ++j) gv[j] = *((const GAS f32x4*)g + lane + 64 * j);
        asm volatile("" ::: "memory");
#pragma unroll
        for (int j = 0; j < 16; ++j) { const f32x4 v = xv[j]; s += (v[0] * v[0] + v[1] * v[1]) + (v[2] * v[2] + v[3] * v[3]);
            const f32x4 y = v * gv[j];
            v2u w; w.x = pk2(y[0], y[1]); w.y = pk2(y[2], y[3]); o8[64 * j] = w; }
        s = wave_sum(s);
        if (lane == 0) rowss[m] = (pg8::facc_t)(s * pg8::RS_SCALE + 0.5f);
    }
}

DI int rg_rmap(int t) { return ((t >> 4) & 3) * 32 + ((t >> 2) & 3) * 8 + (t >> 6) * 4 + (t & 3); }
template <int PASS, int DIR>
DI void rg_dir(LAS unsigned char* lds, bf16x8 (&bwr)[16], bf16x8 (&bwi)[16], const GAS bf16x8* wpn, const float gbr2, const float gbi2, const float kk2,
               const unsigned abase, const unsigned ubase, GAS unsigned* coef, float& S2, float& h) {
    f32x16 nr, ni;
#pragma unroll
    for (int i = 0; i < 16; ++i) { nr[i] = 0.f; ni[i] = 0.f; }
    { const LAS unsigned char* at = lds + (DIR == 0 ? 0 : 3) * 16384;
#pragma unroll
      for (int ks = 0; ks < 16; ++ks) { const bf16x8 av = *(const LAS bf16x8*)(at + (abase ^ ((unsigned)ks << 5)));
          nr = __builtin_amdgcn_mfma_f32_32x32x16_bf16(av, bwr[ks], nr, 0, 0, 0); ni = __builtin_amdgcn_mfma_f32_32x32x16_bf16(av, bwi[ks], ni, 0, 0, 0); } }
#pragma unroll
    for (int ti = 0; ti < 4; ++ti) {
        const int mt = DIR == 0 ? ti : 3 - ti, mtn = DIR == 0 ? ti + 1 : 2 - ti;
        const f32x16 zr = nr, zi = ni;
        if (ti < 3) {
#pragma unroll
            for (int i = 0; i < 16; ++i) { nr[i] = 0.f; ni[i] = 0.f; } }
        else if (wpn) {
#pragma unroll
            for (int ks = 0; ks < 16; ++ks) { bwr[ks] = wpn[ks * 64]; bwi[ks] = wpn[(16 + ks) * 64]; } }

        const LAS unsigned char* at = lds + mt * 16384; const LAS unsigned char* atn = lds + mtn * 16384;
        v4u cpk;
        bf16x8 avn = *(const LAS bf16x8*)((ti < 3 ? atn : at) + abase);
        unsigned short upn = *(const LAS unsigned short*)(at + (ubase ^ ((unsigned)((((DIR == 0 ? 0 : 15) >> 2) & 1) * 8 + ((DIR == 0 ? 0 : 15) & 3)) << 4)) + ((DIR == 0 ? 0 : 15) >> 2) * 4096 + ((DIR == 0 ? 0 : 15) & 3) * 512);
#pragma unroll
        for (int rr = 0; rr < 16; ++rr) {
            const bf16x8 av = avn; const unsigned short upc = upn;
            if (rr < 15) { if (ti < 3) avn = *(const LAS bf16x8*)(atn + (abase ^ ((unsigned)(rr + 1) << 5)));
                const int r1 = DIR == 0 ? rr + 1 : 14 - rr; const unsigned cr1 = (unsigned)(((r1 >> 2) & 1) * 8 + (r1 & 3));
                upn = *(const LAS unsigned short*)(at + (ubase ^ (cr1 << 4)) + (r1 >> 2) * 4096 + (r1 & 3) * 512); }
            if (ti < 3) { nr = __builtin_amdgcn_mfma_f32_32x32x16_bf16(av, bwr[rr], nr, 0, 0, 0); ni = __builtin_amdgcn_mfma_f32_32x32x16_bf16(av, bwi[rr], ni, 0, 0, 0); }

            const int r = DIR == 0 ? rr : 15 - rr;
            const float up = __uint_as_float((unsigned)upc << 16);
            const float rg = fast_rcp(1.0f + fast_exp2(__builtin_fmaf(zr[r], -LOG2E, gbr2)));
            const float ig = fast_rcp(1.0f + fast_exp2(__builtin_fmaf(zi[r], -LOG2E, gbi2)));
            const float la2 = kk2 * rg, av_ = fast_exp2(la2);
            const float em = __builtin_fmaf(-av_, av_, 1.0f);
            const float bv = __builtin_amdgcn_sqrtf(em) * (ig * up);
            h = __builtin_fmaf(av_, h, bv);
            S2 += la2; cpk[r & 3] = pk2(la2, bv);
            if ((rr & 3) == 3) __builtin_nontemporal_store(cpk, (GAS v4u*)coef + (size_t)(mt * 4 + (r >> 2)) * 512);
#ifndef RG_SB_EVERY
#define RG_SB_EVERY 16
#endif
#ifndef RG_SGB
#define RG_SGB 0
#endif
#if RG_SGB
#ifndef RG_SGP
#define RG_SGP 1
#endif
            if (ti < 3) {
                if (RG_SGP == 1) { __builtin_amdgcn_sched_group_barrier(0x8, 1, 0); __builtin_amdgcn_sched_group_barrier(0x402, RG_SGB, 0);
                                   __builtin_amdgcn_sched_group_barrier(0x8, 1, 0); __builtin_amdgcn_sched_group_barrier(0x402, RG_SGB, 0); __builtin_amdgcn_sched_group_barrier(0x100, 2, 0); }
                if (RG_SGP == 2) { __builtin_amdgcn_sched_group_barrier(0x100, 2, 0); __builtin_amdgcn_sched_group_barrier(0x8, 1, 0); __builtin_amdgcn_sched_group_barrier(0x402, RG_SGB, 0);
                                   __builtin_amdgcn_sched_group_barrier(0x8, 1, 0); __builtin_amdgcn_sched_group_barrier(0x402, RG_SGB, 0); }
                if (RG_SGP == 3) { __builtin_amdgcn_sched_group_barrier(0x8, 2, 0); __builtin_amdgcn_sched_group_barrier(0x402, 2 * RG_SGB, 0); __builtin_amdgcn_sched_group_barrier(0x100, 2, 0); }
                if (RG_SGP == 4) { __builtin_amdgcn_sched_group_barrier(0x8, 1, 0); __builtin_amdgcn_sched_group_barrier(0x402, 6, 0); __builtin_amdgcn_sched_group_barrier(0x100, 1, 0);
                                   __builtin_amdgcn_sched_group_barrier(0x8, 1, 0); __builtin_amdgcn_sched_group_barrier(0x402, 6, 0); __builtin_amdgcn_sched_group_barrier(0x100, 1, 0);
                                   __builtin_amdgcn_sched_group_barrier(0x402, 6, 0); }
            }
#endif
            if ((rr % RG_SB_EVERY) == RG_SB_EVERY - 1) __builtin_amdgcn_sched_barrier(0);
        }
    }
}
#ifndef STAMP_SEL
#define STAMP_SEL 0
#endif
#ifndef STAMP_WG
#define STAMP_WG 0
#endif
#ifndef STAMP_WAVE
#define STAMP_WAVE 0
#endif
#if STAMP_SEL
#define STAMP_T(v) const unsigned long long v = __builtin_amdgcn_s_memtime()
#define STAMP_ACC(k, a, b) do { if (STAMP_SEL == (k) && tid == STAMP_WAVE * 64) *(volatile LAS unsigned*)(lds + MISC_OFF + 80) += (unsigned)((b) - (a)); } while (0)
#else
#define STAMP_T(v) do {} while (0)
#define STAMP_ACC(k, a, b) do {} while (0)
#endif
template <int PASS>
DI void rg_unit(LAS unsigned char* lds, int unit, int lj, const bf16* U, const bf16* Gb, bf16* HS, const float* conv_w, const float* conv_b, const v4u* wgt, const float* gate_b, const float* lam,
                float* agg, const float* carry, unsigned* coefb, int tid, int wave, int lane) {
    asm volatile("" : "+v"(tid), "+v"(lane));
    const int nb = unit / 68, gc = unit - nb * 68, m0 = gc * 128;
    const bool has_left = gc < 64 ? ((gc & 31) != 0) : ((gc & 1) != 0);
    const bool has_right = gc < 64 ? ((gc & 31) != 31) : ((gc & 1) != 1);
#ifndef RG_BWI_EARLY
#define RG_BWI_EARLY 1
#endif
    unsigned lo_ = (unsigned)lane; asm volatile("" : "+v"(lo_));
    const GAS bf16x8* wp0 = (const GAS bf16x8*)wgt + ((((size_t)(lj * 16 + nb) * 2 + 0) * 8 + wave) * 2) * (16 * 64) + lo_;
    const GAS bf16x8* wp1 = wp0 + (size_t)8 * 2 * 16 * 64;
    bf16x8 bwr[16], bwi[16];
#ifndef RG_BWR_PRE
#define RG_BWR_PRE 0
#endif
#pragma unroll
    for (int ks = 0; ks < RG_BWR_PRE; ++ks) bwr[ks] = wp0[ks * 64];
    asm volatile("" ::: "memory");
    STAMP_T(st0);
#ifndef RGP
#define RGP 0
#endif
#if RGP == 1
    int nrepA = 2; asm volatile("" : "+s"(nrepA));
#pragma unroll 1
    for (int repA = 0; repA < nrepA; ++repA)
#endif
    {
        asm volatile("" ::: "memory");
        const int cg = tid & 31, run = tid >> 5, ch0 = nb * 256 + cg * 8;
        float xin[11][8];
#pragma unroll
        for (int rr = 0; rr < 11; ++rr) { const int lr = run * 8 - 2 + rr; const bool valid = (lr >= 0 || has_left) && (lr < 128 || has_right);
            v4u raw = (v4u){0u, 0u, 0u, 0u}; if (valid) raw = *(const GAS v4u*)(U + (size_t)(m0 + lr) * D + ch0);
            xin[rr][0] = bflo(raw.x); xin[rr][1] = bfhi(raw.x); xin[rr][2] = bflo(raw.y); xin[rr][3] = bfhi(raw.y); xin[rr][4] = bflo(raw.z); xin[rr][5] = bfhi(raw.z); xin[rr][6] = bflo(raw.w); xin[rr][7] = bfhi(raw.w); }
        float cw[4][8], cb[8];
#pragma unroll
        for (int k = 0; k < 4; ++k) { const f32x4 w0 = *(const GAS f32x4*)(conv_w + ((size_t)lj * 4 + k) * D + ch0), w1 = *(const GAS f32x4*)(conv_w + ((size_t)lj * 4 + k) * D + ch0 + 4);
#pragma unroll
            for (int e = 0; e < 4; ++e) { cw[k][e] = w0[e]; cw[k][4 + e] = w1[e]; } }
        { const f32x4 b0 = *(const GAS f32x4*)(conv_b + (size_t)lj * D + ch0), b1 = *(const GAS f32x4*)(conv_b + (size_t)lj * D + ch0 + 4);
#pragma unroll
          for (int e = 0; e < 4; ++e) { cb[e] = b0[e]; cb[4 + e] = b1[e]; } }
#pragma unroll
        for (int ks = RG_BWR_PRE; ks < 16; ++ks) bwr[ks] = wp0[ks * 64];
#pragma unroll
        for (int tt = 0; tt < 8; ++tt) { float o[8];
#pragma unroll
            for (int e = 0; e < 8; ++e) { float sacc = cb[e];
#pragma unroll
                for (int k = 0; k < 4; ++k) sacc += cw[k][e] * xin[tt + k][e];
                o[e] = sacc; }
            v4u w; w.x = pk2(o[0], o[1]); w.y = pk2(o[2], o[3]); w.z = pk2(o[4], o[5]); w.w = pk2(o[6], o[7]);
            const int R = rg_rmap(run * 8 + tt);
            *(LAS v4u*)(lds + R * 512 + ((cg ^ (R & 15)) << 4)) = w;
#if RG_BWI_EARLY
            if (tt == 3) { asm volatile("" ::: "memory");
#pragma unroll
                for (int ks = 0; ks < 8; ++ks) bwi[ks] = wp0[(16 + ks) * 64]; asm volatile("" ::: "memory"); }
            if (tt == 6) { asm volatile("" ::: "memory");
#pragma unroll
                for (int ks = 8; ks < 16; ++ks) bwi[ks] = wp0[(16 + ks) * 64]; asm volatile("" ::: "memory"); }
#endif
        }
    }
    STAMP_T(st1); STAMP_ACC(1, st0, st1);
    asm volatile("" ::: "memory");
#if !RG_BWI_EARLY
#pragma unroll
    for (int ks = 0; ks < 16; ++ks) bwi[ks] = wp0[(16 + ks) * 64];
#endif
#if RGP == 2
    asm volatile("s_waitcnt vmcnt(0)" ::: "memory");
#pragma unroll
    for (int ks = 0; ks < 16; ++ks) { asm volatile("" : "+v"(bwr[ks]), "+v"(bwi[ks])); }
    { const GAS bf16x8* wq = wp0; asm volatile("" : "+v"(wq));
#pragma unroll
    for (int ks = 0; ks < 16; ++ks) { bwr[ks] = wq[ks * 64]; bwi[ks] = wq[(16 + ks) * 64]; } }
#endif
    LDS_WAIT(); __syncthreads();
    STAMP_T(st2); STAMP_ACC(2, st1, st2);
#if STAMP_SEL == 6
    asm volatile("s_waitcnt vmcnt(0)" ::: "memory");
    STAMP_T(st2b); STAMP_ACC(6, st2, st2b);
#endif
#if RG_SETPRIO
    if (wave < 4) __builtin_amdgcn_s_setprio(1);
#endif
    const unsigned c_ = lo_ & 31u, hh_ = lo_ >> 5, chl_ = (unsigned)wave * 32u + c_;
    const int ch = nb * 256 + (int)chl_, sc = gc * 2 + (int)hh_;
    const unsigned abase = c_ * 512u + ((hh_ ^ (c_ & 15u)) << 4);
    const unsigned ubase = hh_ * 2048u + ((((chl_ >> 3) ^ (hh_ << 2))) << 4) + (chl_ & 7u) * 2u;
    LAS unsigned short* hst = (LAS unsigned short*)(lds + 65536) + chl_ + hh_ * (64 * 256);
    {
        const float gbr2 = -LOG2E * gate_b[((size_t)(lj * 2 + 0) * 2 + 0) * D + ch], gbi2 = -LOG2E * gate_b[((size_t)(lj * 2 + 0) * 2 + 1) * D + ch];
        const float kk2 = -8.0f * LOG2E * log1pf(__expf(-lam[(size_t)(lj * 2 + 0) * D + ch]));
        float S2 = 0.f, h = PASS == 2 ? carry[(size_t)(sc * 2 + 0) * D + ch] : 0.f;
        rg_dir<PASS, 0>(lds, bwr, bwi, wp1, gbr2, gbi2, kk2, abase, ubase, (GAS unsigned*)coefb + ((size_t)unit * 2 + 0) * 64 * 512 + (wave * 64 + lo_) * 4, S2, h);
        if (PASS == 1) { float* ap = agg + ((size_t)(sc * 2 + 0) * 2) * D + ch; ap[0] = fast_exp2(S2); ap[D] = h; }
    }
    __builtin_amdgcn_sched_barrier(0);
    STAMP_T(st3); STAMP_ACC(3, st2, st3);
    {
        const float gbr2 = -LOG2E * gate_b[((size_t)(lj * 2 + 1) * 2 + 0) * D + ch], gbi2 = -LOG2E * gate_b[((size_t)(lj * 2 + 1) * 2 + 1) * D + ch];
        const float kk2 = -8.0f * LOG2E * log1pf(__expf(-lam[(size_t)(lj * 2 + 1) * D + ch]));
        float S2 = 0.f, h = PASS == 2 ? carry[(size_t)(sc * 2 + 1) * D + ch] : 0.f;
        rg_dir<PASS, 1>(lds, bwr, bwi, (const GAS bf16x8*)nullptr, gbr2, gbi2, kk2, abase, ubase, (GAS unsigned*)coefb + ((size_t)unit * 2 + 1) * 64 * 512 + (wave * 64 + lo_) * 4, S2, h);
        if (PASS == 1) { float* ap = agg + ((size_t)(sc * 2 + 1) * 2) * D + ch; ap[0] = fast_exp2(S2); ap[D] = h; }
    }
    __builtin_amdgcn_s_setprio(0);
    STAMP_T(st4); STAMP_ACC(4, st3, st4);
    if (PASS == 2) {
        LDS_WAIT(); __syncthreads();
        int tid2 = tid; asm volatile("" : "+v"(tid2));
        const int cg = tid2 & 31, run = tid2 >> 5, ch0 = nb * 256 + cg * 8;
#pragma unroll
        for (int tt = 0; tt < 8; ++tt) { const int t = run * 8 + tt;
            const v4u hv = *(const LAS v4u*)(lds + 65536 + t * 512 + cg * 16); const v4u gv = *(const GAS v4u*)(Gb + (size_t)(m0 + t) * D + ch0);
            v4u o; o.x = pk2(bflo(hv.x) * bflo(gv.x), bfhi(hv.x) * bfhi(gv.x)); o.y = pk2(bflo(hv.y) * bflo(gv.y), bfhi(hv.y) * bfhi(gv.y));
            o.z = pk2(bflo(hv.z) * bflo(gv.z), bfhi(hv.z) * bfhi(gv.z)); o.w = pk2(bflo(hv.w) * bflo(gv.w), bfhi(hv.w) * bfhi(gv.w));
            *(GAS v4u*)(HS + (size_t)(m0 + t) * D + ch0) = o; }
    }
    LDS_WAIT(); __syncthreads();
    STAMP_T(st5); STAMP_ACC(5, st4, st5); STAMP_ACC(9, st0, st5);
}
DI void rg_unit2(int unit, const bf16* __restrict__ Gb, bf16* __restrict__ HS, const float* __restrict__ carry, const unsigned* __restrict__ coefb, int wave, int lane) {
    asm volatile("" : "+v"(lane));
    const int nb = unit / 68, gc = unit - nb * 68;
    const int hh = wave >> 2, chl = (wave & 3) * 64 + lane, ch = nb * 256 + chl, sc = gc * 2 + hh;
    const GAS v4u* cf = (const GAS v4u*)coefb + (size_t)unit * 2 * 16 * 512 + (chl >> 5) * 64 + hh * 32 + (chl & 31);
    const size_t row0 = (size_t)(gc * 128 + hh * 64) * D + ch;
    float hf[64];
    const GAS v4u* cb = cf + (size_t)16 * 512;
    unsigned wa[16], wb[16]; unsigned short ga[16], gb[16];
#define P2_LOADF(WV, t0) do { _Pragma("unroll") for (int j = 0; j < 4; ++j) { const v4u _q = __builtin_nontemporal_load(cf + (size_t)((t0) / 4 + j) * 512); WV[4 * j] = _q[0]; WV[4 * j + 1] = _q[1]; WV[4 * j + 2] = _q[2]; WV[4 * j + 3] = _q[3]; } } while (0)
#define P2_LOADB(WV, gq, t0) do { _Pragma("unroll") for (int j = 0; j < 4; ++j) { const v4u _q = __builtin_nontemporal_load(cb + (size_t)((t0) / 4 + j) * 512); WV[4 * j] = _q[0]; WV[4 * j + 1] = _q[1]; WV[4 * j + 2] = _q[2]; WV[4 * j + 3] = _q[3]; } \
        _Pragma("unroll") for (int j = 0; j < 16; ++j) gq[j] = *(const GAS unsigned short*)(Gb + row0 + (size_t)((t0) + j) * D); } while (0)
#define P2_FWD(w, t0) do { _Pragma("unroll") for (int j = 0; j < 16; ++j) { h = __builtin_fmaf(fast_exp2(bflo(w[j])), h, bfhi(w[j])); hf[(t0) + j] = h; } } while (0)
#define P2_BWD(w, gq, t0) do { _Pragma("unroll") for (int j = 15; j >= 0; --j) { h = __builtin_fmaf(fast_exp2(bflo(w[j])), h, bfhi(w[j])); \
        *(GAS unsigned short*)(HS + row0 + (size_t)((t0) + j) * D) = (unsigned short)(pk2((hf[(t0) + j] + h) * __uint_as_float((unsigned)gq[j] << 16), 0.f) & 0xffffu); } } while (0)
    float h = carry[(size_t)(sc * 2 + 0) * D + ch]; const float hb0 = carry[(size_t)(sc * 2 + 1) * D + ch];
    P2_LOADF(wa, 0); P2_LOADF(wb, 16); P2_FWD(wa, 0); P2_LOADF(wa, 32); P2_FWD(wb, 16); P2_LOADF(wb, 48); P2_FWD(wa, 32); P2_LOADB(wa, ga, 48); P2_FWD(wb, 48);
    h = hb0;
    P2_LOADB(wb, gb, 32); asm volatile("" ::: "memory"); P2_BWD(wa, ga, 48); P2_LOADB(wa, ga, 16); asm volatile("" ::: "memory"); P2_BWD(wb, gb, 32);
    P2_LOADB(wb, gb, 0); asm volatile("" ::: "memory"); P2_BWD(wa, ga, 16); asm volatile("" ::: "memory"); P2_BWD(wb, gb, 0);
#undef P2_LOADF
#undef P2_LOADB
#undef P2_FWD
#undef P2_BWD
}
DI void rg_carry(LAS unsigned char* lds, int item, const float* agg, float* carry, int tid, int wave, int lane) {
    asm volatile("" : "+v"(tid), "+v"(lane));
    const int b = item >> 7, d = (item >> 6) & 1, ch = (item & 63) * 64 + lane;
    float A[9], H[9]; int scs[9];
#pragma unroll
    for (int e9 = 0; e9 < 9; ++e9) { const int e0 = wave * 9 + e9; const bool valid = e0 < 68; const int e = valid ? e0 : 67;
        const int sq = d == 0 ? (e < 4 ? 128 + b * 4 + e : b * 64 + (e - 4)) : (e < 4 ? 128 + b * 4 + 3 - e : b * 64 + 63 - (e - 4));
        scs[e9] = valid ? sq : -1;
        const GAS float* ap = (const GAS float*)agg + ((size_t)(sq * 2 + d) * 2) * D + ch; A[e9] = ap[0]; H[e9] = ap[D]; }
    asm volatile("" : "+v"(A[0]), "+v"(A[1]), "+v"(A[2]), "+v"(A[3]), "+v"(A[4]), "+v"(A[5]), "+v"(A[6]), "+v"(A[7]), "+v"(A[8]),
                      "+v"(H[0]), "+v"(H[1]), "+v"(H[2]), "+v"(H[3]), "+v"(H[4]), "+v"(H[5]), "+v"(H[6]), "+v"(H[7]), "+v"(H[8]));
#pragma unroll
    for (int e9 = 0; e9 < 9; ++e9) if (scs[e9] < 0) { A[e9] = 1.f; H[e9] = 0.f; }
    float Ac = 1.f, Hc = 0.f;
#pragma unroll
    for (int e9 = 0; e9 < 9; ++e9) { Hc = A[e9] * Hc + H[e9]; Ac *= A[e9]; }
    LAS float* comp = (LAS float*)lds;
    comp[(wave * 64 + lane) * 2 + 0] = Ac; comp[(wave * 64 + lane) * 2 + 1] = Hc;
    LDS_WAIT(); __syncthreads();
    float h = 0.f;
    for (int w2 = 0; w2 < wave; ++w2) h = comp[(w2 * 64 + lane) * 2 + 0] * h + comp[(w2 * 64 + lane) * 2 + 1];
#pragma unroll
    for (int e9 = 0; e9 < 9; ++e9) { if (scs[e9] >= 0) carry[(size_t)(scs[e9] * 2 + d) * D + ch] = h; h = A[e9] * h + H[e9]; }
    LDS_WAIT(); __syncthreads();
}

DI unsigned off_b(unsigned row, unsigned ch) { return 256u * row + 16u * (ch ^ (((row & 3u) << 2) | ((row >> 2) & 3u))); }
DI int clampi(int v, int lo, int hi) { return v < lo ? lo : (v > hi ? hi : v); }
constexpr int VT_DT = 3104, VT_KG = 384, TILE_BUF = 8 * VT_DT;
DI unsigned off_v(unsigned row, unsigned ch) { return (ch >> 1) * VT_DT + (row >> 3) * VT_KG + (row & 7u) * 32u + (ch & 1u) * 16u; }
#define TRS(n) "ds_read_b64_tr_b16 %" #n ", %16 offset:"
DI void tr_read16(s16x4 (&o)[16], unsigned a) {
    asm volatile(TRS(0) "0\n\t" TRS(1) "128\n\t" TRS(2) "3104\n\t" TRS(3) "3232\n\t" TRS(4) "6208\n\t" TRS(5) "6336\n\t" TRS(6) "9312\n\t" TRS(7) "9440\n\t"
                 TRS(8) "12416\n\t" TRS(9) "12544\n\t" TRS(10) "15520\n\t" TRS(11) "15648\n\t" TRS(12) "18624\n\t" TRS(13) "18752\n\t" TRS(14) "21728\n\t" TRS(15) "21856\n\t"
                 "s_waitcnt lgkmcnt(0)"
                 : "=&v"(o[0]), "=&v"(o[1]), "=&v"(o[2]), "=&v"(o[3]), "=&v"(o[4]), "=&v"(o[5]), "=&v"(o[6]), "=&v"(o[7]),
                   "=&v"(o[8]), "=&v"(o[9]), "=&v"(o[10]), "=&v"(o[11]), "=&v"(o[12]), "=&v"(o[13]), "=&v"(o[14]), "=&v"(o[15])
                 : "v"(a) : "memory");
}
DI void tr_issue16(s16x4 (&o)[16], unsigned a) {
    asm volatile(TRS(0) "0\n\t" TRS(1) "128\n\t" TRS(2) "3104\n\t" TRS(3) "3232\n\t" TRS(4) "6208\n\t" TRS(5) "6336\n\t" TRS(6) "9312\n\t" TRS(7) "9440\n\t"
                 TRS(8) "12416\n\t" TRS(9) "12544\n\t" TRS(10) "15520\n\t" TRS(11) "15648\n\t" TRS(12) "18624\n\t" TRS(13) "18752\n\t" TRS(14) "21728\n\t" TRS(15) "21856"
                 : "=&v"(o[0]), "=&v"(o[1]), "=&v"(o[2]), "=&v"(o[3]), "=&v"(o[4]), "=&v"(o[5]), "=&v"(o[6]), "=&v"(o[7]),
                   "=&v"(o[8]), "=&v"(o[9]), "=&v"(o[10]), "=&v"(o[11]), "=&v"(o[12]), "=&v"(o[13]), "=&v"(o[14]), "=&v"(o[15])
                 : "v"(a) : "memory");
}
#undef TRS
DI void lds_read8(bf16x8 (&o)[8], unsigned a0, unsigned a1, unsigned a2, unsigned a3, unsigned a4, unsigned a5, unsigned a6, unsigned a7) {
    asm volatile("ds_read_b128 %0, %8\n\tds_read_b128 %1, %9\n\tds_read_b128 %2, %10\n\tds_read_b128 %3, %11\n\tds_read_b128 %4, %12\n\tds_read_b128 %5, %13\n\tds_read_b128 %6, %14\n\tds_read_b128 %7, %15\n\ts_waitcnt lgkmcnt(0)"
                 : "=&v"(o[0]), "=&v"(o[1]), "=&v"(o[2]), "=&v"(o[3]), "=&v"(o[4]), "=&v"(o[5]), "=&v"(o[6]), "=&v"(o[7])
                 : "v"(a0), "v"(a1), "v"(a2), "v"(a3), "v"(a4), "v"(a5), "v"(a6), "v"(a7) : "memory");
}
constexpr int ATT_BUF = 16384 + TILE_BUF;
constexpr float ATT_THR = 10.0f;
#ifndef ATT_PROBE
#define ATT_PROBE 0
#endif
DI void lds_bias16(float (&o0)[8], float (&o1)[8], unsigned a0, unsigned a1, unsigned a2, unsigned a3, unsigned a4, unsigned a5, unsigned a6, unsigned a7) {
    asm volatile("ds_read_b32 %0, %16 offset:128\n\tds_read_b32 %1, %17 offset:128\n\tds_read_b32 %2, %18 offset:128\n\tds_read_b32 %3, %19 offset:128\n\t"
                 "ds_read_b32 %4, %20 offset:128\n\tds_read_b32 %5, %21 offset:128\n\tds_read_b32 %6, %22 offset:128\n\tds_read_b32 %7, %23 offset:128\n\t"
                 "ds_read_b32 %8, %16\n\tds_read_b32 %9, %17\n\tds_read_b32 %10, %18\n\tds_read_b32 %11, %19\n\t"
                 "ds_read_b32 %12, %20\n\tds_read_b32 %13, %21\n\tds_read_b32 %14, %22\n\tds_read_b32 %15, %23\n\ts_waitcnt lgkmcnt(0)"
                 : "=&v"(o0[0]), "=&v"(o0[1]), "=&v"(o0[2]), "=&v"(o0[3]), "=&v"(o0[4]), "=&v"(o0[5]), "=&v"(o0[6]), "=&v"(o0[7]),
                   "=&v"(o1[0]), "=&v"(o1[1]), "=&v"(o1[2]), "=&v"(o1[3]), "=&v"(o1[4]), "=&v"(o1[5]), "=&v"(o1[6]), "=&v"(o1[7])
                 : "v"(a0), "v"(a1), "v"(a2), "v"(a3), "v"(a4), "v"(a5), "v"(a6), "v"(a7) : "memory");
}
template <bool MASKED>
DI void att_softmax(f32x4 (&S)[2], const float (&bv)[8], const float (&madd)[2][4], const bool rowok, float& m, float& l, f32x4 (&O)[8], v4u& P) {
    float v[2][4]; float lm = -__builtin_inff();
#pragma unroll
    for (int t = 0; t < 2; ++t)
#pragma unroll
        for (int r = 0; r < 4; ++r) { v[t][r] = MASKED ? __builtin_fmaf(S[t][r], ATTN_C1, rowok ? bv[t * 4 + r] + madd[t][r] : -__builtin_inff()) : S[t][r] * ATTN_C1; lm = fmaxf(lm, v[t][r]); }
    if (__any(lm > m + ATT_THR)) {
        const float mx = pg8::xrow16_max(lm);
        const float mn = fmaxf(m, mx), alpha = fast_exp2(m - mn);
#pragma unroll
        for (int dt = 0; dt < 8; ++dt) O[dt] = O[dt] * alpha;
        l *= alpha; m = mn;
    }
    float p[2][4];
#pragma unroll
    for (int t = 0; t < 2; ++t)
#pragma unroll
        for (int r = 0; r < 4; ++r) { p[t][r] = fast_exp2(v[t][r] - m); l += p[t][r]; }
    P.x = pk2(p[0][0], p[0][1]); P.y = pk2(p[0][2], p[0][3]); P.z = pk2(p[1][0], p[1][1]); P.w = pk2(p[1][2], p[1][3]);
}
#ifndef ATT_PRIO
#define ATT_PRIO 1
#endif
#define ATT_PRIO_UP() do { if (ATT_PRIO) __builtin_amdgcn_s_setprio(1); } while (0)
#define ATT_PRIO_DN() do { if (ATT_PRIO) __builtin_amdgcn_s_setprio(0); } while (0)
DI void attn_unit(LAS unsigned char* lds, int unit, const bf16* Qb, const bf16* Kb, const bf16* Vb, const bf16* Gb, bf16* Ob, const float* rpb, int tid, int wave, int lane) {
    asm volatile("" : "+v"(tid), "+v"(lane));
    const bool lat = unit < 1024;
    int b, hd, R0 = 0;
    if (lat) { b = unit >> 9; hd = (unit >> 4) & 31; R0 = (unit & 15) * 4; } else { const int u2 = unit - 1024; b = u2 >> 5; hd = u2 & 31; }
    const int n = wave & 3, rp = wave >> 2, ql = lane & 15, g = lane >> 4;
    const int rw0 = R0 + 2 * rp;
    int qtok[2];
#pragma unroll
    for (int j = 0; j < 2; ++j) qtok[j] = lat ? b * SEQ + (rw0 + j) * 64 + n * 16 + ql : ML + b * CTXL + (2 * rp + j) * 64 + n * 16 + ql;
    const int rs0 = clampi(R0 - 4, 0, 56);
    const int rot = (11 - rs0 % 11) % 11;
    const int bs = n == 0 ? 0 : (n == 1 ? 8 : (n == 2 ? 24 : 32));
    const int qc = n * 16 + ql, qcs = clampi(qc - 8, 0, 48);
    LAS unsigned char* rpbL = lds + 2 * ATT_BUF;
    bf16x8 qf[2][4];
#pragma unroll
    for (int j = 0; j < 2; ++j)
#pragma unroll
        for (int ks = 0; ks < 4; ++ks) qf[j][ks] = *(const GAS bf16x8*)(Qb + (size_t)qtok[j] * D + hd * HDIM + ks * 32 + 8 * g);
    if (lat) for (int i = tid; i < 15 * 31; i += NWAVES * 64) { const int r1 = i / 31, c1 = i - r1 * 31; ((LAS float*)rpbL)[r1 * 32 + c1] = rpb[((size_t)hd * 15 + r1) * 31 + c1] * LOG2E; }
    float madd[2][4]; unsigned bptr[2][4];
#pragma unroll
    for (int t = 0; t < 2; ++t)
#pragma unroll
        for (int r = 0; r < 4; ++r) { const int kc = bs + 8 * g + 4 * t + r; madd[t][r] = (kc >= qcs && kc < qcs + 16) ? 0.f : -__builtin_inff();
            bptr[t][r] = (unsigned)(size_t)rpbL + (unsigned)(((rs0 - rw0 + 7) * 32 + clampi(kc - qc + 15, 0, 30)) * 4); }
    const int crow = tid >> 4, cch = tid & 15;
    const unsigned stK0 = off_b(crow, cch), stK1 = off_b(crow + 32, cch), stV0 = 16384u + off_v(crow, cch), stV1 = 16384u + off_v(crow + 32, cch);
#define TILE_LOAD(st, p) do { const int _s = (st); size_t _t0; if (_s < 11) { int _l = _s + rot; _l = _l >= 11 ? _l - 11 : _l; const int _kr = (rs0 + _l) > 63 ? 63 : (rs0 + _l); _t0 = ((size_t)(b * NHEAD + hd) * SEQ + _kr * 64) * HDIM; } else _t0 = pg8::HM_CTX + ((size_t)(b * NHEAD + hd) * CTXL + (_s - 11) * 64) * HDIM; \
        const size_t _o0 = _t0 + (size_t)tid * 8, _o1 = _o0 + (size_t)32 * HDIM;     \
        p[0] = *(const GAS v4u*)(Kb + _o0); p[1] = *(const GAS v4u*)(Kb + _o1); p[2] = *(const GAS v4u*)(Vb + _o0); p[3] = *(const GAS v4u*)(Vb + _o1); } while (0)
#define TILE_STORE(st, p) do { LAS unsigned char* _b = lds + ((st) & 1) * ATT_BUF; *(LAS v4u*)(_b + stK0) = p[0]; *(LAS v4u*)(_b + stK1) = p[1]; *(LAS v4u*)(_b + stV0) = p[2]; *(LAS v4u*)(_b + stV1) = p[3]; } while (0)
    v4u PF[4];
    if (lat) { TILE_LOAD(0, PF); TILE_STORE(0, PF); TILE_LOAD(1, PF); }
    else { TILE_LOAD(11, PF); TILE_STORE(11, PF); TILE_LOAD(12, PF); }
    f32x4 O[2][8];
#pragma unroll
    for (int j = 0; j < 2; ++j)
#pragma unroll
        for (int dt = 0; dt < 8; ++dt) O[j][dt] = (f32x4){0.f, 0.f, 0.f, 0.f};
    float mrun[2] = {-1e30f, -1e30f}, lrun[2] = {0.f, 0.f};
    unsigned kb_lat[2], kb_ctx[2][2];
#pragma unroll
    for (int t = 0; t < 2; ++t) { kb_lat[t] = off_b((unsigned)(bs + 8 * (ql >> 2) + 4 * t + (ql & 3)), (unsigned)g);
#pragma unroll
        for (int pp = 0; pp < 2; ++pp) kb_ctx[pp][t] = off_b((unsigned)(32 * pp + 8 * (ql >> 2) + 4 * t + (ql & 3)), (unsigned)g); }
    const unsigned ldsb = (unsigned)(size_t)lds;
    const unsigned vlane = 16384u + (unsigned)(g * VT_KG + (ql >> 2) * 32 + (lane & 3) * 8);
    if (lat) {
#pragma unroll
        for (int st = 0; st < 11; ++st) {
            LDS_WAIT(); __syncthreads();
            TILE_STORE(st + 1, PF); TILE_LOAD(st + 2, PF);
            int sts = st + rot; sts = sts >= 11 ? sts - 11 : sts;
            const int kr = rs0 + sts;
            const bool ok0 = kr >= clampi(rw0 - 4, 0, 56) && kr < clampi(rw0 - 4, 0, 56) + 8, ok1 = kr >= clampi(rw0 - 3, 0, 56) && kr < clampi(rw0 - 3, 0, 56) + 8;
            if (ok0 || ok1) {
                const unsigned kbuf = ldsb + (unsigned)(st & 1) * ATT_BUF;
                bf16x8 kf[8];
                lds_read8(kf, kbuf + kb_lat[0], kbuf + (kb_lat[0] ^ 64u), kbuf + (kb_lat[0] ^ 128u), kbuf + (kb_lat[0] ^ 192u), kbuf + kb_lat[1], kbuf + (kb_lat[1] ^ 64u), kbuf + (kb_lat[1] ^ 128u), kbuf + (kb_lat[1] ^ 192u));
                f32x4 S0[2], S1[2];
#if ATT_PROBE == 2
                for (int rep_ = 0; rep_ < 2; ++rep_) { asm volatile("" ::: "memory");
                lds_read8(kf, kbuf + kb_lat[0], kbuf + (kb_lat[0] ^ 64u), kbuf + (kb_lat[0] ^ 128u), kbuf + (kb_lat[0] ^ 192u), kbuf + kb_lat[1], kbuf + (kb_lat[1] ^ 64u), kbuf + (kb_lat[1] ^ 128u), kbuf + (kb_lat[1] ^ 192u));
#endif
                ATT_PRIO_UP();
#pragma unroll
                for (int t = 0; t < 2; ++t) { f32x4 a0 = (f32x4){0.f, 0.f, 0.f, 0.f}, a1 = (f32x4){0.f, 0.f, 0.f, 0.f};
#pragma unroll
                    for (int ks = 0; ks < 4; ++ks) { a0 = __builtin_amdgcn_mfma_f32_16x16x32_bf16(kf[t * 4 + ks], qf[0][ks], a0, 0, 0, 0); a1 = __builtin_amdgcn_mfma_f32_16x16x32_bf16(kf[t * 4 + ks], qf[1][ks], a1, 0, 0, 0); }
                    S0[t] = a0; S1[t] = a1; }
                ATT_PRIO_DN();
#if ATT_PROBE == 2
                asm volatile("" : "+v"(S0[0]), "+v"(S0[1]), "+v"(S1[0]), "+v"(S1[1])); }
#endif
                v4u P0, P1;
                s16x4 o[16];
                tr_issue16(o, ldsb + (unsigned)(st & 1) * ATT_BUF + vlane + (unsigned)(bs >> 3) * VT_KG);
                float bv0[8], bv1[8];
                { const unsigned bo = (unsigned)((sts - 1) * 128);
                  lds_bias16(bv0, bv1, bptr[0][0] + bo, bptr[0][1] + bo, bptr[0][2] + bo, bptr[0][3] + bo, bptr[1][0] + bo, bptr[1][1] + bo, bptr[1][2] + bo, bptr[1][3] + bo); }
                att_softmax<true>(S0, bv0, madd, ok0, mrun[0], lrun[0], O[0], P0);
                att_softmax<true>(S1, bv1, madd, ok1, mrun[1], lrun[1], O[1], P1);
                const bf16x8 p0 = __builtin_bit_cast(bf16x8, P0), p1 = __builtin_bit_cast(bf16x8, P1);
                ATT_PRIO_UP();
#pragma unroll
                for (int dt = 0; dt < 8; ++dt) { const bf16x8 vf = __builtin_shufflevector(o[2 * dt], o[2 * dt + 1], 0, 1, 2, 3, 4, 5, 6, 7);
                    O[0][dt] = __builtin_amdgcn_mfma_f32_16x16x32_bf16(vf, p0, O[0][dt], 0, 0, 0);
                    O[1][dt] = __builtin_amdgcn_mfma_f32_16x16x32_bf16(vf, p1, O[1][dt], 0, 0, 0); }
                ATT_PRIO_DN();
            }
        }
    }
#pragma unroll
    for (int st = 11; st < 15; ++st) {
        LDS_WAIT(); __syncthreads();
        if (st + 1 < 15) { TILE_STORE(st + 1, PF); if (st + 2 < 15) TILE_LOAD(st + 2, PF); }
        const unsigned kbuf = ldsb + (unsigned)(st & 1) * ATT_BUF;
#pragma unroll
        for (int pp = 0; pp < 2; ++pp) {
            bf16x8 kf[8];
            lds_read8(kf, kbuf + kb_ctx[pp][0], kbuf + (kb_ctx[pp][0] ^ 64u), kbuf + (kb_ctx[pp][0] ^ 128u), kbuf + (kb_ctx[pp][0] ^ 192u), kbuf + kb_ctx[pp][1], kbuf + (kb_ctx[pp][1] ^ 64u), kbuf + (kb_ctx[pp][1] ^ 128u), kbuf + (kb_ctx[pp][1] ^ 192u));
            f32x4 S0[2], S1[2];
            ATT_PRIO_UP();
#pragma unroll
            for (int t = 0; t < 2; ++t) { f32x4 a0 = (f32x4){0.f, 0.f, 0.f, 0.f}, a1 = (f32x4){0.f, 0.f, 0.f, 0.f};
#pragma unroll
                for (int ks = 0; ks < 4; ++ks) { a0 = __builtin_amdgcn_mfma_f32_16x16x32_bf16(kf[t * 4 + ks], qf[0][ks], a0, 0, 0, 0); a1 = __builtin_amdgcn_mfma_f32_16x16x32_bf16(kf[t * 4 + ks], qf[1][ks], a1, 0, 0, 0); }
                S0[t] = a0; S1[t] = a1; }
            ATT_PRIO_DN();
            v4u P0, P1;
            const float bvz[8] = {0.f, 0.f, 0.f, 0.f, 0.f, 0.f, 0.f, 0.f};
            att_softmax<false>(S0, bvz, madd, true, mrun[0], lrun[0], O[0], P0);
            att_softmax<false>(S1, bvz, madd, true, mrun[1], lrun[1], O[1], P1);
            s16x4 o[16];
            tr_read16(o, ldsb + (unsigned)(st & 1) * ATT_BUF + vlane + (unsigned)(4 * pp) * VT_KG);
            const bf16x8 p0 = __builtin_bit_cast(bf16x8, P0), p1 = __builtin_bit_cast(bf16x8, P1);
            ATT_PRIO_UP();
#pragma unroll
            for (int dt = 0; dt < 8; ++dt) { const bf16x8 vf = __builtin_shufflevector(o[2 * dt], o[2 * dt + 1], 0, 1, 2, 3, 4, 5, 6, 7);
                O[0][dt] = __builtin_amdgcn_mfma_f32_16x16x32_bf16(vf, p0, O[0][dt], 0, 0, 0);
                O[1][dt] = __builtin_amdgcn_mfma_f32_16x16x32_bf16(vf, p1, O[1][dt], 0, 0, 0); }
            ATT_PRIO_DN();
        }
    }
#undef TILE_LOAD
#undef TILE_STORE
    v4u gvs[2][4];
#pragma unroll
    for (int j = 0; j < 2; ++j)
#pragma unroll
        for (int dp = 0; dp < 4; ++dp) gvs[j][dp] = *(const GAS v4u*)(Gb + (size_t)qtok[j] * D + hd * HDIM + 16 * (g & 1) + 8 * (g >> 1) + dp * 32);
    asm volatile("" ::: "memory");
#pragma unroll
    for (int j = 0; j < 2; ++j) {
        const float l1 = pg8::xrow16_sum(lrun[j]);
        const float inv = fast_rcp(l1);
        const size_t rowoff = (size_t)qtok[j] * D + hd * HDIM + 16 * (g & 1) + 8 * (g >> 1);
#pragma unroll
        for (int dp = 0; dp < 4; ++dp) {
            float na[4], nb[4];
#pragma unroll
            for (int c = 0; c < 4; ++c) { const auto r = __builtin_amdgcn_permlane16_swap(__float_as_uint(O[j][2 * dp][c]), __float_as_uint(O[j][2 * dp + 1][c]), false, false);
                na[c] = __uint_as_float(r[0]); nb[c] = __uint_as_float(r[1]); }
            const size_t off = rowoff + dp * 32;
            const v4u gv = gvs[j][dp];
            v4u w; w.x = pk2(na[0] * inv * bflo(gv.x), na[1] * inv * bfhi(gv.x)); w.y = pk2(na[2] * inv * bflo(gv.y), na[3] * inv * bfhi(gv.y));
            w.z = pk2(nb[0] * inv * bflo(gv.z), nb[1] * inv * bfhi(gv.z)); w.w = pk2(nb[2] * inv * bflo(gv.w), nb[3] * inv * bfhi(gv.w));
            *(GAS v4u*)(Ob + off) = w; }
    }
    __syncthreads();
}

__global__ void __launch_bounds__(NWAVES * 64, 2) mega_fwd(Args args) {
    extern __shared__ __attribute__((aligned(16))) unsigned char lds_raw[];
    LAS unsigned char* lds = (LAS unsigned char*)lds_raw;
    volatile LAS unsigned* MISC = (volatile LAS unsigned*)(lds + MISC_OFF);
    const int tid = threadIdx.x, lane = tid & 63, wave = __builtin_amdgcn_readfirstlane(tid >> 6);
    constexpr int G = 256;
    const int bx = blockIdx.x; const int vcu = (bx % 8) * (G / 8) + bx / 8;
    unsigned char* ws = args.ws;
    if (tid < 32) MISC[tid] = 0u;
    __syncthreads();
    XcdBarrier bar; bar.bar = (unsigned*)(ws + WS_CTL) + CW_BAR; bar.x = 0; bar.st = nullptr;
    if (!MK_PER_PHASE) bar = xcd_barrier_post((unsigned*)(ws + WS_CTL) + CW_BAR, MISC + 8);
#if MK_PER_PHASE
    const int lo = args.ph_lo, hi = args.ph_hi;
#else
    constexpr int lo = 0, hi = NPHASE;
#endif
#ifndef SITE_MASK
#define SITE_MASK 0xffff
#endif
#define SITE(x) ((SITE_MASK >> (x)) & 1)
#define IN(k) (lo <= (k) && (k) < hi)
#define SEAM(k) do { if (IN(k) && IN((k) + 1)) xcd_barrier(bar); } while (0)
#define FRESH() int vcu_ = vcu; constexpr int G_ = G; asm volatile("" : "+s"(vcu_))

#define PTRS() unsigned char* ws_ = ws; asm volatile("" : "+s"(ws_)); bf16* Hb = (bf16*)(ws_ + WS_H); bf16* Ab = (bf16*)(ws_ + WS_A); bf16* Bb = (bf16*)(ws_ + WS_B); bf16* Cb = (bf16*)(ws_ + WS_C); bf16* Db = (bf16*)(ws_ + WS_D); \
    bf16* Eb = (bf16*)(ws_ + WS_E); const float* mod = (const float*)(ws_ + WS_MOD); const float* gsv = (const float*)(ws_ + WS_GS); \
    pg8::facc_t* rowss = (pg8::facc_t*)(ws_ + CTL_ROWSS); const pg8::facc_t* bias2 = (const pg8::facc_t*)(ws_ + CTL_BIAS2); \
    (void)Hb; (void)Ab; (void)Bb; (void)Cb; (void)Db; (void)Eb; (void)mod; (void)gsv; (void)rowss; (void)bias2

    if (SITE(0) && IN(0)) { FRESH(); bg_run(args, lds, tid, wave, lane, vcu_, G_, BgTasks{0, -1, -1, -1}); }
    SEAM(0);
    if (SITE(0) && IN(1)) { for (int rep = 0; rep < NREP(0); ++rep) { FRESH(); bg_run(args, lds, tid, wave, lane, vcu_, G_, BgTasks{-1, 0, 0, -1}); prescale_phase(args, wave, lane, vcu_, G_); } }
    SEAM(1);

    for (int lp = 0; lp < 2; ++lp) {
        const int pb = 2 + lp * 8;
        { const int layer = 2 * lp;
          if (SITE(2) && IN(pb + 0)) { PTRS();
              constexpr int Gg = gemm_wgs((MT / 256) * (8192 / 256), G);
              pg8::Gemm g{Eb, (const bf16*)(ws_ + WS_WLIN) + (size_t)lp * 8192 * D, MT, 8192, D}; pg8::StaticOrder S; S.init(MT, 8192, Gg, bx);
              pg8::EpiRgIn E{Ab, Bb, rowss + (size_t)layer * MT, bias2 + (size_t)layer * 3 * pg8::NB2};
              S.rep = NREP(2);
              if (bx < Gg) pg8::gemm_phase<pg8::EpiRgIn, pg8::StaticOrder, true, PG8_SP2V>(lds, g, S, E);
              BG_SPARE(Gg, BgTasks{2 * lp + 1, -1, 2 + lp, -1});
          }
          SEAM(pb + 0);
          constexpr int GS = 218; const int sw = (bx & 7) * (GS / 8) + ((bx & 7) < (GS & 7) ? (bx & 7) : (GS & 7)) + (bx >> 3);
          if (SITE(3) && IN(pb + 1)) { PTRS();
              { int sw_ = sw; asm volatile("" : "+s"(sw_));
              if (bx < GS) for (int u2 = sw_; u2 < 68 * 16 * NREP(3); u2 += GS) { const int u = (NREP(3) == 2 && u2 >= 68 * 16) ? u2 - 68 * 16 : u2;
                  rg_unit<1>(lds, u, lp, Ab, Bb, Hb, args.in[I_LCONVW], args.in[I_LCONVB], (const v4u*)(ws_ + WS_WGATE), args.in[I_LGATEB], args.in[I_LLAM], (float*)(ws_ + WS_AGG2), (const float*)(ws_ + WS_CARRY), (unsigned*)(ws_ + WS_COEF), tid, wave, lane); } }
              if (lp == 0) BG_SPARE(GS, BgTasks{2, -1, -1, -1, 0, 96});
          }
          SEAM(pb + 1);
          if (SITE(3) && IN(pb + 2)) { PTRS(); FRESH();
              for (int it = vcu_; it < 256; it += G_) rg_carry(lds, it, (const float*)(ws_ + WS_AGG2), (float*)(ws_ + WS_CARRY), tid, wave, lane);
          }
          SEAM(pb + 2);
          if (SITE(4) && IN(pb + 3)) { PTRS();
              for (int rep = 0; rep < NREP(4); ++rep) { int sw_ = sw; asm volatile("" : "+s"(sw_));
              if (bx < GS) for (int u = sw_; u < 68 * 16; u += GS)
                  rg_unit2(u, Bb, Hb, (const float*)(ws_ + WS_CARRY), (const unsigned*)(ws_ + WS_COEF), wave, lane); }
          }
          SEAM(pb + 3);
          if (SITE(5) && IN(pb + 4)) { PTRS();
              constexpr int Gg = gemm_wgs((MT / 256) * (D / 256), G);
              pg8::Gemm g{Hb, (const bf16*)(ws_ + WS_WLOUT) + (size_t)lp * D * D, MT, D, D}; pg8::StaticOrder S; S.init(MT, D, Gg, bx);
              const float* rgsv = (const float*)(ws_ + WS_RGS) + (size_t)layer * 3 * D;
              if (layer == 0) {
                  pg8::EpiOut<false, true> E{args.in[I_X], args.in[I_CTX], nullptr, mod + (size_t)layer * 3 * (3 * D) + 2 * D, rgsv,
                            Eb, gsv + (size_t)(layer + 1) * 3 * D, rowss + (size_t)(layer + 1) * MT, (LAS float*)(lds + EPI_P_OFF), NREP(5) == 2 ? 0.5f : 1.0f};
                  S.rep = NREP(5);
                  if (bx < Gg) pg8::gemm_phase<pg8::EpiOut<false, true>, pg8::StaticOrder, EPIOUT_ALIGN, PG8_SP2V>(lds, g, S, E);
              } else {
                  pg8::EpiOut<true, true> E{Eb, Eb + (size_t)ML * D, nullptr, mod + (size_t)layer * 3 * (3 * D) + 2 * D, rgsv,
                            Eb, gsv + (size_t)(layer + 1) * 3 * D, rowss + (size_t)(layer + 1) * MT, (LAS float*)(lds + EPI_P_OFF), 1.0f};
                  if (bx < Gg) pg8::gemm_phase<pg8::EpiOut<true, true>, pg8::StaticOrder, EPIOUT_ALIGN, PG8_SP2V>(lds, g, S, E);
              }
              BG_SPARE(Gg, BgTasks{-1, -1, 4 + lp, -1});
          }
          SEAM(pb + 4);
        }
        { const int layer = 2 * lp + 1; const bool last = layer == DEPTH - 1;
          if (SITE(6) && IN(pb + 5)) { PTRS();
              constexpr int Gg = gemm_wgs((MT / 256) * (16384 / 256), G);
              pg8::Gemm g{Eb, (const bf16*)(ws_ + WS_WNIN) + (size_t)lp * 16384 * D, MT, 16384, D}; pg8::StaticOrder S; S.init(MT, 16384, Gg, bx);
              pg8::EpiNaIn E{Ab, Bb, Cb, Db, args.in[I_NQKN] + (size_t)lp * 2 * HDIM, (LAS float*)(lds + EPI_P_OFF), rowss + (size_t)layer * MT, bias2 + (size_t)layer * 3 * pg8::NB2};
              S.rep = NREP(6);
              if (bx < Gg) pg8::gemm_phase<pg8::EpiNaIn, pg8::StaticOrder, true, PG8_SP2V>(lds, g, S, E);
              BG_SPARE(Gg, BgTasks{lp == 0 ? 2 : -1, -1, 6 + lp, -1, 96, 192});
          }
          SEAM(pb + 5);
          if (SITE(7) && IN(pb + 6)) { PTRS();
              { FRESH();
              const int nun = (4 + ((!last && vcu_ < 64) ? 1 : 0)) * NREP(7);
              for (int i2 = 0; i2 < nun; ++i2) { const int i = NREP(7) == 2 ? (i2 >> 1) : i2;
                  const int u = i < 4 ? ((vcu_ >> 5) * 8 + 2 * i + ((vcu_ >> 4) & 1)) * 16 + (vcu_ & 15) : 1024 + vcu_;
                  attn_unit(lds, u, Ab, Bb, Cb, Db, Hb, args.in[I_NRPB] + (size_t)lp * NHEAD * 15 * 31, tid, wave, lane); } }
          }
          SEAM(pb + 6);
          if (SITE(5) && IN(pb + 7)) { PTRS();
              const int Mo = last ? ML : MT;
              const int Gg = last ? gemm_wgs((ML / 256) * (D / 256), G) : gemm_wgs((MT / 256) * (D / 256), G);
              pg8::Gemm g{Hb, (const bf16*)(ws_ + WS_WNOUT) + (size_t)lp * D * D, Mo, D, D}; pg8::StaticOrder S; S.init(Mo, D, Gg, bx);
              const float* rgsv = (const float*)(ws_ + WS_RGS) + (size_t)layer * 3 * D;
              if (!last) {
                  pg8::EpiOut<true, true> E{Eb, Eb + (size_t)ML * D, nullptr, mod + (size_t)layer * 3 * (3 * D) + 2 * D, rgsv,
                            Eb, gsv + (size_t)(layer + 1) * 3 * D, rowss + (size_t)(layer + 1) * MT, (LAS float*)(lds + EPI_P_OFF), 1.0f};
                  if (bx < Gg) pg8::gemm_phase<pg8::EpiOut<true, true>, pg8::StaticOrder, EPIOUT_ALIGN, PG8_SP2V>(lds, g, S, E);
              } else {
                  pg8::EpiOut<true, false> E{Eb, Eb + (size_t)ML * D, args.out, mod + (size_t)layer * 3 * (3 * D) + 2 * D, rgsv,
                            (bf16*)nullptr, gsv, rowss, (LAS float*)(lds + EPI_P_OFF), 1.0f};
                  if (bx < Gg) pg8::gemm_phase<pg8::EpiOut<true, false>, pg8::StaticOrder, EPIOUT_ALIGN, PG8_SP2V>(lds, g, S, E);
              }
              if (!last) BG_SPARE(Gg, BgTasks{-1, 1, 1, -1});
          }
          SEAM(pb + 7);
        }
    }
#if STAMP_SEL
    xcd_barrier(bar);
    if (bx == STAMP_WG && tid == 0) args.out[0] = (float)MISC[20] * 1e-3f;
#endif
#undef IN
#undef SEAM
}

extern "C" void kernel_launch(void* const* d_in, const int* in_sizes, int n_in, void* d_out, int out_size, void* d_ws, size_t ws_size, hipStream_t stream) {
    static int grid = 0;
    if (grid == 0) {
        if (n_in != 18 || ws_size < WS_END) { fprintf(stderr, "kernel_launch: unexpected inputs (n_in %d, ws %zu)\n", n_in, ws_size); grid = -1; return; }
        int dev = 0, cus = 0, per_cu = 0;
        if (hipGetDevice(&dev) != hipSuccess || hipDeviceGetAttribute(&cus, hipDeviceAttributeMultiprocessorCount, dev) != hipSuccess) { grid = -1; return; }
        if (hipFuncSetAttribute((const void*)mega_fwd, hipFuncAttributeMaxDynamicSharedMemorySize, LDS_BYTES) != hipSuccess) { fprintf(stderr, "kernel_launch: hipFuncSetAttribute failed\n"); grid = -1; return; }
        if (hipOccupancyMaxActiveBlocksPerMultiprocessor(&per_cu, (const void*)mega_fwd, NWAVES * 64, LDS_BYTES) != hipSuccess || per_cu < 1)
            fprintf(stderr, "kernel_launch: occupancy query reports %d workgroups per CU\n", per_cu);
        (void)hipGetLastError();
        if (cus != 256) fprintf(stderr, "kernel_launch: built for a 256-CU device (one workgroup per CU), found %d CUs\n", cus);
        grid = 256;
    }
    if (grid < 0) return;
    if (hipMemsetAsync((char*)d_ws + WS_CTL, 0, CTL_ZERO_BYTES, stream) != hipSuccess) return;
    Args a{};
    for (int i = 0; i < 18; ++i) a.in[i] = (const float*)d_in[i];
    a.out = (float*)d_out; a.ws = (unsigned char*)d_ws;
#if MK_PER_PHASE
    for (int p = 0; p < NPHASE; ++p) { a.ph_lo = p; a.ph_hi = p + 1; hipLaunchKernelGGL(mega_fwd, dim3(grid), dim3(NWAVES * 64), LDS_BYTES, stream, a); }
#else
    a.ph_lo = 0; a.ph_hi = NPHASE;
    hipLaunchKernelGGL(mega_fwd, dim3(grid), dim3(NWAVES * 64), LDS_BYTES, stream, a);
#endif
    (void)in_sizes; (void)out_size;
}
```

```cpp
#define RG_SGB 9
#include <hip/hip_runtime.h>
#include <cstdio>
#include <cstdint>
#ifndef PG8_WGM
#define PG8_WGM 6
#endif
namespace pg8 {
#define PG8_LAS __attribute__((address_space(3)))
typedef unsigned short bf16_t;
typedef short bf16x8 __attribute__((ext_vector_type(8)));
typedef float f32x4 __attribute__((ext_vector_type(4)));
typedef unsigned u32x4 __attribute__((ext_vector_type(4)));
constexpr int BM = 256, BK = 64, HALF = 128, HTB = HALF * BK * 2  , STAGE_BYTES = 8 * HTB, NXCD = 8, WGM = PG8_WGM;

__host__ __device__ __forceinline__ int lds_byte(int r, int c) { const int st = (r >> 4) * 2 + (c >> 5), rr = r & 15, cc = c & 31, ob = rr * 64 + cc * 2; return st * 1024 + (ob ^ (((ob >> 9) & 1) << 5)); }
__host__ __device__ __forceinline__ void stage_rc(int b, int& R, int& C) { const int st = b / 1024, sb = b % 1024, swz = sb ^ (((sb >> 9) & 1) << 5); R = (st >> 1) * 16 + swz / 64; C = (st & 1) * 32 + (swz % 64) / 2; }
__host__ __device__ __forceinline__ int perm32(int rho) { const int n = rho >> 4, i = rho & 15; return 8 * (i >> 2) + 4 * n + (i & 3); }

struct Unit { int pm, pn; };
struct Gemm { const bf16_t* A; const bf16_t* Bt; int M, N, K; };

struct StaticOrder {
    int nM, nN, nwg, G, c, rep;
    __host__ __device__ void init(int M, int N, int G_, int c_) { nM = M / BM; nN = N / BM; nwg = nM * nN; G = G_; c = c_; rep = 1; }
    __host__ __device__ bool next(int i, Unit& u) const {
        long L = (long)i * G + c; if (L >= (long)nwg * rep) return false; if (rep > 1) L %= nwg;
        int wgid = (int)L; { const int q = nwg / NXCD, r = nwg % NXCD, xcd = wgid % NXCD, off = wgid / NXCD; wgid = (xcd < r ? xcd * (q + 1) : r * (q + 1) + (xcd - r) * q) + off; }
        const int nig = WGM * nN, gid = wgid / nig, fm = gid * WGM, gsz = (nM - fm) < WGM ? (nM - fm) : WGM;
        u.pm = fm + ((wgid % nig) % gsz); u.pn = (wgid % nig) / gsz; return true;
    }
    __device__ __forceinline__ void a_ready(const Unit&) const {}
    __device__ __forceinline__ void done(const Unit&) const {}
};

__device__ __forceinline__ unsigned cvt_pk_bf16(float lo, float hi) { unsigned r; asm volatile("v_cvt_pk_bf16_f32 %0, %1, %2" : "=v"(r) : "v"(lo), "v"(hi)); return r; }
__device__ __forceinline__ float silu_f(float v) { return v * __builtin_amdgcn_rcpf(1.0f + __builtin_amdgcn_exp2f(-1.4426950408889634f * v)); }
__device__ __forceinline__ f32x4 silu4(f32x4 v) { f32x4 o; o[0] = silu_f(v[0]); o[1] = silu_f(v[1]); o[2] = silu_f(v[2]); o[3] = silu_f(v[3]); return o; }
__device__ __forceinline__ float xrow16_sum(float x) {
    const auto s = __builtin_amdgcn_permlane16_swap(__float_as_uint(x), __float_as_uint(x), false, false); x = __uint_as_float(s[0]) + __uint_as_float(s[1]);
    const auto t = __builtin_amdgcn_permlane32_swap(__float_as_uint(x), __float_as_uint(x), false, false); return __uint_as_float(t[0]) + __uint_as_float(t[1]); }
__device__ __forceinline__ float xrow16_max(float x) {
    const auto s = __builtin_amdgcn_permlane16_swap(__float_as_uint(x), __float_as_uint(x), false, false); x = fmaxf(__uint_as_float(s[0]), __uint_as_float(s[1]));
    const auto t = __builtin_amdgcn_permlane32_swap(__float_as_uint(x), __float_as_uint(x), false, false); return fmaxf(__uint_as_float(t[0]), __uint_as_float(t[1])); }
constexpr int DM = 4096;

constexpr int NB2 = 16384;
typedef unsigned facc_t;
constexpr float RS_SCALE = 1024.0f;
constexpr float B2_SCALE = 1048576.0f;
__device__ __forceinline__ float rinv_of(const facc_t* rowss, int row) { return __builtin_amdgcn_rsqf((float)rowss[row] * (1.0f / (RS_SCALE * DM)) + 1e-6f); }
__device__ __forceinline__ f32x4 b2_load4(const facc_t* p) { typedef int i32x4 __attribute__((ext_vector_type(4))); const i32x4 a = *(const i32x4*)p;
    return (f32x4){(float)a.x * (1.0f / B2_SCALE), (float)a.y * (1.0f / B2_SCALE), (float)a.z * (1.0f / B2_SCALE), (float)a.w * (1.0f / B2_SCALE)}; }
#ifndef EPI_TWICE
#define EPI_TWICE 0
#endif
#define PG8_GAS __attribute__((address_space(1)))
__device__ __forceinline__ void epi_in_loads(const facc_t* rowss, const facc_t* b2, int row0, f32x4 (&bb)[2][2], float (&ri)[2][4]) {
    typedef int i32x4 __attribute__((ext_vector_type(4)));
    i32x4 br[2][2]; unsigned rs[2][4];
#pragma unroll
    for (int bj = 0; bj < 2; ++bj) { br[bj][0] = *(const PG8_GAS i32x4*)(b2 + bj * HALF); br[bj][1] = *(const PG8_GAS i32x4*)(b2 + bj * HALF + 4); }
#pragma unroll
    for (int ai = 0; ai < 2; ++ai)
#pragma unroll
        for (int m = 0; m < 4; ++m) rs[ai][m] = *(const PG8_GAS unsigned*)(rowss + row0 + ai * HALF + m * 16);
    asm volatile("" : "+v"(br[0][0]), "+v"(br[0][1]), "+v"(br[1][0]), "+v"(br[1][1]), "+v"(rs[0][0]), "+v"(rs[0][1]), "+v"(rs[0][2]), "+v"(rs[0][3]), "+v"(rs[1][0]), "+v"(rs[1][1]), "+v"(rs[1][2]), "+v"(rs[1][3]));
#pragma unroll
    for (int bj = 0; bj < 2; ++bj)
#pragma unroll
        for (int h = 0; h < 2; ++h) { const i32x4 a = br[bj][h]; bb[bj][h] = (f32x4){(float)a.x * (1.0f / B2_SCALE), (float)a.y * (1.0f / B2_SCALE), (float)a.z * (1.0f / B2_SCALE), (float)a.w * (1.0f / B2_SCALE)}; }
#pragma unroll
    for (int ai = 0; ai < 2; ++ai)
#pragma unroll
        for (int m = 0; m < 4; ++m) ri[ai][m] = __builtin_amdgcn_rsqf((float)rs[ai][m] * (1.0f / (RS_SCALE * DM)) + 1e-6f);
}
struct EpiRgIn {
    static constexpr bool PERM = true, AFTER_DRAIN = false, TWICE = (EPI_TWICE & 1) != 0;
    bf16_t* U; bf16_t* G; const facc_t* rowss; const facc_t* bias2;
    __device__ __forceinline__ void operator()(const f32x4 (&acc)[2][2][4][2], const Unit& u, int wr, int wc, int fr, int fq) const {
        const int row0 = u.pm * BM + wr * 64 + fr; const bool isg = u.pn >= 16; bf16_t* base = isg ? G : U; const int col0 = (u.pn & 15) * BM + wc * 32 + 8 * fq;
        const facc_t* b2 = bias2 + (size_t)(u.pm < 32 ? (u.pm >> 4) : 2) * NB2 + u.pn * BM + wc * 32 + 8 * fq;
        f32x4 bb[2][2]; float riv[2][4];
        epi_in_loads(rowss, b2, row0, bb, riv);
#pragma unroll
        for (int ai = 0; ai < 2; ++ai)
#pragma unroll
            for (int m = 0; m < 4; ++m) { bf16_t* rowp = base + (size_t)(row0 + ai * HALF + m * 16) * DM + col0; const float ri = riv[ai][m];
#pragma unroll
                for (int bj = 0; bj < 2; ++bj) { f32x4 v0 = acc[ai][bj][m][0] * ri + bb[bj][0], v1 = acc[ai][bj][m][1] * ri + bb[bj][1];
                    if (isg) { v0 = silu4(v0); v1 = silu4(v1); }
                    u32x4 w; w.x = cvt_pk_bf16(v0[0], v0[1]); w.y = cvt_pk_bf16(v0[2], v0[3]); w.z = cvt_pk_bf16(v1[0], v1[1]); w.w = cvt_pk_bf16(v1[2], v1[3]);
                    *(PG8_GAS u32x4*)(rowp + bj * HALF) = w; } }
    }
};
constexpr size_t HM_CTX = (size_t)2 * 32 * 4096 * 128;
__device__ __forceinline__ size_t hm_panel(int pm, int head) { return pm < 32 ? ((size_t)((pm >> 4) * 32 + head) * 4096 + (pm & 15) * 256) * 128 : HM_CTX + ((size_t)((pm - 32) * 32 + head) * 256) * 128; }
__device__ __forceinline__ size_t hm_head(int pm) { return pm < 32 ? (size_t)4096 * 128 : (size_t)256 * 128; }
struct EpiNaIn {
    static constexpr bool PERM = true, AFTER_DRAIN = false, TWICE = (EPI_TWICE & 2) != 0;
    bf16_t *Q, *K, *V, *G; const float* qkn; PG8_LAS float* P; const facc_t* rowss; const facc_t* bias2;
    __device__ __forceinline__ void operator()(const f32x4 (&acc0)[2][2][4][2], const Unit& u, int wr, int wc, int fr, int fq) const {
        const int t = u.pn >> 4; bf16_t* base = t == 0 ? Q : (t == 1 ? K : (t == 2 ? V : G));
        const int row0 = u.pm * BM + wr * 64 + fr, col0 = (u.pn & 15) * BM + wc * 32 + 8 * fq;
        bf16_t* hmb = base + hm_panel(u.pm, 2 * (u.pn & 15)) + (size_t)(wr * 64 + fr) * 128 + wc * 32 + 8 * fq; const size_t hmh = hm_head(u.pm);
        f32x4 acc[2][2][4][2];
        { const facc_t* b2 = bias2 + (size_t)(u.pm < 32 ? (u.pm >> 4) : 2) * NB2 + u.pn * BM + wc * 32 + 8 * fq;
          f32x4 bb[2][2]; float riv[2][4];
          epi_in_loads(rowss, b2, row0, bb, riv);
#pragma unroll
          for (int ai = 0; ai < 2; ++ai)
#pragma unroll
              for (int m = 0; m < 4; ++m) { const float ri = riv[ai][m];
#pragma unroll
                  for (int bj = 0; bj < 2; ++bj) { acc[ai][bj][m][0] = acc0[ai][bj][m][0] * ri + bb[bj][0]; acc[ai][bj][m][1] = acc0[ai][bj][m][1] * ri + bb[bj][1]; } } }
        if (t < 2) {
#pragma unroll
            for (int ai = 0; ai < 2; ++ai)
#pragma unroll
                for (int m = 0; m < 4; ++m)
#pragma unroll
                    for (int bj = 0; bj < 2; ++bj) { const f32x4 a = acc[ai][bj][m][0], b = acc[ai][bj][m][1];
                        float s = (a[0] * a[0] + a[1] * a[1]) + (a[2] * a[2] + a[3] * a[3]) + (b[0] * b[0] + b[1] * b[1]) + (b[2] * b[2] + b[3] * b[3]);
                        s = xrow16_sum(s);
                        if (fq == 0) P[((ai * HALF + wr * 64 + m * 16 + fr) * 2 + bj) * 4 + wc] = s; }
            asm volatile("s_waitcnt lgkmcnt(0)" ::: "memory"); __builtin_amdgcn_s_barrier(); asm volatile("" ::: "memory");
            const float* wg = qkn + t * 128 + wc * 32 + 8 * fq; const f32x4 w0 = *(const PG8_GAS f32x4*)wg, w1 = *(const PG8_GAS f32x4*)(wg + 4);
            float rq[2][4][2];
#pragma unroll
            for (int ai = 0; ai < 2; ++ai)
#pragma unroll
                for (int m = 0; m < 4; ++m)
#pragma unroll
                    for (int bj = 0; bj < 2; ++bj) { const f32x4 p = *(const PG8_LAS f32x4*)(P + ((ai * HALF + wr * 64 + m * 16 + fr) * 2 + bj) * 4);
                        rq[ai][m][bj] = __builtin_amdgcn_rsqf(((p[0] + p[1]) + (p[2] + p[3])) * (1.0f / 128.0f) + 1e-6f); }
#pragma unroll
            for (int ai = 0; ai < 2; ++ai)
#pragma unroll
                for (int m = 0; m < 4; ++m) { const int row = row0 + ai * HALF + m * 16;
                    bf16_t* rowp = t == 1 ? hmb + (size_t)(ai * HALF + m * 16) * 128 : base + (size_t)row * DM + col0;
#pragma unroll
                    for (int bj = 0; bj < 2; ++bj) { const float rinv = rq[ai][m][bj];
                        const f32x4 v0 = acc[ai][bj][m][0] * rinv * w0, v1 = acc[ai][bj][m][1] * rinv * w1;
                        u32x4 w; w.x = cvt_pk_bf16(v0[0], v0[1]); w.y = cvt_pk_bf16(v0[2], v0[3]); w.z = cvt_pk_bf16(v1[0], v1[1]); w.w = cvt_pk_bf16(v1[2], v1[3]);
                        *(PG8_GAS u32x4*)(rowp + (t == 1 ? bj * hmh : (size_t)(bj * HALF))) = w; } }
        } else {
#pragma unroll
            for (int ai = 0; ai < 2; ++ai)
#pragma unroll
                for (int m = 0; m < 4; ++m) { const int row = row0 + ai * HALF + m * 16;
                    bf16_t* rowp = t == 2 ? hmb + (size_t)(ai * HALF + m * 16) * 128 : base + (size_t)row * DM + col0;
#pragma unroll
                    for (int bj = 0; bj < 2; ++bj) { f32x4 v0 = acc[ai][bj][m][0], v1 = acc[ai][bj][m][1];
                        if (t == 3) { v0 = silu4(v0); v1 = silu4(v1); }
                        u32x4 w; w.x = cvt_pk_bf16(v0[0], v0[1]); w.y = cvt_pk_bf16(v0[2], v0[3]); w.z = cvt_pk_bf16(v1[0], v1[1]); w.w = cvt_pk_bf16(v1[2], v1[3]);
                        *(PG8_GAS u32x4*)(rowp + (t == 2 ? bj * hmh : (size_t)(bj * HALF))) = w; } }
        }
    }
};
template <bool SRC_BF16, bool DST_BF16>
struct EpiOut {
    static constexpr bool PERM = true, AFTER_DRAIN = false, TWICE = false;
    const void* src_lat; const void* src_ctx; void* dst; const float* gate;
    const float* rgs;
    bf16_t* XG; const float* gsn; facc_t* rowss_n; PG8_LAS float* P; float ssw;
    __device__ __forceinline__ void operator()(const f32x4 (&acc)[2][2][4][2], const Unit& u, int wr, int wc, int fr, int fq) const {
        const int row0 = u.pm * BM + wr * 64 + fr, col0 = u.pn * BM + wc * 32 + 8 * fq; const int r = u.pm < 32 ? (u.pm >> 4) : 2;
        const float* gp = gate + (size_t)r * (3 * DM) + col0;
        f32x4 gv[2][2], gs[2][2], rg[2][2];
#pragma unroll
        for (int bj = 0; bj < 2; ++bj)
#pragma unroll
            for (int n = 0; n < 2; ++n) { gv[bj][n] = *(const PG8_GAS f32x4*)(gp + bj * HALF + n * 4); gs[bj][n] = XG ? *(const PG8_GAS f32x4*)(gsn + (size_t)r * DM + col0 + bj * HALF + n * 4) : (f32x4){0.f, 0.f, 0.f, 0.f};
                rg[bj][n] = SRC_BF16 ? *(const PG8_GAS f32x4*)(rgs + (size_t)r * DM + col0 + bj * HALF + n * 4) : (f32x4){1.f, 1.f, 1.f, 1.f}; }
        f32x4 sv[4][2][2]; u32x4 sb[4][2];
#define EPIOUT_REQ(AIH) do { const int ai_ = (AIH) >> 1, mh_ = ((AIH) & 1) * 2; _Pragma("unroll") for (int m = mh_; m < mh_ + 2; ++m) { const int row = row0 + ai_ * HALF + m * 16; \
                const size_t so = (row < 8192 ? (size_t)row * DM : (size_t)(row - 8192) * DM) + col0; \
                _Pragma("unroll") for (int bj = 0; bj < 2; ++bj) { \
                    if (SRC_BF16) sb[m][bj] = *(const PG8_GAS u32x4*)((const bf16_t*)(row < 8192 ? src_lat : src_ctx) + so + bj * HALF); \
                    else { const float* sp = (const float*)(row < 8192 ? src_lat : src_ctx) + so + bj * HALF; sv[m][bj][0] = *(const PG8_GAS f32x4*)sp; sv[m][bj][1] = *(const PG8_GAS f32x4*)(sp + 4); } } } } while (0)
        if (SRC_BF16) EPIOUT_REQ(0);
#pragma unroll
        for (int aih = 0; aih < 4; ++aih) { const int ai = aih >> 1, mh = (aih & 1) * 2;
            if (SRC_BF16) { if (aih + 1 < 4) EPIOUT_REQ(aih + 1); } else EPIOUT_REQ(aih);
            asm volatile("" ::: "memory");
#pragma unroll
            for (int m = mh; m < mh + 2; ++m) { const int row = row0 + ai * HALF + m * 16;
                float ss = 0.f;
#pragma unroll
                for (int bj = 0; bj < 2; ++bj) {
                    if (SRC_BF16) { const u32x4 w = sb[m][bj];
                        sv[m][bj][0] = (f32x4){__uint_as_float(w.x << 16), __uint_as_float(w.x & 0xffff0000u), __uint_as_float(w.y << 16), __uint_as_float(w.y & 0xffff0000u)} * rg[bj][0];
                        sv[m][bj][1] = (f32x4){__uint_as_float(w.z << 16), __uint_as_float(w.z & 0xffff0000u), __uint_as_float(w.w << 16), __uint_as_float(w.w & 0xffff0000u)} * rg[bj][1]; }
                    const f32x4 o0 = sv[m][bj][0] + gv[bj][0] * acc[ai][bj][m][0], o1 = sv[m][bj][1] + gv[bj][1] * acc[ai][bj][m][1];
                    if (!DST_BF16) { float* dp = (float*)dst + (size_t)row * DM + col0 + bj * HALF; *(PG8_GAS f32x4*)dp = o0; *(PG8_GAS f32x4*)(dp + 4) = o1; }
                    if (XG) { ss += (o0[0] * o0[0] + o0[1] * o0[1]) + (o0[2] * o0[2] + o0[3] * o0[3]) + (o1[0] * o1[0] + o1[1] * o1[1]) + (o1[2] * o1[2] + o1[3] * o1[3]);
                        const f32x4 y0 = o0 * gs[bj][0], y1 = o1 * gs[bj][1];
                        u32x4 w; w.x = cvt_pk_bf16(y0[0], y0[1]); w.y = cvt_pk_bf16(y0[2], y0[3]); w.z = cvt_pk_bf16(y1[0], y1[1]); w.w = cvt_pk_bf16(y1[2], y1[3]);
                        *(PG8_GAS u32x4*)(XG + (size_t)row * DM + col0 + bj * HALF) = w; } }
                if (XG) { ss = xrow16_sum(ss); if (fq == 0) __hip_atomic_fetch_add((PG8_GAS facc_t*)(rowss_n + row), (facc_t)(ss * (ssw * RS_SCALE) + 0.5f), __ATOMIC_RELAXED, __HIP_MEMORY_SCOPE_AGENT); } }
        }
#undef EPIOUT_REQ
    }
};

template <class Epi, class Sched, bool ALIGN_EPI = false, bool SP2 = false>
__device__ __forceinline__ void gemm_phase(PG8_LAS unsigned char* lds, const Gemm g, const Sched& S, const Epi& E) {
    int tid_o = threadIdx.x; asm volatile("" : "+v"(tid_o));
    const int tid = tid_o, wid = __builtin_amdgcn_readfirstlane(tid >> 6), lane = tid & 63, wr = wid >> 2, wc = wid & 3, fr = lane & 15, fq = lane >> 4;
    const int K = g.K, nt = K / BK;
    unsigned voffA[2], voffB[2];
#pragma unroll
    for (int i = 0; i < 2; ++i) { int R, C; stage_rc(tid * 16 + i * 8192, R, C); const int Rb = Epi::PERM ? ((R & ~31) + perm32(R & 31)) : R;
        voffA[i] = (unsigned)(R * K + C) * 2u; voffB[i] = (unsigned)(Rb * K + C) * 2u; }
    const size_t kstep = (size_t)(BK * 2);
    const size_t hstep = (size_t)HALF * K * 2;
    const size_t tstep = 2 * hstep;
    const unsigned ldsw = (unsigned)wid * 1024u;
    const int aoff = lds_byte(wr * 64 + fr, fq * 8), boff = lds_byte(wc * 32 + fr, fq * 8);
#define PG8_SA(b, h) (((b) * 2 + (h)) * HTB)
#define PG8_SB(b, h) ((4 + (b) * 2 + (h)) * HTB)
#define PG8_STAGE(bufoff, gbase, voff) do { _Pragma("unroll") for (int _i = 0; _i < 2; ++_i) \
        __builtin_amdgcn_global_load_lds((const unsigned*)((const char*)(gbase) + (voff)[_i]), (PG8_LAS unsigned*)(lds + (bufoff) + ldsw + _i * 8192), 16, 0, 0); } while (0)
#define PG8_LDA(dst, b, h) do { _Pragma("unroll") for (int m = 0; m < 4; ++m) _Pragma("unroll") for (int k = 0; k < 2; ++k) dst[m][k] = *(const PG8_LAS bf16x8*)(lds + PG8_SA(b, h) + aoff + m * 2048 + k * 1024); } while (0)
#define PG8_LDB(dst, b, h) do { _Pragma("unroll") for (int n = 0; n < 2; ++n) _Pragma("unroll") for (int k = 0; k < 2; ++k) dst[n][k] = *(const PG8_LAS bf16x8*)(lds + PG8_SB(b, h) + boff + n * 2048 + k * 1024); } while (0)
#ifndef PG8_PRIO
#define PG8_PRIO 1
#endif
#define PG8_MMA(ai, bj, At, Bt) do { if (PG8_PRIO) __builtin_amdgcn_s_setprio(1); _Pragma("unroll") for (int m = 0; m < 4; ++m) _Pragma("unroll") for (int n = 0; n < 2; ++n) _Pragma("unroll") for (int k = 0; k < 2; ++k) \
        acc[ai][bj][m][n] = __builtin_amdgcn_mfma_f32_16x16x32_bf16(Bt[n][k], At[m][k], acc[ai][bj][m][n], 0, 0, 0); if (PG8_PRIO) __builtin_amdgcn_s_setprio(0); } while (0)
#define PG8_WAIT_V(n) asm volatile("s_waitcnt vmcnt(" #n ")" ::: "memory")
#define PG8_WAIT_L(n) asm volatile("s_waitcnt lgkmcnt(" #n ")" ::: "memory")
#define PG8_BAR __builtin_amdgcn_s_barrier()
#define PG8_SCHED __builtin_amdgcn_sched_barrier(0)
    Unit cur, nxt; int ui = 0;
    if (!S.next(0, cur)) return;
    f32x4 acc[2][2][4][2];
#pragma unroll
    for (int a = 0; a < 2; ++a)
#pragma unroll
        for (int b = 0; b < 2; ++b)
#pragma unroll
            for (int m = 0; m < 4; ++m)
#pragma unroll
                for (int n = 0; n < 2; ++n) acc[a][b][m][n] = (f32x4){0.f, 0.f, 0.f, 0.f};
    bf16x8 At[4][2], B0[2][2], B1[2][2];
    const char* cA = (const char*)g.A + (size_t)cur.pm * tstep; const char* cB = (const char*)g.Bt + (size_t)cur.pn * tstep;
    S.a_ready(cur);
    if constexpr (SP2) {
        PG8_STAGE(PG8_SB(0, 0), cB, voffB); PG8_STAGE(PG8_SB(0, 1), cB + hstep, voffB); PG8_STAGE(PG8_SA(0, 0), cA, voffA); PG8_STAGE(PG8_SA(0, 1), cA + hstep, voffA);
        if (wr == 1) PG8_BAR;
        PG8_WAIT_V(2); PG8_BAR;
        PG8_STAGE(PG8_SB(1, 0), cB + kstep, voffB); PG8_STAGE(PG8_SA(1, 0), cA + kstep, voffA); PG8_STAGE(PG8_SB(1, 1), cB + hstep + kstep, voffB);
        PG8_WAIT_V(6); PG8_BAR;
    } else {
        PG8_STAGE(PG8_SB(0, 0), cB, voffB); PG8_STAGE(PG8_SA(0, 0), cA, voffA); PG8_STAGE(PG8_SB(0, 1), cB + hstep, voffB); PG8_STAGE(PG8_SA(0, 1), cA + hstep, voffA);
        if (wr == 1) PG8_BAR;
        PG8_WAIT_V(4); PG8_BAR;
        PG8_STAGE(PG8_SB(1, 0), cB + kstep, voffB); PG8_STAGE(PG8_SA(1, 0), cA + kstep, voffA); PG8_STAGE(PG8_SB(1, 1), cB + hstep + kstep, voffB);
        PG8_WAIT_V(6); PG8_BAR;
    }
    for (;;) {
        const bool has_next = S.next(ui + 1, nxt);
        const char* nA = has_next ? (const char*)g.A + (size_t)nxt.pm * tstep : cA; const char* nB = has_next ? (const char*)g.Bt + (size_t)nxt.pn * tstep : cB;
        for (int t = 0; t < nt; t += 2) {
            const bool last = (t == nt - 2);
            const char* a1 = cA + (size_t)(t + 1) * kstep;
            const char* a2 = last ? nA : cA + (size_t)(t + 2) * kstep; const char* b2 = last ? nB : cB + (size_t)(t + 2) * kstep;
            const char* a3 = a2 + kstep; const char* b3 = b2 + kstep;
            if (last && has_next) S.a_ready(nxt);
            if constexpr (SP2) {
            PG8_LDB(B0, 0, 0); PG8_LDB(B1, 0, 1); PG8_SCHED; PG8_LDA(At, 0, 0); PG8_STAGE(PG8_SA(1, 1), a1 + hstep, voffA);
            PG8_WAIT_V(8); PG8_WAIT_L(0); PG8_BAR; PG8_MMA(0, 0, At, B0); PG8_MMA(0, 1, At, B1); PG8_BAR; PG8_SCHED;
            PG8_LDA(At, 0, 1); PG8_STAGE(PG8_SB(0, 0), b2, voffB); PG8_STAGE(PG8_SB(0, 1), b2 + hstep, voffB); PG8_STAGE(PG8_SA(0, 0), a2, voffA);
            PG8_WAIT_V(8); PG8_WAIT_L(0); PG8_BAR; PG8_MMA(1, 0, At, B0); PG8_MMA(1, 1, At, B1); PG8_BAR; PG8_SCHED;
            PG8_LDB(B0, 1, 0); PG8_LDB(B1, 1, 1); PG8_SCHED; PG8_LDA(At, 1, 0); PG8_STAGE(PG8_SA(0, 1), a2 + hstep, voffA);
            PG8_WAIT_V(8); PG8_WAIT_L(0); PG8_BAR; PG8_MMA(0, 0, At, B0); PG8_MMA(0, 1, At, B1); PG8_BAR; PG8_SCHED;
            PG8_LDA(At, 1, 1); PG8_STAGE(PG8_SB(1, 0), b3, voffB); PG8_STAGE(PG8_SB(1, 1), b3 + hstep, voffB); PG8_STAGE(PG8_SA(1, 0), a3, voffA);
            PG8_WAIT_V(8); PG8_WAIT_L(0); PG8_BAR; PG8_MMA(1, 0, At, B0); PG8_MMA(1, 1, At, B1); PG8_BAR; PG8_SCHED;
            } else {
            PG8_LDB(B0, 0, 0); PG8_SCHED; PG8_LDA(At, 0, 0); PG8_STAGE(PG8_SA(1, 1), a1 + hstep, voffA);
            PG8_WAIT_L(8); PG8_BAR; PG8_WAIT_L(0); PG8_MMA(0, 0, At, B0); PG8_BAR; PG8_SCHED;
            PG8_LDB(B1, 0, 1); PG8_STAGE(PG8_SB(0, 0), b2, voffB);
            PG8_BAR; PG8_WAIT_L(0); PG8_MMA(0, 1, At, B1); PG8_BAR;
            PG8_LDA(At, 0, 1); PG8_STAGE(PG8_SA(0, 0), a2, voffA);
            PG8_BAR; PG8_WAIT_L(0); PG8_MMA(1, 0, At, B0); PG8_BAR; PG8_SCHED;
            PG8_STAGE(PG8_SB(0, 1), b2 + hstep, voffB);
            PG8_WAIT_V(6); PG8_BAR; PG8_MMA(1, 1, At, B1); PG8_BAR;
            PG8_LDB(B0, 1, 0); PG8_SCHED; PG8_LDA(At, 1, 0); PG8_STAGE(PG8_SA(0, 1), a2 + hstep, voffA);
            PG8_WAIT_L(8); PG8_BAR; PG8_WAIT_L(0); PG8_MMA(0, 0, At, B0); PG8_BAR; PG8_SCHED;
            PG8_LDB(B1, 1, 1); PG8_STAGE(PG8_SB(1, 0), b3, voffB);
            PG8_BAR; PG8_WAIT_L(0); PG8_MMA(0, 1, At, B1); PG8_BAR;
            PG8_LDA(At, 1, 1); PG8_STAGE(PG8_SA(1, 0), a3, voffA);
            PG8_BAR; PG8_WAIT_L(0); PG8_MMA(1, 0, At, B0); PG8_BAR; PG8_SCHED;
            PG8_STAGE(PG8_SB(1, 1), b3 + hstep, voffB);
            PG8_WAIT_V(6); PG8_BAR; PG8_MMA(1, 1, At, B1); PG8_BAR;
            }
        }
        if constexpr (ALIGN_EPI) { if (wr == 0) PG8_BAR; }
        if constexpr (!Epi::AFTER_DRAIN) { if constexpr (Epi::TWICE) { int ne_ = 2; asm volatile("" : "+s"(ne_)); _Pragma("unroll 1") for (int e_ = 0; e_ < ne_; ++e_) { asm volatile("" ::: "memory"); E(acc, cur, wr, wc, fr, fq); } } else E(acc, cur, wr, wc, fr, fq); S.done(cur); }
        if (!has_next) break;
#pragma unroll
        for (int a = 0; a < 2; ++a)
#pragma unroll
            for (int b = 0; b < 2; ++b)
#pragma unroll
                for (int m = 0; m < 4; ++m)
#pragma unroll
                    for (int n = 0; n < 2; ++n) acc[a][b][m][n] = (f32x4){0.f, 0.f, 0.f, 0.f};
        cur = nxt; cA = nA; cB = nB; ++ui;
        if constexpr (ALIGN_EPI) { if (wr == 1) PG8_BAR; }
    }
    PG8_WAIT_V(0);
    if constexpr (!ALIGN_EPI) { if (wr == 0) PG8_BAR; }
    PG8_BAR;
    if constexpr (Epi::AFTER_DRAIN) { E.fused(acc, cur, wr, wc, fr, fq, lds, wid, lane); S.done(cur); }
#undef PG8_SA
#undef PG8_SB
#undef PG8_STAGE
#undef PG8_LDA
#undef PG8_LDB
#undef PG8_MMA
#undef PG8_WAIT_V
#undef PG8_WAIT_L
#undef PG8_BAR
#undef PG8_SCHED
}
}

#ifndef EPIOUT_ALIGN
#define EPIOUT_ALIGN true
#endif
#ifndef PG8_SP2V
#define PG8_SP2V true
#endif
constexpr int NWAVES = 8;
constexpr int D = 4096, NBATCH = 2, SEQ = 4096, CTXL = 256, DEPTH = 4, NHEAD = 32, HDIM = 128;
constexpr int ML = NBATCH * SEQ;
constexpr int MC = NBATCH * CTXL;
constexpr int MT = ML + MC;
constexpr float EPS = 1e-6f;
constexpr float LOG2E = 1.4426950408889634f;
constexpr float ATTN_C1 = 0.08838834764831845f * LOG2E;

#ifndef DUP_MASK
#define DUP_MASK 0
#endif
#define NREP(x) (1 + ((DUP_MASK >> (x)) & 1))
#ifndef MK_PER_PHASE
#define MK_PER_PHASE 0
#endif
constexpr int NPHASE = 18;

constexpr size_t MiB = 1u << 20;
constexpr size_t WS_CTL = 0, CTL_ZERO_BYTES = 4 * MiB;
constexpr size_t WS_MOD = 1 * MiB;
constexpr size_t WS_WGATE = 8 * MiB;
constexpr size_t WS_WLIN = 24 * MiB;
constexpr size_t WS_WLOUT = 152 * MiB;
constexpr size_t WS_WNIN = 216 * MiB;
constexpr size_t WS_WNOUT = 472 * MiB;
constexpr size_t WS_H = 672 * MiB;
constexpr size_t WS_A = 740 * MiB, WS_B = 808 * MiB, WS_C = 876 * MiB, WS_D = 944 * MiB;
constexpr size_t WS_AGG2 = 1012 * MiB;
constexpr size_t WS_CARRY = 1022 * MiB;
constexpr size_t WS_E = 1028 * MiB;
constexpr size_t WS_GS = 1096 * MiB;
constexpr size_t WS_COEF = 1097 * MiB;
constexpr size_t WS_RGS = 1370 * MiB;
constexpr size_t WS_END = 1371 * MiB;
constexpr size_t CTL_ROWSS = 2 * MiB;
constexpr size_t CTL_BIAS2 = 2 * MiB + 512 * 1024;
constexpr int CW_BAR = 4096;

constexpr int RING_BYTES = 131072;
constexpr int EPI_P_OFF = RING_BYTES;
constexpr int MISC_OFF = RING_BYTES + 8192 + 320;
constexpr int LDS_BYTES = 147456;

#define GAS __attribute__((address_space(1)))
#define LAS __attribute__((address_space(3)))
#define DI __device__ __forceinline__
typedef unsigned short bf16;
typedef unsigned v4u __attribute__((ext_vector_type(4)));
typedef unsigned v2u __attribute__((ext_vector_type(2)));
typedef float f32x4 __attribute__((ext_vector_type(4)));
typedef float f32x16 __attribute__((ext_vector_type(16)));
typedef short bf16x8 __attribute__((ext_vector_type(8)));
typedef short s16x4 __attribute__((ext_vector_type(4)));
#define LDS_WAIT() asm volatile("s_waitcnt lgkmcnt(0)" ::: "memory")
#define VM_WAIT() asm volatile("s_waitcnt vmcnt(0)" ::: "memory")
DI unsigned pk2(float lo, float hi) { return pg8::cvt_pk_bf16(lo, hi); }
DI float bflo(unsigned w) { return __uint_as_float(w << 16); }
DI float bfhi(unsigned w) { return __uint_as_float(w & 0xffff0000u); }
DI float fast_exp2(float x) { return __builtin_amdgcn_exp2f(x); }
DI float fast_rcp(float x) { return __builtin_amdgcn_rcpf(x); }

#define XB_TMO      128
#define XB_XCNT(j)  (256  + 64 * (j))
#define XB_XSUB(j)  (1280 + 64 * (j))
#define XB_XGEN(j)  (2304 + 64 * (j))
#define XB_TOP      3328
#define XB_TOPGEN   3392
#define XCD_BAR_WORDS 3456
#define XB_SPIN_CAP (1u << 18)
__device__ __forceinline__ unsigned xb_ld(unsigned* p)              { return __hip_atomic_load(p, __ATOMIC_RELAXED, __HIP_MEMORY_SCOPE_AGENT); }
__device__ __forceinline__ unsigned xb_add(unsigned* p, unsigned v) { return __hip_atomic_fetch_add(p, v, __ATOMIC_RELAXED, __HIP_MEMORY_SCOPE_AGENT); }
__device__ __forceinline__ unsigned xb_xcc_id() { return (unsigned)__builtin_amdgcn_s_getreg((3 << 11) | 20) & 0xFu; }
#define XB_SPIN(cond, bar) do { unsigned _sp = 0; while (cond) { __builtin_amdgcn_s_sleep(1); \
    if ((++_sp & 255u) == 0u) { if (xb_ld(&(bar)[XB_TMO])) break; if (_sp > XB_SPIN_CAP) { atomicAdd(&(bar)[XB_TMO], 1u); break; } } } } while (0)
struct XcdBarrier { unsigned* bar; unsigned x; volatile LAS unsigned* st; };
__device__ __forceinline__ XcdBarrier xcd_barrier_post(unsigned* bar, volatile LAS unsigned* st) {
    XcdBarrier b; b.bar = bar; b.x = xb_xcc_id(); b.st = st;
    if (threadIdx.x == 0) (void)xb_add(&bar[XB_XCNT(b.x)], 1u);
    return b;
}
__device__ __forceinline__ void xcd_barrier_complete(unsigned* bar, unsigned x, unsigned& nloc, unsigned& nx) {
    const unsigned G = gridDim.x * gridDim.y * gridDim.z;
    unsigned sum, cnt, mine, sp = 0u;
    for (;;) {
        sum = 0u; cnt = 0u; mine = 0u;
#pragma unroll
        for (unsigned j0 = 0; j0 < 16; j0 += 8) {
            unsigned c8[8];
#pragma unroll
            for (unsigned j = 0; j < 8; ++j) c8[j] = xb_ld(&bar[XB_XCNT(j0 + j)]);
            asm volatile("" : "+v"(c8[0]), "+v"(c8[1]), "+v"(c8[2]), "+v"(c8[3]), "+v"(c8[4]), "+v"(c8[5]), "+v"(c8[6]), "+v"(c8[7]));
#pragma unroll
            for (unsigned j = 0; j < 8; ++j) { const unsigned c = c8[j]; sum += c; cnt += (c > 0u) ? 1u : 0u; mine = (j0 + j == x) ? c : mine; } }
        if (sum == G) break;
        __builtin_amdgcn_s_sleep(1);
        if ((++sp & 255u) == 0u) { if (xb_ld(&bar[XB_TMO])) break; if (sp > XB_SPIN_CAP) { atomicAdd(&bar[XB_TMO], 1u); break; } }
    }
    nloc = mine > 0u ? mine : 1u; nx = cnt > 0u ? cnt : 1u;
}
__device__ __forceinline__ void xcd_barrier(const XcdBarrier& b) {
    asm volatile("s_waitcnt vmcnt(0)" ::: "memory");
    __syncthreads();
    if (threadIdx.x == 0) {
        unsigned* bar = b.bar;
        __builtin_amdgcn_s_waitcnt(0);
        const unsigned bx_ = xb_xcc_id();
        unsigned nloc = b.st[0], nx = b.st[1];
        if (nloc == 0u) { xcd_barrier_complete(bar, bx_, nloc, nx); b.st[0] = nloc; b.st[1] = nx; }
        const unsigned old = xb_add(&bar[XB_XSUB(bx_)], 1u);
        const unsigned gen = old / nloc;
        if (old + 1u == (gen + 1u) * nloc) {
            __builtin_amdgcn_fence(__ATOMIC_RELEASE, "agent");
            asm volatile("s_waitcnt vmcnt(0)" ::: "memory");
            const unsigned og = xb_add(&bar[XB_TOP], 1u);
            const unsigned tg = og / nx;
            if (og + 1u == (tg + 1u) * nx) xb_add(&bar[XB_TOPGEN], 1u);
            else XB_SPIN(xb_ld(&bar[XB_TOPGEN]) == tg, bar);
            __builtin_amdgcn_fence(__ATOMIC_ACQUIRE, "agent");
            xb_add(&bar[XB_XGEN(bx_)], 1u);
            asm volatile("s_waitcnt vmcnt(0)" ::: "memory");
        } else {
            XB_SPIN(xb_ld(&bar[XB_XGEN(bx_)]) == gen, bar);
            __builtin_amdgcn_fence(__ATOMIC_ACQUIRE, "agent");
            asm volatile("s_waitcnt vmcnt(0)" ::: "memory");
        }
    }
    __syncthreads();
}

struct Args { const float* in[18]; float* out; unsigned char* ws; int ph_lo, ph_hi; };
enum { I_X = 0, I_C, I_CTX, I_CCTX, I_ADAW, I_ADAB, I_NORMG, I_LIN, I_LCONVW, I_LCONVB, I_LGATEW, I_LGATEB, I_LLAM, I_LOUT, I_NIN, I_NQKN, I_NRPB, I_NOUT };

DI float wave_sum(float v) {
#pragma unroll
    for (int o = 1; o < 64; o <<= 1) v += __shfl_xor(v, o);
    return v;
}

DI void tr_load(const float* W, int N, int item, int lane, f32x4 (&v)[16]) {
    const int nblk = N >> 6, kb = item / nblk, nb = item - kb * nblk;
    const GAS float* p = (const GAS float*)W + (size_t)(64 * kb + (lane >> 4)) * N + 64 * nb + 4 * (lane & 15);
#pragma unroll
    for (int i = 0; i < 16; ++i) v[i] = __builtin_nontemporal_load((const GAS f32x4*)(p + (size_t)(4 * i) * N));
}
DI void tr_store(bf16* WT, int K, int N, int item, int lane, LAS float* scr, const f32x4 (&v)[16], const float* shift, pg8::facc_t* bias2) {
    const int nblk = N >> 6, kb = item / nblk, nb = item - kb * nblk;
    { LAS float* w = scr + (lane >> 4) * 65 + 4 * (lane & 15);
#pragma unroll
      for (int i = 0; i < 16; ++i) { w[(4 * i) * 65 + 0] = v[i][0]; w[(4 * i) * 65 + 1] = v[i][1]; w[(4 * i) * 65 + 2] = v[i][2]; w[(4 * i) * 65 + 3] = v[i][3]; } }
    LDS_WAIT(); asm volatile("" ::: "memory");
    if (shift) {
        const float h0 = shift[64 * kb + lane], h1 = shift[3 * D + 64 * kb + lane], h2 = shift[6 * D + 64 * kb + lane];
        float s0 = 0.f, s1 = 0.f, s2 = 0.f;
#pragma unroll
        for (int k = 0; k < 64; ++k) { const float w = scr[k * 65 + lane];
            s0 += __builtin_bit_cast(float, __builtin_amdgcn_readlane(__builtin_bit_cast(int, h0), k)) * w;
            s1 += __builtin_bit_cast(float, __builtin_amdgcn_readlane(__builtin_bit_cast(int, h1), k)) * w;
            s2 += __builtin_bit_cast(float, __builtin_amdgcn_readlane(__builtin_bit_cast(int, h2), k)) * w; }
        pg8::facc_t* bp = bias2 + 64 * nb + lane;
        atomicAdd(bp, (pg8::facc_t)(int)rintf(s0 * pg8::B2_SCALE)); atomicAdd(bp + pg8::NB2, (pg8::facc_t)(int)rintf(s1 * pg8::B2_SCALE)); atomicAdd(bp + 2 * pg8::NB2, (pg8::facc_t)(int)rintf(s2 * pg8::B2_SCALE));
    }
    const int c = lane & 7;
#pragma unroll
    for (int j = 0; j < 8; ++j) { const int n = (lane >> 3) + 8 * j; const LAS float* q = scr + (8 * c) * 65 + n;
        v4u o; o.x = pk2(q[0 * 65], q[1 * 65]); o.y = pk2(q[2 * 65], q[3 * 65]); o.z = pk2(q[4 * 65], q[5 * 65]); o.w = pk2(q[6 * 65], q[7 * 65]);
        __builtin_nontemporal_store(o, (GAS v4u*)(WT + (size_t)(64 * nb + n) * K + 64 * kb + 8 * c)); }
    LDS_WAIT(); asm volatile("" ::: "memory");
}

struct BgTasks { int ada_layer, gate_lj, tr0, tr1, ada_lo = 0, ada_hi = 192; };
DI void bg_run(const Args& a, LAS unsigned char* lds, int tid, int wave, int lane, int widx, int nw, const BgTasks t) {
    asm volatile("" : "+v"(tid), "+v"(lane));
    unsigned char* ws = a.ws;
    if (t.ada_layer >= 0) {
        const int i = t.ada_layer;
        LAS f32x4* condL = (LAS f32x4*)lds;
        LAS float* red = (LAS float*)(lds + 65536);
        const float* c = a.in[I_C]; const float* cc = a.in[I_CCTX];
        for (int k = tid; k < D; k += NWAVES * 64) { f32x4 v; v[0] = pg8::silu_f(c[k]); v[1] = pg8::silu_f(c[D + k]); v[2] = pg8::silu_f(cc[k]); v[3] = 0.f; condL[k] = v; }
        __syncthreads();
        float* mod = (float*)(ws + WS_MOD);
        const int cw = nw >= 256 ? 48 : 64, ilo = nw >= 256 ? 0 : t.ada_lo, ihi = nw >= 256 ? (3 * D) / 48 : t.ada_hi;
        for (int item = ilo + widx; item < ihi; item += nw) {
            const int n0 = item * cw;
            const float* wp = a.in[I_ADAW] + ((size_t)i * D + wave * 512) * (3 * D) + n0 + lane;
            float a0 = 0.f, a1 = 0.f, a2 = 0.f;
            if (lane < cw) for (int kk = 0; kk < 512; kk += 32) {
                float w[32];
#pragma unroll
                for (int j = 0; j < 32; ++j) w[j] = __builtin_nontemporal_load(wp + (size_t)(kk + j) * (3 * D));
#pragma unroll
                for (int j = 0; j < 32; ++j) { const f32x4 cv = condL[wave * 512 + kk + j]; a0 += cv[0] * w[j]; a1 += cv[1] * w[j]; a2 += cv[2] * w[j]; }
            }
            red[(wave * 3 + 0) * 64 + lane] = a0; red[(wave * 3 + 1) * 64 + lane] = a1; red[(wave * 3 + 2) * 64 + lane] = a2;
            __syncthreads();
            if (tid < 192 && (tid & 63) < cw) { const int r = tid >> 6, l = tid & 63, n = n0 + l; float s = 0.f;
#pragma unroll
                for (int w8 = 0; w8 < 8; ++w8) s += red[(w8 * 3 + r) * 64 + l];
                const float val = s + a.in[I_ADAB][(size_t)i * (3 * D) + n];
                mod[((size_t)i * 3 + r) * (3 * D) + n] = val;
                if (n >= D && n < 2 * D) { float gsx = a.in[I_NORMG][(size_t)i * D + n - D] * (1.0f + val);
                    if (!(fabsf(gsx) >= 1e-18f)) gsx = gsx < 0.f ? -1e-18f : 1e-18f;
                    ((float*)(ws + WS_GS))[((size_t)i * 3 + r) * D + n - D] = gsx; ((float*)(ws + WS_RGS))[((size_t)i * 3 + r) * D + n - D] = 1.0f / gsx; } }
            __syncthreads();
        }
    }
    if (t.gate_lj >= 0) {
        const float* gw = a.in[I_LGATEW]; v4u* dst = (v4u*)(ws + WS_WGATE);
        for (int f0 = widx * (NWAVES * 64) + tid; f0 < 16 * 2 * 8 * 2 * 16 * 64; f0 += nw * NWAVES * 64) {
            const int f = f0 + (t.gate_lj << 19);
            const int ln = f & 63, ks = (f >> 6) & 15, gate = (f >> 10) & 1, jt = (f >> 11) & 7, dir = (f >> 14) & 1, nb = (f >> 15) & 15, lj = f >> 19;
            const int k0 = ks * 16 + 8 * (ln >> 5), j = jt * 32 + (ln & 31);
            const float* s = gw + ((((size_t)(lj * 2 + dir) * 2 + gate) * 16 + nb) * 256 + k0) * 256 + j;
            v4u o; o.x = pk2(s[0], s[256]); o.y = pk2(s[512], s[768]); o.z = pk2(s[1024], s[1280]); o.w = pk2(s[1536], s[1792]);
            dst[f] = o;
        }
    }
    {
        LAS float* scr = (LAS float*)(lds + wave * 16640);
#ifndef BG_WAVES
#define BG_WAVES 8
#endif
        const int nwv = nw >= 256 ? NWAVES : BG_WAVES;
        const int gw = widx * nwv + wave, NGW = nw * nwv;
#pragma unroll 1
        for (int q = 0; q < 2; ++q) { const int id = q == 0 ? t.tr0 : t.tr1; if (id < 0 || wave >= nwv) continue;
            const int kind = id >> 1, lj = id & 1; const int N = kind == 0 ? 8192 : (kind == 2 ? 16384 : D);
            const float* W = a.in[kind == 0 ? I_LIN : (kind == 1 ? I_LOUT : (kind == 2 ? I_NIN : I_NOUT))] + (size_t)lj * D * N;
            bf16* WT = (bf16*)(ws + (kind == 0 ? WS_WLIN : (kind == 1 ? WS_WLOUT : (kind == 2 ? WS_WNIN : WS_WNOUT)))) + (size_t)lj * N * D;
            const int nitems = 64 * (N / 64);
            const int lay = kind == 0 ? 2 * lj : 2 * lj + 1;
            const float* shift = (kind == 0 || kind == 2) ? (const float*)(ws + WS_MOD) + (size_t)lay * 3 * (3 * D) : nullptr;
            pg8::facc_t* bias2 = (pg8::facc_t*)(ws + CTL_BIAS2) + (size_t)lay * 3 * pg8::NB2;
            f32x4 va[16], vb[16];
            if (gw < nitems) tr_load(W, N, gw, lane, va);
            for (int it = gw; it < nitems; it += 2 * NGW) {
                if (it + NGW < nitems) tr_load(W, N, it + NGW, lane, vb);
                tr_store(WT, D, N, it, lane, scr, va, shift, bias2);
                if (it + 2 * NGW < nitems) tr_load(W, N, it + 2 * NGW, lane, va);
                if (it + NGW < nitems) tr_store(WT, D, N, it + NGW, lane, scr, vb, shift, bias2);
            }
        }
    }
    __syncthreads();
}
constexpr DI int gemm_wgs(int nunits, int G) { const int rounds = (nunits + G - 1) / G; return (nunits + rounds - 1) / rounds; }
#define BG_SPARE(Gg, ...) do { const BgTasks _t = __VA_ARGS__; if ((Gg) >= G) bg_run(args, lds, tid, wave, lane, bx, G, _t); else if (bx >= (Gg)) bg_run(args, lds, tid, wave, lane, bx - (Gg), G - (Gg), _t); } while (0)

DI void prescale_phase(const Args& a, int wave, int lane, int vcu, int G) {
    asm volatile("" : "+v"(lane));
    unsigned char* ws = a.ws;
    const float* gs = (const float*)(ws + WS_GS);
    pg8::facc_t* rowss = (pg8::facc_t*)(ws + CTL_ROWSS);
    bf16* E = (bf16*)(ws + WS_E);
    const int gw = vcu * NWAVES + wave, NGW = G * NWAVES;
    for (int m2 = gw; m2 < MT * NREP(1); m2 += NGW) { const int m = m2 >= MT ? m2 - MT : m2;
        const float* src = m < ML ? a.in[I_X] + (size_t)m * D : a.in[I_CTX] + (size_t)(m - ML) * D;
        const float* g = gs + (size_t)(m < ML ? (m >> 12) : 2) * D;
        const GAS f32x4* xr = (const GAS f32x4*)src + lane;
        GAS v2u* o8 = (GAS v2u*)(E + (size_t)m * D) + lane;
        float s = 0.f;
        f32x4 xv[16], gv[16];
#pragma unroll
        for (int j = 0; j < 16; ++j) xv[j] = xr[64 * j];
#pragma unroll
        for (int j = 0; j < 16; ++j) gv[j] = *((const GAS f32x4*)g + lane + 64 * j);
        asm volatile("" ::: "memory");
#pragma unroll
        for (int j = 0; j < 16; ++j) { const f32x4 v = xv[j]; s += (v[0] * v[0] + v[1] * v[1]) + (v[2] * v[2] + v[3] * v[3]);
            const f32x4 y = v * gv[j];
            v2u w; w.x = pk2(y[0], y[1]); w.y = pk2(y[2], y[3]); o8[64 * j] = w; }
        s = wave_sum(s);
        if (lane == 0) rowss[m] = (pg8::facc_t)(s * pg8::RS_SCALE + 0.5f);
    }
}

DI int rg_rmap(int t) { return ((t >> 4) & 3) * 32 + ((t >> 2) & 3) * 8 + (t >> 6) * 4 + (t & 3); }
template <int PASS, int DIR>
DI void rg_dir(LAS unsigned char* lds, bf16x8 (&bwr)[16], bf16x8 (&bwi)[16], const GAS bf16x8* wpn, const float gbr2, const float gbi2, const float kk2,
               const unsigned abase, const unsigned ubase, GAS unsigned* coef, float& S2, float& h) {
    f32x16 nr, ni;
#pragma unroll
    for (int i = 0; i < 16; ++i) { nr[i] = 0.f; ni[i] = 0.f; }
    { const LAS unsigned char* at = lds + (DIR == 0 ? 0 : 3) * 16384;
#pragma unroll
      for (int ks = 0; ks < 16; ++ks) { const bf16x8 av = *(const LAS bf16x8*)(at + (abase ^ ((unsigned)ks << 5)));
          nr = __builtin_amdgcn_mfma_f32_32x32x16_bf16(av, bwr[ks], nr, 0, 0, 0); ni = __builtin_amdgcn_mfma_f32_32x32x16_bf16(av, bwi[ks], ni, 0, 0, 0); } }
#pragma unroll
    for (int ti = 0; ti < 4; ++ti) {
        const int mt = DIR == 0 ? ti : 3 - ti, mtn = DIR == 0 ? ti + 1 : 2 - ti;
        const f32x16 zr = nr, zi = ni;
        if (ti < 3) {
#pragma unroll
            for (int i = 0; i < 16; ++i) { nr[i] = 0.f; ni[i] = 0.f; } }
        else if (wpn) {
#pragma unroll
            for (int ks = 0; ks < 16; ++ks) { bwr[ks] = wpn[ks * 64]; bwi[ks] = wpn[(16 + ks) * 64]; } }

        const LAS unsigned char* at = lds + mt * 16384; const LAS unsigned char* atn = lds + mtn * 16384;
        v4u cpk;
        bf16x8 avn = *(const LAS bf16x8*)((ti < 3 ? atn : at) + abase);
        unsigned short upn = *(const LAS unsigned short*)(at + (ubase ^ ((unsigned)((((DIR == 0 ? 0 : 15) >> 2) & 1) * 8 + ((DIR == 0 ? 0 : 15) & 3)) << 4)) + ((DIR == 0 ? 0 : 15) >> 2) * 4096 + ((DIR == 0 ? 0 : 15) & 3) * 512);
#pragma unroll
        for (int rr = 0; rr < 16; ++rr) {
            const bf16x8 av = avn; const unsigned short upc = upn;
            if (rr < 15) { if (ti < 3) avn = *(const LAS bf16x8*)(atn + (abase ^ ((unsigned)(rr + 1) << 5)));
                const int r1 = DIR == 0 ? rr + 1 : 14 - rr; const unsigned cr1 = (unsigned)(((r1 >> 2) & 1) * 8 + (r1 & 3));
                upn = *(const LAS unsigned short*)(at + (ubase ^ (cr1 << 4)) + (r1 >> 2) * 4096 + (r1 & 3) * 512); }
            if (ti < 3) { nr = __builtin_amdgcn_mfma_f32_32x32x16_bf16(av, bwr[rr], nr, 0, 0, 0); ni = __builtin_amdgcn_mfma_f32_32x32x16_bf16(av, bwi[rr], ni, 0, 0, 0); }

            const int r = DIR == 0 ? rr : 15 - rr;
            const float up = __uint_as_float((unsigned)upc << 16);
            const float rg = fast_rcp(1.0f + fast_exp2(__builtin_fmaf(zr[r], -LOG2E, gbr2)));
            const float ig = fast_rcp(1.0f + fast_exp2(__builtin_fmaf(zi[r], -LOG2E, gbi2)));
            const float la2 = kk2 * rg, av_ = fast_exp2(la2);
            const float em = __builtin_fmaf(-av_, av_, 1.0f);
            const float bv = __builtin_amdgcn_sqrtf(em) * (ig * up);
            h = __builtin_fmaf(av_, h, bv);
            S2 += la2; cpk[r & 3] = pk2(la2, bv);
            if ((rr & 3) == 3) __builtin_nontemporal_store(cpk, (GAS v4u*)coef + (size_t)(mt * 4 + (r >> 2)) * 512);
#ifndef RG_SB_EVERY
#define RG_SB_EVERY 16
#endif
#ifndef RG_SGB
#define RG_SGB 0
#endif
#if RG_SGB
#ifndef RG_SGP
#define RG_SGP 1
#endif
            if (ti < 3) {
                if (RG_SGP == 1) { __builtin_amdgcn_sched_group_barrier(0x8, 1, 0); __builtin_amdgcn_sched_group_barrier(0x402, RG_SGB, 0);
                                   __builtin_amdgcn_sched_group_barrier(0x8, 1, 0); __builtin_amdgcn_sched_group_barrier(0x402, RG_SGB, 0); __builtin_amdgcn_sched_group_barrier(0x100, 2, 0); }
                if (RG_SGP == 2) { __builtin_amdgcn_sched_group_barrier(0x100, 2, 0); __builtin_amdgcn_sched_group_barrier(0x8, 1, 0); __builtin_amdgcn_sched_group_barrier(0x402, RG_SGB, 0);
                                   __builtin_amdgcn_sched_group_barrier(0x8, 1, 0); __builtin_amdgcn_sched_group_barrier(0x402, RG_SGB, 0); }
                if (RG_SGP == 3) { __builtin_amdgcn_sched_group_barrier(0x8, 2, 0); __builtin_amdgcn_sched_group_barrier(0x402, 2 * RG_SGB, 0); __builtin_amdgcn_sched_group_barrier(0x100, 2, 0); }
                if (RG_SGP == 4) { __builtin_amdgcn_sched_group_barrier(0x8, 1, 0); __builtin_amdgcn_sched_group_barrier(0x402, 6, 0); __builtin_amdgcn_sched_group_barrier(0x100, 1, 0);
                                   __builtin_amdgcn_sched_group_barrier(0x8, 1, 0); __builtin_amdgcn_sched_group_barrier(0x402, 6, 0); __builtin_amdgcn_sched_group_barrier(0x100, 1, 0);
                                   __builtin_amdgcn_sched_group_barrier(0x402, 6, 0); }
            }
#endif
            if ((rr % RG_SB_EVERY) == RG_SB_EVERY - 1) __builtin_amdgcn_sched_barrier(0);
        }
    }
}
#ifndef STAMP_SEL
#define STAMP_SEL 0
#endif
#ifndef STAMP_WG
#define STAMP_WG 0
#endif
#ifndef STAMP_WAVE
#define STAMP_WAVE 0
#endif
#if STAMP_SEL
#define STAMP_T(v) const unsigned long long v = __builtin_amdgcn_s_memtime()
#define STAMP_ACC(k, a, b) do { if (STAMP_SEL == (k) && tid == STAMP_WAVE * 64) *(volatile LAS unsigned*)(lds + MISC_OFF + 80) += (unsigned)((b) - (a)); } while (0)
#else
#define STAMP_T(v) do {} while (0)
#define STAMP_ACC(k, a, b) do {} while (0)
#endif
template <int PASS>
DI void rg_unit(LAS unsigned char* lds, int unit, int lj, const bf16* U, const bf16* Gb, bf16* HS, const float* conv_w, const float* conv_b, const v4u* wgt, const float* gate_b, const float* lam,
                float* agg, const float* carry, unsigned* coefb, int tid, int wave, int lane) {
    asm volatile("" : "+v"(tid), "+v"(lane));
    const int nb = unit / 68, gc = unit - nb * 68, m0 = gc * 128;
    const bool has_left = gc < 64 ? ((gc & 31) != 0) : ((gc & 1) != 0);
    const bool has_right = gc < 64 ? ((gc & 31) != 31) : ((gc & 1) != 1);
#ifndef RG_BWI_EARLY
#define RG_BWI_EARLY 1
#endif
    unsigned lo_ = (unsigned)lane; asm volatile("" : "+v"(lo_));
    const GAS bf16x8* wp0 = (const GAS bf16x8*)wgt + ((((size_t)(lj * 16 + nb) * 2 + 0) * 8 + wave) * 2) * (16 * 64) + lo_;
    const GAS bf16x8* wp1 = wp0 + (size_t)8 * 2 * 16 * 64;
    bf16x8 bwr[16], bwi[16];
#ifndef RG_BWR_PRE
#define RG_BWR_PRE 0
#endif
#pragma unroll
    for (int ks = 0; ks < RG_BWR_PRE; ++ks) bwr[ks] = wp0[ks * 64];
    asm volatile("" ::: "memory");
    STAMP_T(st0);
#ifndef RGP
#define RGP 0
#endif
#if RGP == 1
    int nrepA = 2; asm volatile("" : "+s"(nrepA));
#pragma unroll 1
    for (int repA = 0; repA < nrepA; ++repA)
#endif
    {
        asm volatile("" ::: "memory");
        const int cg = tid & 31, run = tid >> 5, ch0 = nb * 256 + cg * 8;
        float xin[11][8];
#pragma unroll
        for (int rr = 0; rr < 11; ++rr) { const int lr = run * 8 - 2 + rr; const bool valid = (lr >= 0 || has_left) && (lr < 128 || has_right);
            v4u raw = (v4u){0u, 0u, 0u, 0u}; if (valid) raw = *(const GAS v4u*)(U + (size_t)(m0 + lr) * D + ch0);
            xin[rr][0] = bflo(raw.x); xin[rr][1] = bfhi(raw.x); xin[rr][2] = bflo(raw.y); xin[rr][3] = bfhi(raw.y); xin[rr][4] = bflo(raw.z); xin[rr][5] = bfhi(raw.z); xin[rr][6] = bflo(raw.w); xin[rr][7] = bfhi(raw.w); }
        float cw[4][8], cb[8];
#pragma unroll
        for (int k = 0; k < 4; ++k) { const f32x4 w0 = *(const GAS f32x4*)(conv_w + ((size_t)lj * 4 + k) * D + ch0), w1 = *(const GAS f32x4*)(conv_w + ((size_t)lj * 4 + k) * D + ch0 + 4);
#pragma unroll
            for (int e = 0; e < 4; ++e) { cw[k][e] = w0[e]; cw[k][4 + e] = w1[e]; } }
        { const f32x4 b0 = *(const GAS f32x4*)(conv_b + (size_t)lj * D + ch0), b1 = *(const GAS f32x4*)(conv_b + (size_t)lj * D + ch0 + 4);
#pragma unroll
          for (int e = 0; e < 4; ++e) { cb[e] = b0[e]; cb[4 + e] = b1[e]; } }
#pragma unroll
        for (int ks = RG_BWR_PRE; ks < 16; ++ks) bwr[ks] = wp0[ks * 64];
#pragma unroll
        for (int tt = 0; tt < 8; ++tt) { float o[8];
#pragma unroll
            for (int e = 0; e < 8; ++e) { float sacc = cb[e];
#pragma unroll
                for (int k = 0; k < 4; ++k) sacc += cw[k][e] * xin[tt + k][e];
                o[e] = sacc; }
            v4u w; w.x = pk2(o[0], o[1]); w.y = pk2(o[2], o[3]); w.z = pk2(o[4], o[5]); w.w = pk2(o[6], o[7]);
            const int R = rg_rmap(run * 8 + tt);
            *(LAS v4u*)(lds + R * 512 + ((cg ^ (R & 15)) << 4)) = w;
#if RG_BWI_EARLY
            if (tt == 3) { asm volatile("" ::: "memory");
#pragma unroll
                for (int ks = 0; ks < 8; ++ks) bwi[ks] = wp0[(16 + ks) * 64]; asm volatile("" ::: "memory"); }
            if (tt == 6) { asm volatile("" ::: "memory");
#pragma unroll
                for (int ks = 8; ks < 16; ++ks) bwi[ks] = wp0[(16 + ks) * 64]; asm volatile("" ::: "memory"); }
#endif
        }
    }
    STAMP_T(st1); STAMP_ACC(1, st0, st1);
    asm volatile("" ::: "memory");
#if !RG_BWI_EARLY
#pragma unroll
    for (int ks = 0; ks < 16; ++ks) bwi[ks] = wp0[(16 + ks) * 64];
#endif
#if RGP == 2
    asm volatile("s_waitcnt vmcnt(0)" ::: "memory");
#pragma unroll
    for (int ks = 0; ks < 16; ++ks) { asm volatile("" : "+v"(bwr[ks]), "+v"(bwi[ks])); }
    { const GAS bf16x8* wq = wp0; asm volatile("" : "+v"(wq));
#pragma unroll
    for (int ks = 0; ks < 16; ++ks) { bwr[ks] = wq[ks * 64]; bwi[ks] = wq[(16 + ks) * 64]; } }
#endif
    LDS_WAIT(); __syncthreads();
    STAMP_T(st2); STAMP_ACC(2, st1, st2);
#if STAMP_SEL == 6
    asm volatile("s_waitcnt vmcnt(0)" ::: "memory");
    STAMP_T(st2b); STAMP_ACC(6, st2, st2b);
#endif
#if RG_SETPRIO
    if (wave < 4) __builtin_amdgcn_s_setprio(1);
#endif
    const unsigned c_ = lo_ & 31u, hh_ = lo_ >> 5, chl_ = (unsigned)wave * 32u + c_;
    const int ch = nb * 256 + (int)chl_, sc = gc * 2 + (int)hh_;
    const unsigned abase = c_ * 512u + ((hh_ ^ (c_ & 15u)) << 4);
    const unsigned ubase = hh_ * 2048u + ((((chl_ >> 3) ^ (hh_ << 2))) << 4) + (chl_ & 7u) * 2u;
    LAS unsigned short* hst = (LAS unsigned short*)(lds + 65536) + chl_ + hh_ * (64 * 256);
    {
        const float gbr2 = -LOG2E * gate_b[((size_t)(lj * 2 + 0) * 2 + 0) * D + ch], gbi2 = -LOG2E * gate_b[((size_t)(lj * 2 + 0) * 2 + 1) * D + ch];
        const float kk2 = -8.0f * LOG2E * log1pf(__expf(-lam[(size_t)(lj * 2 + 0) * D + ch]));
        float S2 = 0.f, h = PASS == 2 ? carry[(size_t)(sc * 2 + 0) * D + ch] : 0.f;
        rg_dir<PASS, 0>(lds, bwr, bwi, wp1, gbr2, gbi2, kk2, abase, ubase, (GAS unsigned*)coefb + ((size_t)unit * 2 + 0) * 64 * 512 + (wave * 64 + lo_) * 4, S2, h);
        if (PASS == 1) { float* ap = agg + ((size_t)(sc * 2 + 0) * 2) * D + ch; ap[0] = fast_exp2(S2); ap[D] = h; }
    }
    __builtin_amdgcn_sched_barrier(0);
    STAMP_T(st3); STAMP_ACC(3, st2, st3);
    {
        const float gbr2 = -LOG2E * gate_b[((size_t)(lj * 2 + 1) * 2 + 0) * D + ch], gbi2 = -LOG2E * gate_b[((size_t)(lj * 2 + 1) * 2 + 1) * D + ch];
        const float kk2 = -8.0f * LOG2E * log1pf(__expf(-lam[(size_t)(lj * 2 + 1) * D + ch]));
        float S2 = 0.f, h = PASS == 2 ? carry[(size_t)(sc * 2 + 1) * D + ch] : 0.f;
        rg_dir<PASS, 1>(lds, bwr, bwi, (const GAS bf16x8*)nullptr, gbr2, gbi2, kk2, abase, ubase, (GAS unsigned*)coefb + ((size_t)unit * 2 + 1) * 64 * 512 + (wave * 64 + lo_) * 4, S2, h);
        if (PASS == 1) { float* ap = agg + ((size_t)(sc * 2 + 1) * 2) * D + ch; ap[0] = fast_exp2(S2); ap[D] = h; }
    }
    __builtin_amdgcn_s_setprio(0);
    STAMP_T(st4); STAMP_ACC(4, st3, st4);
    if (PASS == 2) {
        LDS_WAIT(); __syncthreads();
        int tid2 = tid; asm volatile("" : "+v"(tid2));
        const int cg = tid2 & 31, run = tid2 >> 5, ch0 = nb * 256 + cg * 8;
#pragma unroll
        for (int tt = 0; tt < 8; ++tt) { const int t = run * 8 + tt;
            const v4u hv = *(const LAS v4u*)(lds + 65536 + t * 512 + cg * 16); const v4u gv = *(const GAS v4u*)(Gb + (size_t)(m0 + t) * D + ch0);
            v4u o; o.x = pk2(bflo(hv.x) * bflo(gv.x), bfhi(hv.x) * bfhi(gv.x)); o.y = pk2(bflo(hv.y) * bflo(gv.y), bfhi(hv.y) * bfhi(gv.y));
            o.z = pk2(bflo(hv.z) * bflo(gv.z), bfhi(hv.z) * bfhi(gv.z)); o.w = pk2(bflo(hv.w) * bflo(gv.w), bfhi(hv.w) * bfhi(gv.w));
            *(GAS v4u*)(HS + (size_t)(m0 + t) * D + ch0) = o; }
    }
    LDS_WAIT(); __syncthreads();
    STAMP_T(st5); STAMP_ACC(5, st4, st5); STAMP_ACC(9, st0, st5);
}
DI void rg_unit2(int unit, const bf16* __restrict__ Gb, bf16* __restrict__ HS, const float* __restrict__ carry, const unsigned* __restrict__ coefb, int wave, int lane) {
    asm volatile("" : "+v"(lane));
    const int nb = unit / 68, gc = unit - nb * 68;
    const int hh = wave >> 2, chl = (wave & 3) * 64 + lane, ch = nb * 256 + chl, sc = gc * 2 + hh;
    const GAS v4u* cf = (const GAS v4u*)coefb + (size_t)unit * 2 * 16 * 512 + (chl >> 5) * 64 + hh * 32 + (chl & 31);
    const size_t row0 = (size_t)(gc * 128 + hh * 64) * D + ch;
    float hf[64];
    const GAS v4u* cb = cf + (size_t)16 * 512;
    unsigned wa[16], wb[16]; unsigned short ga[16], gb[16];
#define P2_LOADF(WV, t0) do { _Pragma("unroll") for (int j = 0; j < 4; ++j) { const v4u _q = __builtin_nontemporal_load(cf + (size_t)((t0) / 4 + j) * 512); WV[4 * j] = _q[0]; WV[4 * j + 1] = _q[1]; WV[4 * j + 2] = _q[2]; WV[4 * j + 3] = _q[3]; } } while (0)
#define P2_LOADB(WV, gq, t0) do { _Pragma("unroll") for (int j = 0; j < 4; ++j) { const v4u _q = __builtin_nontemporal_load(cb + (size_t)((t0) / 4 + j) * 512); WV[4 * j] = _q[0]; WV[4 * j + 1] = _q[1]; WV[4 * j + 2] = _q[2]; WV[4 * j + 3] = _q[3]; } \
        _Pragma("unroll") for (int j = 0; j < 16; ++j) gq[j] = *(const GAS unsigned short*)(Gb + row0 + (size_t)((t0) + j) * D); } while (0)
#define P2_FWD(w, t0) do { _Pragma("unroll") for (int j = 0; j < 16; ++j) { h = __builtin_fmaf(fast_exp2(bflo(w[j])), h, bfhi(w[j])); hf[(t0) + j] = h; } } while (0)
#define P2_BWD(w, gq, t0) do { _Pragma("unroll") for (int j = 15; j >= 0; --j) { h = __builtin_fmaf(fast_exp2(bflo(w[j])), h, bfhi(w[j])); \
        *(GAS unsigned short*)(HS + row0 + (size_t)((t0) + j) * D) = (unsigned short)(pk2((hf[(t0) + j] + h) * __uint_as_float((unsigned)gq[j] << 16), 0.f) & 0xffffu); } } while (0)
    float h = carry[(size_t)(sc * 2 + 0) * D + ch]; const float hb0 = carry[(size_t)(sc * 2 + 1) * D + ch];
    P2_LOADF(wa, 0); P2_LOADF(wb, 16); P2_FWD(wa, 0); P2_LOADF(wa, 32); P2_FWD(wb, 16); P2_LOADF(wb, 48); P2_FWD(wa, 32); P2_LOADB(wa, ga, 48); P2_FWD(wb, 48);
    h = hb0;
    P2_LOADB(wb, gb, 32); asm volatile("" ::: "memory"); P2_BWD(wa, ga, 48); P2_LOADB(wa, ga, 16); asm volatile("" ::: "memory"); P2_BWD(wb, gb, 32);
    P2_LOADB(wb, gb, 0); asm volatile("" ::: "memory"); P2_BWD(wa, ga, 16); asm volatile("" ::: "memory"); P2_BWD(wb, gb, 0);
#undef P2_LOADF
#undef P2_LOADB
#undef P2_FWD
#undef P2_BWD
}
DI void rg_carry(LAS unsigned char* lds, int item, const float* agg, float* carry, int tid, int wave, int lane) {
    asm volatile("" : "+v"(tid), "+v"(lane));
    const int b = item >> 7, d = (item >> 6) & 1, ch = (item & 63) * 64 + lane;
    float A[9], H[9]; int scs[9];
#pragma unroll
    for (int e9 = 0; e9 < 9; ++e9) { const int e0 = wave * 9 + e9; const bool valid = e0 < 68; const int e = valid ? e0 : 67;
        const int sq = d == 0 ? (e < 4 ? 128 + b * 4 + e : b * 64 + (e - 4)) : (e < 4 ? 128 + b * 4 + 3 - e : b * 64 + 63 - (e - 4));
        scs[e9] = valid ? sq : -1;
        const GAS float* ap = (const GAS float*)agg + ((size_t)(sq * 2 + d) * 2) * D + ch; A[e9] = ap[0]; H[e9] = ap[D]; }
    asm volatile("" : "+v"(A[0]), "+v"(A[1]), "+v"(A[2]), "+v"(A[3]), "+v"(A[4]), "+v"(A[5]), "+v"(A[6]), "+v"(A[7]), "+v"(A[8]),
                      "+v"(H[0]), "+v"(H[1]), "+v"(H[2]), "+v"(H[3]), "+v"(H[4]), "+v"(H[5]), "+v"(H[6]), "+v"(H[7]), "+v"(H[8]));
#pragma unroll
    for (int e9 = 0; e9 < 9; ++e9) if (scs[e9] < 0) { A[e9] = 1.f; H[e9] = 0.f; }
    float Ac = 1.f, Hc = 0.f;
#pragma unroll
    for (int e9 = 0; e9 < 9; ++e9) { Hc = A[e9] * Hc + H[e9]; Ac *= A[e9]; }
    LAS float* comp = (LAS float*)lds;
    comp[(wave * 64 + lane) * 2 + 0] = Ac; comp[(wave * 64 + lane) * 2 + 1] = Hc;
    LDS_WAIT(); __syncthreads();
    float h = 0.f;
    for (int w2 = 0; w2 < wave; ++w2) h = comp[(w2 * 64 + lane) * 2 + 0] * h + comp[(w2 * 64 + lane) * 2 + 1];
#pragma unroll
    for (int e9 = 0; e9 < 9; ++e9) { if (scs[e9] >= 0) carry[(size_t)(scs[e9] * 2 + d) * D + ch] = h; h = A[e9] * h + H[e9]; }
    LDS_WAIT(); __syncthreads();
}

DI unsigned off_b(unsigned row, unsigned ch) { return 256u * row + 16u * (ch ^ (((row & 3u) << 2) | ((row >> 2) & 3u))); }
DI int clampi(int v, int lo, int hi) { return v < lo ? lo : (v > hi ? hi : v); }
constexpr int VT_DT = 3104, VT_KG = 384, TILE_BUF = 8 * VT_DT;
DI unsigned off_v(unsigned row, unsigned ch) { return (ch >> 1) * VT_DT + (row >> 3) * VT_KG + (row & 7u) * 32u + (ch & 1u) * 16u; }
#define TRS(n) "ds_read_b64_tr_b16 %" #n ", %16 offset:"
DI void tr_read16(s16x4 (&o)[16], unsigned a) {
    asm volatile(TRS(0) "0\n\t" TRS(1) "128\n\t" TRS(2) "3104\n\t" TRS(3) "3232\n\t" TRS(4) "6208\n\t" TRS(5) "6336\n\t" TRS(6) "9312\n\t" TRS(7) "9440\n\t"
                 TRS(8) "12416\n\t" TRS(9) "12544\n\t" TRS(10) "15520\n\t" TRS(11) "15648\n\t" TRS(12) "18624\n\t" TRS(13) "18752\n\t" TRS(14) "21728\n\t" TRS(15) "21856\n\t"
                 "s_waitcnt lgkmcnt(0)"
                 : "=&v"(o[0]), "=&v"(o[1]), "=&v"(o[2]), "=&v"(o[3]), "=&v"(o[4]), "=&v"(o[5]), "=&v"(o[6]), "=&v"(o[7]),
                   "=&v"(o[8]), "=&v"(o[9]), "=&v"(o[10]), "=&v"(o[11]), "=&v"(o[12]), "=&v"(o[13]), "=&v"(o[14]), "=&v"(o[15])
                 : "v"(a) : "memory");
}
DI void tr_issue16(s16x4 (&o)[16], unsigned a) {
    asm volatile(TRS(0) "0\n\t" TRS(1) "128\n\t" TRS(2) "3104\n\t" TRS(3) "3232\n\t" TRS(4) "6208\n\t" TRS(5) "6336\n\t" TRS(6) "9312\n\t" TRS(7) "9440\n\t"
                 TRS(8) "12416\n\t" TRS(9) "12544\n\t" TRS(10) "15520\n\t" TRS(11) "15648\n\t" TRS(12) "18624\n\t" TRS(13) "18752\n\t" TRS(14) "21728\n\t" TRS(15) "21856"
                 : "=&v"(o[0]), "=&v"(o[1]), "=&v"(o[2]), "=&v"(o[3]), "=&v"(o[4]), "=&v"(o[5]), "=&v"(o[6]), "=&v"(o[7]),
                   "=&v"(o[8]), "=&v"(o[9]), "=&v"(o[10]), "=&v"(o[11]), "=&v"(o[12]), "=&v"(o[13]), "=&v"(o[14]), "=&v"(o[15])
                 : "v"(a) : "memory");
}
#undef TRS
DI void lds_read8(bf16x8 (&o)[8], unsigned a0, unsigned a1, unsigned a2, unsigned a3, unsigned a4, unsigned a5, unsigned a6, unsigned a7) {
    asm volatile("ds_read_b128 %0, %8\n\tds_read_b128 %1, %9\n\tds_read_b128 %2, %10\n\tds_read_b128 %3, %11\n\tds_read_b128 %4, %12\n\tds_read_b128 %5, %13\n\tds_read_b128 %6, %14\n\tds_read_b128 %7, %15\n\ts_waitcnt lgkmcnt(0)"
                 : "=&v"(o[0]), "=&v"(o[1]), "=&v"(o[2]), "=&v"(o[3]), "=&v"(o[4]), "=&v"(o[5]), "=&v"(o[6]), "=&v"(o[7])
                 : "v"(a0), "v"(a1), "v"(a2), "v"(a3), "v"(a4), "v"(a5), "v"(a6), "v"(a7) : "memory");
}
constexpr int ATT_BUF = 16384 + TILE_BUF;
constexpr float ATT_THR = 10.0f;
#ifndef ATT_PROBE
#define ATT_PROBE 0
#endif
DI void lds_bias16(float (&o0)[8], float (&o1)[8], unsigned a0, unsigned a1, unsigned a2, unsigned a3, unsigned a4, unsigned a5, unsigned a6, unsigned a7) {
    asm volatile("ds_read_b32 %0, %16 offset:128\n\tds_read_b32 %1, %17 offset:128\n\tds_read_b32 %2, %18 offset:128\n\tds_read_b32 %3, %19 offset:128\n\t"
                 "ds_read_b32 %4, %20 offset:128\n\tds_read_b32 %5, %21 offset:128\n\tds_read_b32 %6, %22 offset:128\n\tds_read_b32 %7, %23 offset:128\n\t"
                 "ds_read_b32 %8, %16\n\tds_read_b32 %9, %17\n\tds_read_b32 %10, %18\n\tds_read_b32 %11, %19\n\t"
                 "ds_read_b32 %12, %20\n\tds_read_b32 %13, %21\n\tds_read_b32 %14, %22\n\tds_read_b32 %15, %23\n\ts_waitcnt lgkmcnt(0)"
                 : "=&v"(o0[0]), "=&v"(o0[1]), "=&v"(o0[2]), "=&v"(o0[3]), "=&v"(o0[4]), "=&v"(o0[5]), "=&v"(o0[6]), "=&v"(o0[7]),
                   "=&v"(o1[0]), "=&v"(o1[1]), "=&v"(o1[2]), "=&v"(o1[3]), "=&v"(o1[4]), "=&v"(o1[5]), "=&v"(o1[6]), "=&v"(o1[7])
                 : "v"(a0), "v"(a1), "v"(a2), "v"(a3), "v"(a4), "v"(a5), "v"(a6), "v"(a7) : "memory");
}
template <bool MASKED>
DI void att_softmax(f32x4 (&S)[2], const float (&bv)[8], const float (&madd)[2][4], const bool rowok, float& m, float& l, f32x4 (&O)[8], v4u& P) {
    float v[2][4]; float lm = -__builtin_inff();
#pragma unroll
    for (int t = 0; t < 2; ++t)
#pragma unroll
        for (int r = 0; r < 4; ++r) { v[t][r] = MASKED ? __builtin_fmaf(S[t][r], ATTN_C1, rowok ? bv[t * 4 + r] + madd[t][r] : -__builtin_inff()) : S[t][r] * ATTN_C1; lm = fmaxf(lm, v[t][r]); }
    if (__any(lm > m + ATT_THR)) {
        const float mx = pg8::xrow16_max(lm);
        const float mn = fmaxf(m, mx), alpha = fast_exp2(m - mn);
#pragma unroll
        for (int dt = 0; dt < 8; ++dt) O[dt] = O[dt] * alpha;
        l *= alpha; m = mn;
    }
    float p[2][4];
#pragma unroll
    for (int t = 0; t < 2; ++t)
#pragma unroll
        for (int r = 0; r < 4; ++r) { p[t][r] = fast_exp2(v[t][r] - m); l += p[t][r]; }
    P.x = pk2(p[0][0], p[0][1]); P.y = pk2(p[0][2], p[0][3]); P.z = pk2(p[1][0], p[1][1]); P.w = pk2(p[1][2], p[1][3]);
}
#ifndef ATT_PRIO
#define ATT_PRIO 1
#endif
#define ATT_PRIO_UP() do { if (ATT_PRIO) __builtin_amdgcn_s_setprio(1); } while (0)
#define ATT_PRIO_DN() do { if (ATT_PRIO) __builtin_amdgcn_s_setprio(0); } while (0)
DI void attn_unit(LAS unsigned char* lds, int unit, const bf16* Qb, const bf16* Kb, const bf16* Vb, const bf16* Gb, bf16* Ob, const float* rpb, int tid, int wave, int lane) {
    asm volatile("" : "+v"(tid), "+v"(lane));
    const bool lat = unit < 1024;
    int b, hd, R0 = 0;
    if (lat) { b = unit >> 9; hd = (unit >> 4) & 31; R0 = (unit & 15) * 4; } else { const int u2 = unit - 1024; b = u2 >> 5; hd = u2 & 31; }
    const int n = wave & 3, rp = wave >> 2, ql = lane & 15, g = lane >> 4;
    const int rw0 = R0 + 2 * rp;
    int qtok[2];
#pragma unroll
    for (int j = 0; j < 2; ++j) qtok[j] = lat ? b * SEQ + (rw0 + j) * 64 + n * 16 + ql : ML + b * CTXL + (2 * rp + j) * 64 + n * 16 + ql;
    const int rs0 = clampi(R0 - 4, 0, 56);
    const int rot = (11 - rs0 % 11) % 11;
    const int bs = n == 0 ? 0 : (n == 1 ? 8 : (n == 2 ? 24 : 32));
    const int qc = n * 16 + ql, qcs = clampi(qc - 8, 0, 48);
    LAS unsigned char* rpbL = lds + 2 * ATT_BUF;
    bf16x8 qf[2][4];
#pragma unroll
    for (int j = 0; j < 2; ++j)
#pragma unroll
        for (int ks = 0; ks < 4; ++ks) qf[j][ks] = *(const GAS bf16x8*)(Qb + (size_t)qtok[j] * D + hd * HDIM + ks * 32 + 8 * g);
    if (lat) for (int i = tid; i < 15 * 31; i += NWAVES * 64) { const int r1 = i / 31, c1 = i - r1 * 31; ((LAS float*)rpbL)[r1 * 32 + c1] = rpb[((size_t)hd * 15 + r1) * 31 + c1] * LOG2E; }
    float madd[2][4]; unsigned bptr[2][4];
#pragma unroll
    for (int t = 0; t < 2; ++t)
#pragma unroll
        for (int r = 0; r < 4; ++r) { const int kc = bs + 8 * g + 4 * t + r; madd[t][r] = (kc >= qcs && kc < qcs + 16) ? 0.f : -__builtin_inff();
            bptr[t][r] = (unsigned)(size_t)rpbL + (unsigned)(((rs0 - rw0 + 7) * 32 + clampi(kc - qc + 15, 0, 30)) * 4); }
    const int crow = tid >> 4, cch = tid & 15;
    const unsigned stK0 = off_b(crow, cch), stK1 = off_b(crow + 32, cch), stV0 = 16384u + off_v(crow, cch), stV1 = 16384u + off_v(crow + 32, cch);
#define TILE_LOAD(st, p) do { const int _s = (st); size_t _t0; if (_s < 11) { int _l = _s + rot; _l = _l >= 11 ? _l - 11 : _l; const int _kr = (rs0 + _l) > 63 ? 63 : (rs0 + _l); _t0 = ((size_t)(b * NHEAD + hd) * SEQ + _kr * 64) * HDIM; } else _t0 = pg8::HM_CTX + ((size_t)(b * NHEAD + hd) * CTXL + (_s - 11) * 64) * HDIM; \
        const size_t _o0 = _t0 + (size_t)tid * 8, _o1 = _o0 + (size_t)32 * HDIM;     \
        p[0] = *(const GAS v4u*)(Kb + _o0); p[1] = *(const GAS v4u*)(Kb + _o1); p[2] = *(const GAS v4u*)(Vb + _o0); p[3] = *(const GAS v4u*)(Vb + _o1); } while (0)
#define TILE_STORE(st, p) do { LAS unsigned char* _b = lds + ((st) & 1) * ATT_BUF; *(LAS v4u*)(_b + stK0) = p[0]; *(LAS v4u*)(_b + stK1) = p[1]; *(LAS v4u*)(_b + stV0) = p[2]; *(LAS v4u*)(_b + stV1) = p[3]; } while (0)
    v4u PF[4];
    if (lat) { TILE_LOAD(0, PF); TILE_STORE(0, PF); TILE_LOAD(1, PF); }
    else { TILE_LOAD(11, PF); TILE_STORE(11, PF); TILE_LOAD(12, PF); }
    f32x4 O[2][8];
#pragma unroll
    for (int j = 0; j < 2; ++j)
#pragma unroll
        for (int dt = 0; dt < 8; ++dt) O[j][dt] = (f32x4){0.f, 0.f, 0.f, 0.f};
    float mrun[2] = {-1e30f, -1e30f}, lrun[2] = {0.f, 0.f};
    unsigned kb_lat[2], kb_ctx[2][2];
#pragma unroll
    for (int t = 0; t < 2; ++t) { kb_lat[t] = off_b((unsigned)(bs + 8 * (ql >> 2) + 4 * t + (ql & 3)), (unsigned)g);
#pragma unroll
        for (int pp = 0; pp < 2; ++pp) kb_ctx[pp][t] = off_b((unsigned)(32 * pp + 8 * (ql >> 2) + 4 * t + (ql & 3)), (unsigned)g); }
    const unsigned ldsb = (unsigned)(size_t)lds;
    const unsigned vlane = 16384u + (unsigned)(g * VT_KG + (ql >> 2) * 32 + (lane & 3) * 8);
    if (lat) {
#pragma unroll
        for (int st = 0; st < 11; ++st) {
            LDS_WAIT(); __syncthreads();
            TILE_STORE(st + 1, PF); TILE_LOAD(st + 2, PF);
            int sts = st + rot; sts = sts >= 11 ? sts - 11 : sts;
            const int kr = rs0 + sts;
            const bool ok0 = kr >= clampi(rw0 - 4, 0, 56) && kr < clampi(rw0 - 4, 0, 56) + 8, ok1 = kr >= clampi(rw0 - 3, 0, 56) && kr < clampi(rw0 - 3, 0, 56) + 8;
            if (ok0 || ok1) {
                const unsigned kbuf = ldsb + (unsigned)(st & 1) * ATT_BUF;
                bf16x8 kf[8];
                lds_read8(kf, kbuf + kb_lat[0], kbuf + (kb_lat[0] ^ 64u), kbuf + (kb_lat[0] ^ 128u), kbuf + (kb_lat[0] ^ 192u), kbuf + kb_lat[1], kbuf + (kb_lat[1] ^ 64u), kbuf + (kb_lat[1] ^ 128u), kbuf + (kb_lat[1] ^ 192u));
                f32x4 S0[2], S1[2];
#if ATT_PROBE == 2
                for (int rep_ = 0; rep_ < 2; ++rep_) { asm volatile("" ::: "memory");
                lds_read8(kf, kbuf + kb_lat[0], kbuf + (kb_lat[0] ^ 64u), kbuf + (kb_lat[0] ^ 128u), kbuf + (kb_lat[0] ^ 192u), kbuf + kb_lat[1], kbuf + (kb_lat[1] ^ 64u), kbuf + (kb_lat[1] ^ 128u), kbuf + (kb_lat[1] ^ 192u));
#endif
                ATT_PRIO_UP();
#pragma unroll
                for (int t = 0; t < 2; ++t) { f32x4 a0 = (f32x4){0.f, 0.f, 0.f, 0.f}, a1 = (f32x4){0.f, 0.f, 0.f, 0.f};
#pragma unroll
                    for (int ks = 0; ks < 4; ++ks) { a0 = __builtin_amdgcn_mfma_f32_16x16x32_bf16(kf[t * 4 + ks], qf[0][ks], a0, 0, 0, 0); a1 = __builtin_amdgcn_mfma_f32_16x16x32_bf16(kf[t * 4 + ks], qf[1][ks], a1, 0, 0, 0); }
                    S0[t] = a0; S1[t] = a1; }
                ATT_PRIO_DN();
#if ATT_PROBE == 2
                asm volatile("" : "+v"(S0[0]), "+v"(S0[1]), "+v"(S1[0]), "+v"(S1[1])); }
#endif
                v4u P0, P1;
                s16x4 o[16];
                tr_issue16(o, ldsb + (unsigned)(st & 1) * ATT_BUF + vlane + (unsigned)(bs >> 3) * VT_KG);
                float bv0[8], bv1[8];
                { const unsigned bo = (unsigned)((sts - 1) * 128);
                  lds_bias16(bv0, bv1, bptr[0][0] + bo, bptr[0][1] + bo, bptr[0][2] + bo, bptr[0][3] + bo, bptr[1][0] + bo, bptr[1][1] + bo, bptr[1][2] + bo, bptr[1][3] + bo); }
                att_softmax<true>(S0, bv0, madd, ok0, mrun[0], lrun[0], O[0], P0);
                att_softmax<true>(S1, bv1, madd, ok1, mrun[1], lrun[1], O[1], P1);
                const bf16x8 p0 = __builtin_bit_cast(bf16x8, P0), p1 = __builtin_bit_cast(bf16x8, P1);
                ATT_PRIO_UP();
#pragma unroll
                for (int dt = 0; dt < 8; ++dt) { const bf16x8 vf = __builtin_shufflevector(o[2 * dt], o[2 * dt + 1], 0, 1, 2, 3, 4, 5, 6, 7);
                    O[0][dt] = __builtin_amdgcn_mfma_f32_16x16x32_bf16(vf, p0, O[0][dt], 0, 0, 0);
                    O[1][dt] = __builtin_amdgcn_mfma_f32_16x16x32_bf16(vf, p1, O[1][dt], 0, 0, 0); }
                ATT_PRIO_DN();
            }
        }
    }
#pragma unroll
    for (int st = 11; st < 15; ++st) {
        LDS_WAIT(); __syncthreads();
        if (st + 1 < 15) { TILE_STORE(st + 1, PF); if (st + 2 < 15) TILE_LOAD(st + 2, PF); }
        const unsigned kbuf = ldsb + (unsigned)(st & 1) * ATT_BUF;
#pragma unroll
        for (int pp = 0; pp < 2; ++pp) {
            bf16x8 kf[8];
            lds_read8(kf, kbuf + kb_ctx[pp][0], kbuf + (kb_ctx[pp][0] ^ 64u), kbuf + (kb_ctx[pp][0] ^ 128u), kbuf + (kb_ctx[pp][0] ^ 192u), kbuf + kb_ctx[pp][1], kbuf + (kb_ctx[pp][1] ^ 64u), kbuf + (kb_ctx[pp][1] ^ 128u), kbuf + (kb_ctx[pp][1] ^ 192u));
            f32x4 S0[2], S1[2];
            ATT_PRIO_UP();
#pragma unroll
            for (int t = 0; t < 2; ++t) { f32x4 a0 = (f32x4){0.f, 0.f, 0.f, 0.f}, a1 = (f32x4){0.f, 0.f, 0.f, 0.f};
#pragma unroll
                for (int ks = 0; ks < 4; ++ks) { a0 = __builtin_amdgcn_mfma_f32_16x16x32_bf16(kf[t * 4 + ks], qf[0][ks], a0, 0, 0, 0); a1 = __builtin_amdgcn_mfma_f32_16x16x32_bf16(kf[t * 4 + ks], qf[1][ks], a1, 0, 0, 0); }
                S0[t] = a0; S1[t] = a1; }
            ATT_PRIO_DN();
            v4u P0, P1;
            const float bvz[8] = {0.f, 0.f, 0.f, 0.f, 0.f, 0.f, 0.f, 0.f};
            att_softmax<false>(S0, bvz, madd, true, mrun[0], lrun[0], O[0], P0);
            att_softmax<false>(S1, bvz, madd, true, mrun[1], lrun[1], O[1], P1);
            s16x4 o[16];
            tr_read16(o, ldsb + (unsigned)(st & 1) * ATT_BUF + vlane + (unsigned)(4 * pp) * VT_KG);
            const bf16x8 p0 = __builtin_bit_cast(bf16x8, P0), p1 = __builtin_bit_cast(bf16x8, P1);
            ATT_PRIO_UP();
#pragma unroll
            for (int dt = 0; dt < 8; ++dt) { const bf16x8 vf = __builtin_shufflevector(o[2 * dt], o[2 * dt + 1], 0, 1, 2, 3, 4, 5, 6, 7);
                O[0][dt] = __builtin_amdgcn_mfma_f32_16x16x32_bf16(vf, p0, O[0][dt], 0, 0, 0);
                O[1][dt] = __builtin_amdgcn_mfma_f32_16x16x32_bf16(vf, p1, O[1][dt], 0, 0, 0); }
            ATT_PRIO_DN();
        }
    }
#undef TILE_LOAD
#undef TILE_STORE
    v4u gvs[2][4];
#pragma unroll
    for (int j = 0; j < 2; ++j)
#pragma unroll
        for (int dp = 0; dp < 4; ++dp) gvs[j][dp] = *(const GAS v4u*)(Gb + (size_t)qtok[j] * D + hd * HDIM + 16 * (g & 1) + 8 * (g >> 1) + dp * 32);
    asm volatile("" ::: "memory");
#pragma unroll
    for (int j = 0; j < 2; ++j) {
        const float l1 = pg8::xrow16_sum(lrun[j]);
        const float inv = fast_rcp(l1);
        const size_t rowoff = (size_t)qtok[j] * D + hd * HDIM + 16 * (g & 1) + 8 * (g >> 1);
#pragma unroll
        for (int dp = 0; dp < 4; ++dp) {
            float na[4], nb[4];
#pragma unroll
            for (int c = 0; c < 4; ++c) { const auto r = __builtin_amdgcn_permlane16_swap(__float_as_uint(O[j][2 * dp][c]), __float_as_uint(O[j][2 * dp + 1][c]), false, false);
                na[c] = __uint_as_float(r[0]); nb[c] = __uint_as_float(r[1]); }
            const size_t off = rowoff + dp * 32;
            const v4u gv = gvs[j][dp];
            v4u w; w.x = pk2(na[0] * inv * bflo(gv.x), na[1] * inv * bfhi(gv.x)); w.y = pk2(na[2] * inv * bflo(gv.y), na[3] * inv * bfhi(gv.y));
            w.z = pk2(nb[0] * inv * bflo(gv.z), nb[1] * inv * bfhi(gv.z)); w.w = pk2(nb[2] * inv * bflo(gv.w), nb[3] * inv * bfhi(gv.w));
            *(GAS v4u*)(Ob + off) = w; }
    }
    __syncthreads();
}

__global__ void __launch_bounds__(NWAVES * 64, 2) mega_fwd(Args args) {
    extern __shared__ __attribute__((aligned(16))) unsigned char lds_raw[];
    LAS unsigned char* lds = (LAS unsigned char*)lds_raw;
    volatile LAS unsigned* MISC = (volatile LAS unsigned*)(lds + MISC_OFF);
    const int tid = threadIdx.x, lane = tid & 63, wave = __builtin_amdgcn_readfirstlane(tid >> 6);
    constexpr int G = 256;
    const int bx = blockIdx.x; const int vcu = (bx % 8) * (G / 8) + bx / 8;
    unsigned char* ws = args.ws;
    if (tid < 32) MISC[tid] = 0u;
    __syncthreads();
    XcdBarrier bar; bar.bar = (unsigned*)(ws + WS_CTL) + CW_BAR; bar.x = 0; bar.st = nullptr;
    if (!MK_PER_PHASE) bar = xcd_barrier_post((unsigned*)(ws + WS_CTL) + CW_BAR, MISC + 8);
#if MK_PER_PHASE
    const int lo = args.ph_lo, hi = args.ph_hi;
#else
    constexpr int lo = 0, hi = NPHASE;
#endif
#ifndef SITE_MASK
#define SITE_MASK 0xffff
#endif
#define SITE(x) ((SITE_MASK >> (x)) & 1)
#define IN(k) (lo <= (k) && (k) < hi)
#define SEAM(k) do { if (IN(k) && IN((k) + 1)) xcd_barrier(bar); } while (0)
#define FRESH() int vcu_ = vcu; constexpr int G_ = G; asm volatile("" : "+s"(vcu_))

#define PTRS() unsigned char* ws_ = ws; asm volatile("" : "+s"(ws_)); bf16* Hb = (bf16*)(ws_ + WS_H); bf16* Ab = (bf16*)(ws_ + WS_A); bf16* Bb = (bf16*)(ws_ + WS_B); bf16* Cb = (bf16*)(ws_ + WS_C); bf16* Db = (bf16*)(ws_ + WS_D); \
    bf16* Eb = (bf16*)(ws_ + WS_E); const float* mod = (const float*)(ws_ + WS_MOD); const float* gsv = (const float*)(ws_ + WS_GS); \
    pg8::facc_t* rowss = (pg8::facc_t*)(ws_ + CTL_ROWSS); const pg8::facc_t* bias2 = (const pg8::facc_t*)(ws_ + CTL_BIAS2); \
    (void)Hb; (void)Ab; (void)Bb; (void)Cb; (void)Db; (void)Eb; (void)mod; (void)gsv; (void)rowss; (void)bias2

    if (SITE(0) && IN(0)) { FRESH(); bg_run(args, lds, tid, wave, lane, vcu_, G_, BgTasks{0, -1, -1, -1}); }
    SEAM(0);
    if (SITE(0) && IN(1)) { for (int rep = 0; rep < NREP(0); ++rep) { FRESH(); bg_run(args, lds, tid, wave, lane, vcu_, G_, BgTasks{-1, 0, 0, -1}); prescale_phase(args, wave, lane, vcu_, G_); } }
    SEAM(1);

    for (int lp = 0; lp < 2; ++lp) {
        const int pb = 2 + lp * 8;
        { const int layer = 2 * lp;
          if (SITE(2) && IN(pb + 0)) { PTRS();
              constexpr int Gg = gemm_wgs((MT / 256) * (8192 / 256), G);
              pg8::Gemm g{Eb, (const bf16*)(ws_ + WS_WLIN) + (size_t)lp * 8192 * D, MT, 8192, D}; pg8::StaticOrder S; S.init(MT, 8192, Gg, bx);
              pg8::EpiRgIn E{Ab, Bb, rowss + (size_t)layer * MT, bias2 + (size_t)layer * 3 * pg8::NB2};
              S.rep = NREP(2);
              if (bx < Gg) pg8::gemm_phase<pg8::EpiRgIn, pg8::StaticOrder, true, PG8_SP2V>(lds, g, S, E);
              BG_SPARE(Gg, BgTasks{2 * lp + 1, -1, 2 + lp, -1});
          }
          SEAM(pb + 0);
          constexpr int GS = 218; const int sw = (bx & 7) * (GS / 8) + ((bx & 7) < (GS & 7) ? (bx & 7) : (GS & 7)) + (bx >> 3);
          if (SITE(3) && IN(pb + 1)) { PTRS();
              { int sw_ = sw; asm volatile("" : "+s"(sw_));
              if (bx < GS) for (int u2 = sw_; u2 < 68 * 16 * NREP(3); u2 += GS) { const int u = (NREP(3) == 2 && u2 >= 68 * 16) ? u2 - 68 * 16 : u2;
                  rg_unit<1>(lds, u, lp, Ab, Bb, Hb, args.in[I_LCONVW], args.in[I_LCONVB], (const v4u*)(ws_ + WS_WGATE), args.in[I_LGATEB], args.in[I_LLAM], (float*)(ws_ + WS_AGG2), (const float*)(ws_ + WS_CARRY), (unsigned*)(ws_ + WS_COEF), tid, wave, lane); } }
              if (lp == 0) BG_SPARE(GS, BgTasks{2, -1, -1, -1, 0, 96});
          }
          SEAM(pb + 1);
          if (SITE(3) && IN(pb + 2)) { PTRS(); FRESH();
              for (int it = vcu_; it < 256; it += G_) rg_carry(lds, it, (const float*)(ws_ + WS_AGG2), (float*)(ws_ + WS_CARRY), tid, wave, lane);
          }
          SEAM(pb + 2);
          if (SITE(4) && IN(pb + 3)) { PTRS();
              for (int rep = 0; rep < NREP(4); ++rep) { int sw_ = sw; asm volatile("" : "+s"(sw_));
#ifndef P2_REV
#define P2_REV 1
#endif
              if (bx < GS) for (int u0 = sw_; u0 < 68 * 16; u0 += GS) { const int ul = (68 * 16 - 1 - sw_) / GS * GS + sw_;
                  const int u = P2_REV ? ul - (u0 - sw_) : u0;
                  rg_unit2(u, Bb, Hb, (const float*)(ws_ + WS_CARRY), (const unsigned*)(ws_ + WS_COEF), wave, lane); } }
          }
          SEAM(pb + 3);
          if (SITE(5) && IN(pb + 4)) { PTRS();
              constexpr int Gg = gemm_wgs((MT / 256) * (D / 256), G);
              pg8::Gemm g{Hb, (const bf16*)(ws_ + WS_WLOUT) + (size_t)lp * D * D, MT, D, D}; pg8::StaticOrder S; S.init(MT, D, Gg, bx);
              const float* rgsv = (const float*)(ws_ + WS_RGS) + (size_t)layer * 3 * D;
              if (layer == 0) {
                  pg8::EpiOut<false, true> E{args.in[I_X], args.in[I_CTX], nullptr, mod + (size_t)layer * 3 * (3 * D) + 2 * D, rgsv,
                            Eb, gsv + (size_t)(layer + 1) * 3 * D, rowss + (size_t)(layer + 1) * MT, (LAS float*)(lds + EPI_P_OFF), NREP(5) == 2 ? 0.5f : 1.0f};
                  S.rep = NREP(5);
                  if (bx < Gg) pg8::gemm_phase<pg8::EpiOut<false, true>, pg8::StaticOrder, EPIOUT_ALIGN, PG8_SP2V>(lds, g, S, E);
              } else {
                  pg8::EpiOut<true, true> E{Eb, Eb + (size_t)ML * D, nullptr, mod + (size_t)layer * 3 * (3 * D) + 2 * D, rgsv,
                            Eb, gsv + (size_t)(layer + 1) * 3 * D, rowss + (size_t)(layer + 1) * MT, (LAS float*)(lds + EPI_P_OFF), 1.0f};
                  if (bx < Gg) pg8::gemm_phase<pg8::EpiOut<true, true>, pg8::StaticOrder, EPIOUT_ALIGN, PG8_SP2V>(lds, g, S, E);
              }
              BG_SPARE(Gg, BgTasks{-1, -1, 4 + lp, -1});
          }
          SEAM(pb + 4);
        }
        { const int layer = 2 * lp + 1; const bool last = layer == DEPTH - 1;
          if (SITE(6) && IN(pb + 5)) { PTRS();
              constexpr int Gg = gemm_wgs((MT / 256) * (16384 / 256), G);
              pg8::Gemm g{Eb, (const bf16*)(ws_ + WS_WNIN) + (size_t)lp * 16384 * D, MT, 16384, D}; pg8::StaticOrder S; S.init(MT, 16384, Gg, bx);
              pg8::EpiNaIn E{Ab, Bb, Cb, Db, args.in[I_NQKN] + (size_t)lp * 2 * HDIM, (LAS float*)(lds + EPI_P_OFF), rowss + (size_t)layer * MT, bias2 + (size_t)layer * 3 * pg8::NB2};
              S.rep = NREP(6);
              if (bx < Gg) pg8::gemm_phase<pg8::EpiNaIn, pg8::StaticOrder, true, PG8_SP2V>(lds, g, S, E);
              BG_SPARE(Gg, BgTasks{lp == 0 ? 2 : -1, -1, 6 + lp, -1, 96, 192});
          }
          SEAM(pb + 5);
          if (SITE(7) && IN(pb + 6)) { PTRS();
              { FRESH();
              const int nun = (4 + ((!last && vcu_ < 64) ? 1 : 0)) * NREP(7);
              for (int i2 = 0; i2 < nun; ++i2) { const int i = NREP(7) == 2 ? (i2 >> 1) : i2;
                  const int u = i < 4 ? ((vcu_ >> 5) * 8 + 2 * i + ((vcu_ >> 4) & 1)) * 16 + (vcu_ & 15) : 1024 + vcu_;
                  attn_unit(lds, u, Ab, Bb, Cb, Db, Hb, args.in[I_NRPB] + (size_t)lp * NHEAD * 15 * 31, tid, wave, lane); } }
          }
          SEAM(pb + 6);
          if (SITE(5) && IN(pb + 7)) { PTRS();
              const int Mo = last ? ML : MT;
              const int Gg = last ? gemm_wgs((ML / 256) * (D / 256), G) : gemm_wgs((MT / 256) * (D / 256), G);
              pg8::Gemm g{Hb, (const bf16*)(ws_ + WS_WNOUT) + (size_t)lp * D * D, Mo, D, D}; pg8::StaticOrder S; S.init(Mo, D, Gg, bx);
              const float* rgsv = (const float*)(ws_ + WS_RGS) + (size_t)layer * 3 * D;
              if (!last) {
                  pg8::EpiOut<true, true> E{Eb, Eb + (size_t)ML * D, nullptr, mod + (size_t)layer * 3 * (3 * D) + 2 * D, rgsv,
                            Eb, gsv + (size_t)(layer + 1) * 3 * D, rowss + (size_t)(layer + 1) * MT, (LAS float*)(lds + EPI_P_OFF), 1.0f};
                  if (bx < Gg) pg8::gemm_phase<pg8::EpiOut<true, true>, pg8::StaticOrder, EPIOUT_ALIGN, PG8_SP2V>(lds, g, S, E);
              } else {
                  pg8::EpiOut<true, false> E{Eb, Eb + (size_t)ML * D, args.out, mod + (size_t)layer * 3 * (3 * D) + 2 * D, rgsv,
                            (bf16*)nullptr, gsv, rowss, (LAS float*)(lds + EPI_P_OFF), 1.0f};
                  if (bx < Gg) pg8::gemm_phase<pg8::EpiOut<true, false>, pg8::StaticOrder, EPIOUT_ALIGN, PG8_SP2V>(lds, g, S, E);
              }
              if (!last) BG_SPARE(Gg, BgTasks{-1, 1, 1, -1});
          }
          SEAM(pb + 7);
        }
    }
#if STAMP_SEL
    xcd_barrier(bar);
    if (bx == STAMP_WG && tid == 0) args.out[0] = (float)MISC[20] * 1e-3f;
#endif
#undef IN
#undef SEAM
}

extern "C" void kernel_launch(void* const* d_in, const int* in_sizes, int n_in, void* d_out, int out_size, void* d_ws, size_t ws_size, hipStream_t stream) {
    static int grid = 0;
    if (grid == 0) {
        if (n_in != 18 || ws_size < WS_END) { fprintf(stderr, "kernel_launch: unexpected inputs (n_in %d, ws %zu)\n", n_in, ws_size); grid = -1; return; }
        int dev = 0, cus = 0, per_cu = 0;
        if (hipGetDevice(&dev) != hipSuccess || hipDeviceGetAttribute(&cus, hipDeviceAttributeMultiprocessorCount, dev) != hipSuccess) { grid = -1; return; }
        if (hipFuncSetAttribute((const void*)mega_fwd, hipFuncAttributeMaxDynamicSharedMemorySize, LDS_BYTES) != hipSuccess) { fprintf(stderr, "kernel_launch: hipFuncSetAttribute failed\n"); grid = -1; return; }
        if (hipOccupancyMaxActiveBlocksPerMultiprocessor(&per_cu, (const void*)mega_fwd, NWAVES * 64, LDS_BYTES) != hipSuccess || per_cu < 1)
            fprintf(stderr, "kernel_launch: occupancy query reports %d workgroups per CU\n", per_cu);
        (void)hipGetLastError();
        if (cus != 256) fprintf(stderr, "kernel_launch: built for a 256-CU device (one workgroup per CU), found %d CUs\n", cus);
        grid = 256;
    }
    if (grid < 0) return;
    if (hipMemsetAsync((char*)d_ws + WS_CTL, 0, CTL_ZERO_BYTES, stream) != hipSuccess) return;
    Args a{};
    for (int i = 0; i < 18; ++i) a.in[i] = (const float*)d_in[i];
    a.out = (float*)d_out; a.ws = (unsigned char*)d_ws;
#if MK_PER_PHASE
    for (int p = 0; p < NPHASE; ++p) { a.ph_lo = p; a.ph_hi = p + 1; hipLaunchKernelGGL(mega_fwd, dim3(grid), dim3(NWAVES * 64), LDS_BYTES, stream, a); }
#else
    a.ph_lo = 0; a.ph_hi = NPHASE;
    hipLaunchKernelGGL(mega_fwd, dim3(grid), dim3(NWAVES * 64), LDS_BYTES, stream, a);
#endif
    (void)in_sizes; (void)out_size;
}
```

```cpp
#define RG_SGB 9
#include <hip/hip_runtime.h>
#include <cstdio>
#include <cstdint>
#ifndef PG8_WGM
#define PG8_WGM 6
#endif
namespace pg8 {
#define PG8_LAS __attribute__((address_space(3)))
typedef unsigned short bf16_t;
typedef short bf16x8 __attribute__((ext_vector_type(8)));
typedef float f32x4 __attribute__((ext_vector_type(4)));
typedef unsigned u32x4 __attribute__((ext_vector_type(4)));
constexpr int BM = 256, BK = 64, HALF = 128, HTB = HALF * BK * 2  , STAGE_BYTES = 8 * HTB, NXCD = 8, WGM = PG8_WGM;

__host__ __device__ __forceinline__ int lds_byte(int r, int c) { const int st = (r >> 4) * 2 + (c >> 5), rr = r & 15, cc = c & 31, ob = rr * 64 + cc * 2; return st * 1024 + (ob ^ (((ob >> 9) & 1) << 5)); }
__host__ __device__ __forceinline__ void stage_rc(int b, int& R, int& C) { const int st = b / 1024, sb = b % 1024, swz = sb ^ (((sb >> 9) & 1) << 5); R = (st >> 1) * 16 + swz / 64; C = (st & 1) * 32 + (swz % 64) / 2; }
__host__ __device__ __forceinline__ int perm32(int rho) { const int n = rho >> 4, i = rho & 15; return 8 * (i >> 2) + 4 * n + (i & 3); }

struct Unit { int pm, pn; };
struct Gemm { const bf16_t* A; const bf16_t* Bt; int M, N, K; };

struct StaticOrder {
    int nM, nN, nwg, G, c, rep;
    __host__ __device__ void init(int M, int N, int G_, int c_) { nM = M / BM; nN = N / BM; nwg = nM * nN; G = G_; c = c_; rep = 1; }
    __host__ __device__ bool next(int i, Unit& u) const {
        long L = (long)i * G + c; if (L >= (long)nwg * rep) return false; if (rep > 1) L %= nwg;
        int wgid = (int)L; { const int q = nwg / NXCD, r = nwg % NXCD, xcd = wgid % NXCD, off = wgid / NXCD; wgid = (xcd < r ? xcd * (q + 1) : r * (q + 1) + (xcd - r) * q) + off; }
        const int nig = WGM * nN, gid = wgid / nig, fm = gid * WGM, gsz = (nM - fm) < WGM ? (nM - fm) : WGM;
        u.pm = fm + ((wgid % nig) % gsz); u.pn = (wgid % nig) / gsz; return true;
    }
    __device__ __forceinline__ void a_ready(const Unit&) const {}
    __device__ __forceinline__ void done(const Unit&) const {}
};

__device__ __forceinline__ unsigned cvt_pk_bf16(float lo, float hi) { unsigned r; asm volatile("v_cvt_pk_bf16_f32 %0, %1, %2" : "=v"(r) : "v"(lo), "v"(hi)); return r; }
__device__ __forceinline__ float silu_f(float v) { return v * __builtin_amdgcn_rcpf(1.0f + __builtin_amdgcn_exp2f(-1.4426950408889634f * v)); }
__device__ __forceinline__ f32x4 silu4(f32x4 v) { f32x4 o; o[0] = silu_f(v[0]); o[1] = silu_f(v[1]); o[2] = silu_f(v[2]); o[3] = silu_f(v[3]); return o; }
__device__ __forceinline__ float xrow16_sum(float x) {
    const auto s = __builtin_amdgcn_permlane16_swap(__float_as_uint(x), __float_as_uint(x), false, false); x = __uint_as_float(s[0]) + __uint_as_float(s[1]);
    const auto t = __builtin_amdgcn_permlane32_swap(__float_as_uint(x), __float_as_uint(x), false, false); return __uint_as_float(t[0]) + __uint_as_float(t[1]); }
__device__ __forceinline__ float xrow16_max(float x) {
    const auto s = __builtin_amdgcn_permlane16_swap(__float_as_uint(x), __float_as_uint(x), false, false); x = fmaxf(__uint_as_float(s[0]), __uint_as_float(s[1]));
    const auto t = __builtin_amdgcn_permlane32_swap(__float_as_uint(x), __float_as_uint(x), false, false); return fmaxf(__uint_as_float(t[0]), __uint_as_float(t[1])); }
constexpr int DM = 4096;

constexpr int NB2 = 16384;
typedef unsigned facc_t;
constexpr float RS_SCALE = 1024.0f;
constexpr float B2_SCALE = 1048576.0f;
__device__ __forceinline__ float rinv_of(const facc_t* rowss, int row) { return __builtin_amdgcn_rsqf((float)rowss[row] * (1.0f / (RS_SCALE * DM)) + 1e-6f); }
__device__ __forceinline__ f32x4 b2_load4(const facc_t* p) { typedef int i32x4 __attribute__((ext_vector_type(4))); const i32x4 a = *(const i32x4*)p;
    return (f32x4){(float)a.x * (1.0f / B2_SCALE), (float)a.y * (1.0f / B2_SCALE), (float)a.z * (1.0f / B2_SCALE), (float)a.w * (1.0f / B2_SCALE)}; }
#ifndef EPI_TWICE
#define EPI_TWICE 0
#endif
#define PG8_GAS __attribute__((address_space(1)))
__device__ __forceinline__ void epi_in_loads(const facc_t* rowss, const facc_t* b2, int row0, f32x4 (&bb)[2][2], float (&ri)[2][4]) {
    typedef int i32x4 __attribute__((ext_vector_type(4)));
    i32x4 br[2][2]; unsigned rs[2][4];
#pragma unroll
    for (int bj = 0; bj < 2; ++bj) { br[bj][0] = *(const PG8_GAS i32x4*)(b2 + bj * HALF); br[bj][1] = *(const PG8_GAS i32x4*)(b2 + bj * HALF + 4); }
#pragma unroll
    for (int ai = 0; ai < 2; ++ai)
#pragma unroll
        for (int m = 0; m < 4; ++m) rs[ai][m] = *(const PG8_GAS unsigned*)(rowss + row0 + ai * HALF + m * 16);
    asm volatile("" : "+v"(br[0][0]), "+v"(br[0][1]), "+v"(br[1][0]), "+v"(br[1][1]), "+v"(rs[0][0]), "+v"(rs[0][1]), "+v"(rs[0][2]), "+v"(rs[0][3]), "+v"(rs[1][0]), "+v"(rs[1][1]), "+v"(rs[1][2]), "+v"(rs[1][3]));
#pragma unroll
    for (int bj = 0; bj < 2; ++bj)
#pragma unroll
        for (int h = 0; h < 2; ++h) { const i32x4 a = br[bj][h]; bb[bj][h] = (f32x4){(float)a.x * (1.0f / B2_SCALE), (float)a.y * (1.0f / B2_SCALE), (float)a.z * (1.0f / B2_SCALE), (float)a.w * (1.0f / B2_SCALE)}; }
#pragma unroll
    for (int ai = 0; ai < 2; ++ai)
#pragma unroll
        for (int m = 0; m < 4; ++m) ri[ai][m] = __builtin_amdgcn_rsqf((float)rs[ai][m] * (1.0f / (RS_SCALE * DM)) + 1e-6f);
}
struct EpiRgIn {
    static constexpr bool PERM = true, AFTER_DRAIN = false, TWICE = (EPI_TWICE & 1) != 0;
    bf16_t* U; bf16_t* G; const facc_t* rowss; const facc_t* bias2;
    __device__ __forceinline__ void operator()(const f32x4 (&acc)[2][2][4][2], const Unit& u, int wr, int wc, int fr, int fq) const {
        const int row0 = u.pm * BM + wr * 64 + fr; const bool isg = u.pn >= 16; bf16_t* base = isg ? G : U; const int col0 = (u.pn & 15) * BM + wc * 32 + 8 * fq;
        const facc_t* b2 = bias2 + (size_t)(u.pm < 32 ? (u.pm >> 4) : 2) * NB2 + u.pn * BM + wc * 32 + 8 * fq;
        f32x4 bb[2][2]; float riv[2][4];
        epi_in_loads(rowss, b2, row0, bb, riv);
#pragma unroll
        for (int ai = 0; ai < 2; ++ai)
#pragma unroll
            for (int m = 0; m < 4; ++m) { bf16_t* rowp = base + (size_t)(row0 + ai * HALF + m * 16) * DM + col0; const float ri = riv[ai][m];
#pragma unroll
                for (int bj = 0; bj < 2; ++bj) { f32x4 v0 = acc[ai][bj][m][0] * ri + bb[bj][0], v1 = acc[ai][bj][m][1] * ri + bb[bj][1];
                    if (isg) { v0 = silu4(v0); v1 = silu4(v1); }
                    u32x4 w; w.x = cvt_pk_bf16(v0[0], v0[1]); w.y = cvt_pk_bf16(v0[2], v0[3]); w.z = cvt_pk_bf16(v1[0], v1[1]); w.w = cvt_pk_bf16(v1[2], v1[3]);
                    *(PG8_GAS u32x4*)(rowp + bj * HALF) = w; } }
    }
};
constexpr size_t HM_CTX = (size_t)2 * 32 * 4096 * 128;
__device__ __forceinline__ size_t hm_panel(int pm, int head) { return pm < 32 ? ((size_t)((pm >> 4) * 32 + head) * 4096 + (pm & 15) * 256) * 128 : HM_CTX + ((size_t)((pm - 32) * 32 + head) * 256) * 128; }
__device__ __forceinline__ size_t hm_head(int pm) { return pm < 32 ? (size_t)4096 * 128 : (size_t)256 * 128; }
struct EpiNaIn {
    static constexpr bool PERM = true, AFTER_DRAIN = false, TWICE = (EPI_TWICE & 2) != 0;
    bf16_t *Q, *K, *V, *G; const float* qkn; PG8_LAS float* P; const facc_t* rowss; const facc_t* bias2;
    __device__ __forceinline__ void operator()(const f32x4 (&acc0)[2][2][4][2], const Unit& u, int wr, int wc, int fr, int fq) const {
        const int t = u.pn >> 4; bf16_t* base = t == 0 ? Q : (t == 1 ? K : (t == 2 ? V : G));
        const int row0 = u.pm * BM + wr * 64 + fr, col0 = (u.pn & 15) * BM + wc * 32 + 8 * fq;
        bf16_t* hmb = base + hm_panel(u.pm, 2 * (u.pn & 15)) + (size_t)(wr * 64 + fr) * 128 + wc * 32 + 8 * fq; const size_t hmh = hm_head(u.pm);
        f32x4 acc[2][2][4][2];
        { const facc_t* b2 = bias2 + (size_t)(u.pm < 32 ? (u.pm >> 4) : 2) * NB2 + u.pn * BM + wc * 32 + 8 * fq;
          f32x4 bb[2][2]; float riv[2][4];
          epi_in_loads(rowss, b2, row0, bb, riv);
#pragma unroll
          for (int ai = 0; ai < 2; ++ai)
#pragma unroll
              for (int m = 0; m < 4; ++m) { const float ri = riv[ai][m];
#pragma unroll
                  for (int bj = 0; bj < 2; ++bj) { acc[ai][bj][m][0] = acc0[ai][bj][m][0] * ri + bb[bj][0]; acc[ai][bj][m][1] = acc0[ai][bj][m][1] * ri + bb[bj][1]; } } }
        if (t < 2) {
#pragma unroll
            for (int ai = 0; ai < 2; ++ai)
#pragma unroll
                for (int m = 0; m < 4; ++m)
#pragma unroll
                    for (int bj = 0; bj < 2; ++bj) { const f32x4 a = acc[ai][bj][m][0], b = acc[ai][bj][m][1];
                        float s = (a[0] * a[0] + a[1] * a[1]) + (a[2] * a[2] + a[3] * a[3]) + (b[0] * b[0] + b[1] * b[1]) + (b[2] * b[2] + b[3] * b[3]);
                        s = xrow16_sum(s);
                        if (fq == 0) P[((ai * HALF + wr * 64 + m * 16 + fr) * 2 + bj) * 4 + wc] = s; }
            asm volatile("s_waitcnt lgkmcnt(0)" ::: "memory"); __builtin_amdgcn_s_barrier(); asm volatile("" ::: "memory");
            const float* wg = qkn + t * 128 + wc * 32 + 8 * fq; const f32x4 w0 = *(const PG8_GAS f32x4*)wg, w1 = *(const PG8_GAS f32x4*)(wg + 4);
            float rq[2][4][2];
#pragma unroll
            for (int ai = 0; ai < 2; ++ai)
#pragma unroll
                for (int m = 0; m < 4; ++m)
#pragma unroll
                    for (int bj = 0; bj < 2; ++bj) { const f32x4 p = *(const PG8_LAS f32x4*)(P + ((ai * HALF + wr * 64 + m * 16 + fr) * 2 + bj) * 4);
                        rq[ai][m][bj] = __builtin_amdgcn_rsqf(((p[0] + p[1]) + (p[2] + p[3])) * (1.0f / 128.0f) + 1e-6f); }
#pragma unroll
            for (int ai = 0; ai < 2; ++ai)
#pragma unroll
                for (int m = 0; m < 4; ++m) { const int row = row0 + ai * HALF + m * 16;
                    bf16_t* rowp = t == 1 ? hmb + (size_t)(ai * HALF + m * 16) * 128 : base + (size_t)row * DM + col0;
#pragma unroll
                    for (int bj = 0; bj < 2; ++bj) { const float rinv = rq[ai][m][bj];
                        const f32x4 v0 = acc[ai][bj][m][0] * rinv * w0, v1 = acc[ai][bj][m][1] * rinv * w1;
                        u32x4 w; w.x = cvt_pk_bf16(v0[0], v0[1]); w.y = cvt_pk_bf16(v0[2], v0[3]); w.z = cvt_pk_bf16(v1[0], v1[1]); w.w = cvt_pk_bf16(v1[2], v1[3]);
                        *(PG8_GAS u32x4*)(rowp + (t == 1 ? bj * hmh : (size_t)(bj * HALF))) = w; } }
        } else {
#pragma unroll
            for (int ai = 0; ai < 2; ++ai)
#pragma unroll
                for (int m = 0; m < 4; ++m) { const int row = row0 + ai * HALF + m * 16;
                    bf16_t* rowp = t == 2 ? hmb + (size_t)(ai * HALF + m * 16) * 128 : base + (size_t)row * DM + col0;
#pragma unroll
                    for (int bj = 0; bj < 2; ++bj) { f32x4 v0 = acc[ai][bj][m][0], v1 = acc[ai][bj][m][1];
                        if (t == 3) { v0 = silu4(v0); v1 = silu4(v1); }
                        u32x4 w; w.x = cvt_pk_bf16(v0[0], v0[1]); w.y = cvt_pk_bf16(v0[2], v0[3]); w.z = cvt_pk_bf16(v1[0], v1[1]); w.w = cvt_pk_bf16(v1[2], v1[3]);
                        *(PG8_GAS u32x4*)(rowp + (t == 2 ? bj * hmh : (size_t)(bj * HALF))) = w; } }
        }
    }
};
template <bool SRC_BF16, bool DST_BF16>
struct EpiOut {
    static constexpr bool PERM = true, AFTER_DRAIN = false, TWICE = false;
    const void* src_lat; const void* src_ctx; void* dst; const float* gate;
    const float* rgs;
    bf16_t* XG; const float* gsn; facc_t* rowss_n; PG8_LAS float* P; float ssw;
    __device__ __forceinline__ void operator()(const f32x4 (&acc)[2][2][4][2], const Unit& u, int wr, int wc, int fr, int fq) const {
        const int row0 = u.pm * BM + wr * 64 + fr, col0 = u.pn * BM + wc * 32 + 8 * fq; const int r = u.pm < 32 ? (u.pm >> 4) : 2;
        const float* gp = gate + (size_t)r * (3 * DM) + col0;
        f32x4 gv[2][2], gs[2][2], rg[2][2];
#pragma unroll
        for (int bj = 0; bj < 2; ++bj)
#pragma unroll
            for (int n = 0; n < 2; ++n) { gv[bj][n] = *(const PG8_GAS f32x4*)(gp + bj * HALF + n * 4); gs[bj][n] = XG ? *(const PG8_GAS f32x4*)(gsn + (size_t)r * DM + col0 + bj * HALF + n * 4) : (f32x4){0.f, 0.f, 0.f, 0.f};
                rg[bj][n] = SRC_BF16 ? *(const PG8_GAS f32x4*)(rgs + (size_t)r * DM + col0 + bj * HALF + n * 4) : (f32x4){1.f, 1.f, 1.f, 1.f}; }
        f32x4 sv[4][2][2]; u32x4 sb[4][2];
#define EPIOUT_REQ(AIH) do { const int ai_ = (AIH) >> 1, mh_ = ((AIH) & 1) * 2; _Pragma("unroll") for (int m = mh_; m < mh_ + 2; ++m) { const int row = row0 + ai_ * HALF + m * 16; \
                const size_t so = (row < 8192 ? (size_t)row * DM : (size_t)(row - 8192) * DM) + col0; \
                _Pragma("unroll") for (int bj = 0; bj < 2; ++bj) { \
                    if (SRC_BF16) sb[m][bj] = *(const PG8_GAS u32x4*)((const bf16_t*)(row < 8192 ? src_lat : src_ctx) + so + bj * HALF); \
                    else { const float* sp = (const float*)(row < 8192 ? src_lat : src_ctx) + so + bj * HALF; sv[m][bj][0] = *(const PG8_GAS f32x4*)sp; sv[m][bj][1] = *(const PG8_GAS f32x4*)(sp + 4); } } } } while (0)
        if (SRC_BF16) EPIOUT_REQ(0);
#pragma unroll
        for (int aih = 0; aih < 4; ++aih) { const int ai = aih >> 1, mh = (aih & 1) * 2;
            if (SRC_BF16) { if (aih + 1 < 4) EPIOUT_REQ(aih + 1); } else EPIOUT_REQ(aih);
            asm volatile("" ::: "memory");
#pragma unroll
            for (int m = mh; m < mh + 2; ++m) { const int row = row0 + ai * HALF + m * 16;
                float ss = 0.f;
#pragma unroll
                for (int bj = 0; bj < 2; ++bj) {
                    if (SRC_BF16) { const u32x4 w = sb[m][bj];
                        sv[m][bj][0] = (f32x4){__uint_as_float(w.x << 16), __uint_as_float(w.x & 0xffff0000u), __uint_as_float(w.y << 16), __uint_as_float(w.y & 0xffff0000u)} * rg[bj][0];
                        sv[m][bj][1] = (f32x4){__uint_as_float(w.z << 16), __uint_as_float(w.z & 0xffff0000u), __uint_as_float(w.w << 16), __uint_as_float(w.w & 0xffff0000u)} * rg[bj][1]; }
                    const f32x4 o0 = sv[m][bj][0] + gv[bj][0] * acc[ai][bj][m][0], o1 = sv[m][bj][1] + gv[bj][1] * acc[ai][bj][m][1];
                    if (!DST_BF16) { float* dp = (float*)dst + (size_t)row * DM + col0 + bj * HALF; *(PG8_GAS f32x4*)dp = o0; *(PG8_GAS f32x4*)(dp + 4) = o1; }
                    if (XG) { ss += (o0[0] * o0[0] + o0[1] * o0[1]) + (o0[2] * o0[2] + o0[3] * o0[3]) + (o1[0] * o1[0] + o1[1] * o1[1]) + (o1[2] * o1[2] + o1[3] * o1[3]);
                        const f32x4 y0 = o0 * gs[bj][0], y1 = o1 * gs[bj][1];
                        u32x4 w; w.x = cvt_pk_bf16(y0[0], y0[1]); w.y = cvt_pk_bf16(y0[2], y0[3]); w.z = cvt_pk_bf16(y1[0], y1[1]); w.w = cvt_pk_bf16(y1[2], y1[3]);
                        *(PG8_GAS u32x4*)(XG + (size_t)row * DM + col0 + bj * HALF) = w; } }
                if (XG) { ss = xrow16_sum(ss); if (fq == 0) __hip_atomic_fetch_add((PG8_GAS facc_t*)(rowss_n + row), (facc_t)(ss * (ssw * RS_SCALE) + 0.5f), __ATOMIC_RELAXED, __HIP_MEMORY_SCOPE_AGENT); } }
        }
#undef EPIOUT_REQ
    }
};

template <class Epi, class Sched, bool ALIGN_EPI = false, bool SP2 = false>
__device__ __forceinline__ void gemm_phase(PG8_LAS unsigned char* lds, const Gemm g, const Sched& S, const Epi& E) {
    int tid_o = threadIdx.x; asm volatile("" : "+v"(tid_o));
    const int tid = tid_o, wid = __builtin_amdgcn_readfirstlane(tid >> 6), lane = tid & 63, wr = wid >> 2, wc = wid & 3, fr = lane & 15, fq = lane >> 4;
    const int K = g.K, nt = K / BK;
    unsigned voffA[2], voffB[2];
#pragma unroll
    for (int i = 0; i < 2; ++i) { int R, C; stage_rc(tid * 16 + i * 8192, R, C); const int Rb = Epi::PERM ? ((R & ~31) + perm32(R & 31)) : R;
        voffA[i] = (unsigned)(R * K + C) * 2u; voffB[i] = (unsigned)(Rb * K + C) * 2u; }
    const size_t kstep = (size_t)(BK * 2);
    const size_t hstep = (size_t)HALF * K * 2;
    const size_t tstep = 2 * hstep;
    const unsigned ldsw = (unsigned)wid * 1024u;
    const int aoff = lds_byte(wr * 64 + fr, fq * 8), boff = lds_byte(wc * 32 + fr, fq * 8);
#define PG8_SA(b, h) (((b) * 2 + (h)) * HTB)
#define PG8_SB(b, h) ((4 + (b) * 2 + (h)) * HTB)
#define PG8_STAGE(bufoff, gbase, voff) do { _Pragma("unroll") for (int _i = 0; _i < 2; ++_i) \
        __builtin_amdgcn_global_load_lds((const unsigned*)((const char*)(gbase) + (voff)[_i]), (PG8_LAS unsigned*)(lds + (bufoff) + ldsw + _i * 8192), 16, 0, 0); } while (0)
#define PG8_LDA(dst, b, h) do { _Pragma("unroll") for (int m = 0; m < 4; ++m) _Pragma("unroll") for (int k = 0; k < 2; ++k) dst[m][k] = *(const PG8_LAS bf16x8*)(lds + PG8_SA(b, h) + aoff + m * 2048 + k * 1024); } while (0)
#define PG8_LDB(dst, b, h) do { _Pragma("unroll") for (int n = 0; n < 2; ++n) _Pragma("unroll") for (int k = 0; k < 2; ++k) dst[n][k] = *(const PG8_LAS bf16x8*)(lds + PG8_SB(b, h) + boff + n * 2048 + k * 1024); } while (0)
#ifndef PG8_PRIO
#define PG8_PRIO 1
#endif
#define PG8_MMA(ai, bj, At, Bt) do { if (PG8_PRIO) __builtin_amdgcn_s_setprio(1); _Pragma("unroll") for (int m = 0; m < 4; ++m) _Pragma("unroll") for (int n = 0; n < 2; ++n) _Pragma("unroll") for (int k = 0; k < 2; ++k) \
        acc[ai][bj][m][n] = __builtin_amdgcn_mfma_f32_16x16x32_bf16(Bt[n][k], At[m][k], acc[ai][bj][m][n], 0, 0, 0); if (PG8_PRIO) __builtin_amdgcn_s_setprio(0); } while (0)
#define PG8_WAIT_V(n) asm volatile("s_waitcnt vmcnt(" #n ")" ::: "memory")
#define PG8_WAIT_L(n) asm volatile("s_waitcnt lgkmcnt(" #n ")" ::: "memory")
#define PG8_BAR __builtin_amdgcn_s_barrier()
#define PG8_SCHED __builtin_amdgcn_sched_barrier(0)
    Unit cur, nxt; int ui = 0;
    if (!S.next(0, cur)) return;
    f32x4 acc[2][2][4][2];
#pragma unroll
    for (int a = 0; a < 2; ++a)
#pragma unroll
        for (int b = 0; b < 2; ++b)
#pragma unroll
            for (int m = 0; m < 4; ++m)
#pragma unroll
                for (int n = 0; n < 2; ++n) acc[a][b][m][n] = (f32x4){0.f, 0.f, 0.f, 0.f};
    bf16x8 At[4][2], B0[2][2], B1[2][2];
    const char* cA = (const char*)g.A + (size_t)cur.pm * tstep; const char* cB = (const char*)g.Bt + (size_t)cur.pn * tstep;
    S.a_ready(cur);
    if constexpr (SP2) {
        PG8_STAGE(PG8_SB(0, 0), cB, voffB); PG8_STAGE(PG8_SB(0, 1), cB + hstep, voffB); PG8_STAGE(PG8_SA(0, 0), cA, voffA); PG8_STAGE(PG8_SA(0, 1), cA + hstep, voffA);
        if (wr == 1) PG8_BAR;
        PG8_WAIT_V(2); PG8_BAR;
        PG8_STAGE(PG8_SB(1, 0), cB + kstep, voffB); PG8_STAGE(PG8_SA(1, 0), cA + kstep, voffA); PG8_STAGE(PG8_SB(1, 1), cB + hstep + kstep, voffB);
        PG8_WAIT_V(6); PG8_BAR;
    } else {
        PG8_STAGE(PG8_SB(0, 0), cB, voffB); PG8_STAGE(PG8_SA(0, 0), cA, voffA); PG8_STAGE(PG8_SB(0, 1), cB + hstep, voffB); PG8_STAGE(PG8_SA(0, 1), cA + hstep, voffA);
        if (wr == 1) PG8_BAR;
        PG8_WAIT_V(4); PG8_BAR;
        PG8_STAGE(PG8_SB(1, 0), cB + kstep, voffB); PG8_STAGE(PG8_SA(1, 0), cA + kstep, voffA); PG8_STAGE(PG8_SB(1, 1), cB + hstep + kstep, voffB);
        PG8_WAIT_V(6); PG8_BAR;
    }
    for (;;) {
        const bool has_next = S.next(ui + 1, nxt);
        const char* nA = has_next ? (const char*)g.A + (size_t)nxt.pm * tstep : cA; const char* nB = has_next ? (const char*)g.Bt + (size_t)nxt.pn * tstep : cB;
        for (int t = 0; t < nt; t += 2) {
            const bool last = (t == nt - 2);
            const char* a1 = cA + (size_t)(t + 1) * kstep;
            const char* a2 = last ? nA : cA + (size_t)(t + 2) * kstep; const char* b2 = last ? nB : cB + (size_t)(t + 2) * kstep;
            const char* a3 = a2 + kstep; const char* b3 = b2 + kstep;
            if (last && has_next) S.a_ready(nxt);
            if constexpr (SP2) {
            PG8_LDB(B0, 0, 0); PG8_LDB(B1, 0, 1); PG8_SCHED; PG8_LDA(At, 0, 0); PG8_STAGE(PG8_SA(1, 1), a1 + hstep, voffA);
            PG8_WAIT_V(8); PG8_WAIT_L(0); PG8_BAR; PG8_MMA(0, 0, At, B0); PG8_MMA(0, 1, At, B1); PG8_BAR; PG8_SCHED;
            PG8_LDA(At, 0, 1); PG8_STAGE(PG8_SB(0, 0), b2, voffB); PG8_STAGE(PG8_SB(0, 1), b2 + hstep, voffB); PG8_STAGE(PG8_SA(0, 0), a2, voffA);
            PG8_WAIT_V(8); PG8_WAIT_L(0); PG8_BAR; PG8_MMA(1, 0, At, B0); PG8_MMA(1, 1, At, B1); PG8_BAR; PG8_SCHED;
            PG8_LDB(B0, 1, 0); PG8_LDB(B1, 1, 1); PG8_SCHED; PG8_LDA(At, 1, 0); PG8_STAGE(PG8_SA(0, 1), a2 + hstep, voffA);
            PG8_WAIT_V(8); PG8_WAIT_L(0); PG8_BAR; PG8_MMA(0, 0, At, B0); PG8_MMA(0, 1, At, B1); PG8_BAR; PG8_SCHED;
            PG8_LDA(At, 1, 1); PG8_STAGE(PG8_SB(1, 0), b3, voffB); PG8_STAGE(PG8_SB(1, 1), b3 + hstep, voffB); PG8_STAGE(PG8_SA(1, 0), a3, voffA);
            PG8_WAIT_V(8); PG8_WAIT_L(0); PG8_BAR; PG8_MMA(1, 0, At, B0); PG8_MMA(1, 1, At, B1); PG8_BAR; PG8_SCHED;
            } else {
            PG8_LDB(B0, 0, 0); PG8_SCHED; PG8_LDA(At, 0, 0); PG8_STAGE(PG8_SA(1, 1), a1 + hstep, voffA);
            PG8_WAIT_L(8); PG8_BAR; PG8_WAIT_L(0); PG8_MMA(0, 0, At, B0); PG8_BAR; PG8_SCHED;
            PG8_LDB(B1, 0, 1); PG8_STAGE(PG8_SB(0, 0), b2, voffB);
            PG8_BAR; PG8_WAIT_L(0); PG8_MMA(0, 1, At, B1); PG8_BAR;
            PG8_LDA(At, 0, 1); PG8_STAGE(PG8_SA(0, 0), a2, voffA);
            PG8_BAR; PG8_WAIT_L(0); PG8_MMA(1, 0, At, B0); PG8_BAR; PG8_SCHED;
            PG8_STAGE(PG8_SB(0, 1), b2 + hstep, voffB);
            PG8_WAIT_V(6); PG8_BAR; PG8_MMA(1, 1, At, B1); PG8_BAR;
            PG8_LDB(B0, 1, 0); PG8_SCHED; PG8_LDA(At, 1, 0); PG8_STAGE(PG8_SA(0, 1), a2 + hstep, voffA);
            PG8_WAIT_L(8); PG8_BAR; PG8_WAIT_L(0); PG8_MMA(0, 0, At, B0); PG8_BAR; PG8_SCHED;
            PG8_LDB(B1, 1, 1); PG8_STAGE(PG8_SB(1, 0), b3, voffB);
            PG8_BAR; PG8_WAIT_L(0); PG8_MMA(0, 1, At, B1); PG8_BAR;
            PG8_LDA(At, 1, 1); PG8_STAGE(PG8_SA(1, 0), a3, voffA);
            PG8_BAR; PG8_WAIT_L(0); PG8_MMA(1, 0, At, B0); PG8_BAR; PG8_SCHED;
            PG8_STAGE(PG8_SB(1, 1), b3 + hstep, voffB);
            PG8_WAIT_V(6); PG8_BAR; PG8_MMA(1, 1, At, B1); PG8_BAR;
            }
        }
        if constexpr (ALIGN_EPI) { if (wr == 0) PG8_BAR; }
        if constexpr (!Epi::AFTER_DRAIN) { if constexpr (Epi::TWICE) { int ne_ = 2; asm volatile("" : "+s"(ne_)); _Pragma("unroll 1") for (int e_ = 0; e_ < ne_; ++e_) { asm volatile("" ::: "memory"); E(acc, cur, wr, wc, fr, fq); } } else E(acc, cur, wr, wc, fr, fq); S.done(cur); }
        if (!has_next) break;
#pragma unroll
        for (int a = 0; a < 2; ++a)
#pragma unroll
            for (int b = 0; b < 2; ++b)
#pragma unroll
                for (int m = 0; m < 4; ++m)
#pragma unroll
                    for (int n = 0; n < 2; ++n) acc[a][b][m][n] = (f32x4){0.f, 0.f, 0.f, 0.f};
        cur = nxt; cA = nA; cB = nB; ++ui;
        if constexpr (ALIGN_EPI) { if (wr == 1) PG8_BAR; }
    }
    PG8_WAIT_V(0);
    if constexpr (!ALIGN_EPI) { if (wr == 0) PG8_BAR; }
    PG8_BAR;
    if constexpr (Epi::AFTER_DRAIN) { E.fused(acc, cur, wr, wc, fr, fq, lds, wid, lane); S.done(cur); }
#undef PG8_SA
#undef PG8_SB
#undef PG8_STAGE
#undef PG8_LDA
#undef PG8_LDB
#undef PG8_MMA
#undef PG8_WAIT_V
#undef PG8_WAIT_L
#undef PG8_BAR
#undef PG8_SCHED
}
}

#ifndef EPIOUT_ALIGN
#define EPIOUT_ALIGN true
#endif
#ifndef PG8_SP2V
#define PG8_SP2V true
#endif
constexpr int NWAVES = 8;
constexpr int D = 4096, NBATCH = 2, SEQ = 4096, CTXL = 256, DEPTH = 4, NHEAD = 32, HDIM = 128;
constexpr int ML = NBATCH * SEQ;
constexpr int MC = NBATCH * CTXL;
constexpr int MT = ML + MC;
constexpr float EPS = 1e-6f;
constexpr float LOG2E = 1.4426950408889634f;
constexpr float ATTN_C1 = 0.08838834764831845f * LOG2E;

#ifndef DUP_MASK
#define DUP_MASK 0
#endif
#define NREP(x) (1 + ((DUP_MASK >> (x)) & 1))
#ifndef MK_PER_PHASE
#define MK_PER_PHASE 0
#endif
constexpr int NPHASE = 18;

constexpr size_t MiB = 1u << 20;
constexpr size_t WS_CTL = 0, CTL_ZERO_BYTES = 4 * MiB;
constexpr size_t WS_MOD = 1 * MiB;
constexpr size_t WS_WGATE = 8 * MiB;
constexpr size_t WS_WLIN = 24 * MiB;
constexpr size_t WS_WLOUT = 152 * MiB;
constexpr size_t WS_WNIN = 216 * MiB;
constexpr size_t WS_WNOUT = 472 * MiB;
constexpr size_t WS_H = 672 * MiB;
constexpr size_t WS_A = 740 * MiB, WS_B = 808 * MiB, WS_C = 876 * MiB, WS_D = 944 * MiB;
constexpr size_t WS_AGG2 = 1012 * MiB;
constexpr size_t WS_CARRY = 1022 * MiB;
constexpr size_t WS_E = 1028 * MiB;
constexpr size_t WS_GS = 1096 * MiB;
constexpr size_t WS_COEF = 1097 * MiB;
constexpr size_t WS_RGS = 1370 * MiB;
constexpr size_t WS_END = 1371 * MiB;
constexpr size_t CTL_ROWSS = 2 * MiB;
constexpr size_t CTL_BIAS2 = 2 * MiB + 512 * 1024;
constexpr int CW_BAR = 4096;

constexpr int RING_BYTES = 131072;
constexpr int EPI_P_OFF = RING_BYTES;
constexpr int MISC_OFF = RING_BYTES + 8192 + 320;
constexpr int LDS_BYTES = 147456;

#define GAS __attribute__((address_space(1)))
#define LAS __attribute__((address_space(3)))
#define DI __device__ __forceinline__
typedef unsigned short bf16;
typedef unsigned v4u __attribute__((ext_vector_type(4)));
typedef unsigned v2u __attribute__((ext_vector_type(2)));
typedef float f32x4 __attribute__((ext_vector_type(4)));
typedef float f32x16 __attribute__((ext_vector_type(16)));
typedef short bf16x8 __attribute__((ext_vector_type(8)));
typedef short s16x4 __attribute__((ext_vector_type(4)));
#define LDS_WAIT() asm volatile("s_waitcnt lgkmcnt(0)" ::: "memory")
#define VM_WAIT() asm volatile("s_waitcnt vmcnt(0)" ::: "memory")
DI unsigned pk2(float lo, float hi) { return pg8::cvt_pk_bf16(lo, hi); }
DI float bflo(unsigned w) { return __uint_as_float(w << 16); }
DI float bfhi(unsigned w) { return __uint_as_float(w & 0xffff0000u); }
DI float fast_exp2(float x) { return __builtin_amdgcn_exp2f(x); }
DI float fast_rcp(float x) { return __builtin_amdgcn_rcpf(x); }

#define XB_TMO      128
#define XB_XCNT(j)  (256  + 64 * (j))
#define XB_XSUB(j)  (1280 + 64 * (j))
#define XB_XGEN(j)  (2304 + 64 * (j))
#define XB_TOP      3328
#define XB_TOPGEN   3392
#define XCD_BAR_WORDS 3456
#define XB_SPIN_CAP (1u << 18)
__device__ __forceinline__ unsigned xb_ld(unsigned* p)              { return __hip_atomic_load(p, __ATOMIC_RELAXED, __HIP_MEMORY_SCOPE_AGENT); }
__device__ __forceinline__ unsigned xb_add(unsigned* p, unsigned v) { return __hip_atomic_fetch_add(p, v, __ATOMIC_RELAXED, __HIP_MEMORY_SCOPE_AGENT); }
__device__ __forceinline__ unsigned xb_xcc_id() { return (unsigned)__builtin_amdgcn_s_getreg((3 << 11) | 20) & 0xFu; }
#define XB_SPIN(cond, bar) do { unsigned _sp = 0; while (cond) { __builtin_amdgcn_s_sleep(1); \
    if ((++_sp & 255u) == 0u) { if (xb_ld(&(bar)[XB_TMO])) break; if (_sp > XB_SPIN_CAP) { atomicAdd(&(bar)[XB_TMO], 1u); break; } } } } while (0)
struct XcdBarrier { unsigned* bar; unsigned x; volatile LAS unsigned* st; };
__device__ __forceinline__ XcdBarrier xcd_barrier_post(unsigned* bar, volatile LAS unsigned* st) {
    XcdBarrier b; b.bar = bar; b.x = xb_xcc_id(); b.st = st;
    if (threadIdx.x == 0) (void)xb_add(&bar[XB_XCNT(b.x)], 1u);
    return b;
}
__device__ __forceinline__ void xcd_barrier_complete(unsigned* bar, unsigned x, unsigned& nloc, unsigned& nx) {
    const unsigned G = gridDim.x * gridDim.y * gridDim.z;
    unsigned sum, cnt, mine, sp = 0u;
    for (;;) {
        sum = 0u; cnt = 0u; mine = 0u;
#pragma unroll
        for (unsigned j0 = 0; j0 < 16; j0 += 8) {
            unsigned c8[8];
#pragma unroll
            for (unsigned j = 0; j < 8; ++j) c8[j] = xb_ld(&bar[XB_XCNT(j0 + j)]);
            asm volatile("" : "+v"(c8[0]), "+v"(c8[1]), "+v"(c8[2]), "+v"(c8[3]), "+v"(c8[4]), "+v"(c8[5]), "+v"(c8[6]), "+v"(c8[7]));
#pragma unroll
            for (unsigned j = 0; j < 8; ++j) { const unsigned c = c8[j]; sum += c; cnt += (c > 0u) ? 1u : 0u; mine = (j0 + j == x) ? c : mine; } }
        if (sum == G) break;
        __builtin_amdgcn_s_sleep(1);
        if ((++sp & 255u) == 0u) { if (xb_ld(&bar[XB_TMO])) break; if (sp > XB_SPIN_CAP) { atomicAdd(&bar[XB_TMO], 1u); break; } }
    }
    nloc = mine > 0u ? mine : 1u; nx = cnt > 0u ? cnt : 1u;
}
__device__ __forceinline__ void xcd_barrier(const XcdBarrier& b) {
    asm volatile("s_waitcnt vmcnt(0)" ::: "memory");
    __syncthreads();
    if (threadIdx.x == 0) {
        unsigned* bar = b.bar;
        __builtin_amdgcn_s_waitcnt(0);
        const unsigned bx_ = xb_xcc_id();
        unsigned nloc = b.st[0], nx = b.st[1];
        if (nloc == 0u) { xcd_barrier_complete(bar, bx_, nloc, nx); b.st[0] = nloc; b.st[1] = nx; }
        const unsigned old = xb_add(&bar[XB_XSUB(bx_)], 1u);
        const unsigned gen = old / nloc;
        if (old + 1u == (gen + 1u) * nloc) {
            __builtin_amdgcn_fence(__ATOMIC_RELEASE, "agent");
            asm volatile("s_waitcnt vmcnt(0)" ::: "memory");
            const unsigned og = xb_add(&bar[XB_TOP], 1u);
            const unsigned tg = og / nx;
            if (og + 1u == (tg + 1u) * nx) xb_add(&bar[XB_TOPGEN], 1u);
            else XB_SPIN(xb_ld(&bar[XB_TOPGEN]) == tg, bar);
            __builtin_amdgcn_fence(__ATOMIC_ACQUIRE, "agent");
            xb_add(&bar[XB_XGEN(bx_)], 1u);
            asm volatile("s_waitcnt vmcnt(0)" ::: "memory");
        } else {
            XB_SPIN(xb_ld(&bar[XB_XGEN(bx_)]) == gen, bar);
            __builtin_amdgcn_fence(__ATOMIC_ACQUIRE, "agent");
            asm volatile("s_waitcnt vmcnt(0)" ::: "memory");
        }
    }
    __syncthreads();
}

struct Args { const float* in[18]; float* out; unsigned char* ws; int ph_lo, ph_hi; };
enum { I_X = 0, I_C, I_CTX, I_CCTX, I_ADAW, I_ADAB, I_NORMG, I_LIN, I_LCONVW, I_LCONVB, I_LGATEW, I_LGATEB, I_LLAM, I_LOUT, I_NIN, I_NQKN, I_NRPB, I_NOUT };

DI float wave_sum(float v) {
#pragma unroll
    for (int o = 1; o < 64; o <<= 1) v += __shfl_xor(v, o);
    return v;
}

DI void tr_load(const float* W, int N, int item, int lane, f32x4 (&v)[16]) {
    const int nblk = N >> 6, kb = item / nblk, nb = item - kb * nblk;
    const GAS float* p = (const GAS float*)W + (size_t)(64 * kb + (lane >> 4)) * N + 64 * nb + 4 * (lane & 15);
#pragma unroll
    for (int i = 0; i < 16; ++i) v[i] = __builtin_nontemporal_load((const GAS f32x4*)(p + (size_t)(4 * i) * N));
}
DI void tr_store(bf16* WT, int K, int N, int item, int lane, LAS float* scr, const f32x4 (&v)[16], const float* shift, pg8::facc_t* bias2) {
    const int nblk = N >> 6, kb = item / nblk, nb = item - kb * nblk;
    { LAS float* w = scr + (lane >> 4) * 65 + 4 * (lane & 15);
#pragma unroll
      for (int i = 0; i < 16; ++i) { w[(4 * i) * 65 + 0] = v[i][0]; w[(4 * i) * 65 + 1] = v[i][1]; w[(4 * i) * 65 + 2] = v[i][2]; w[(4 * i) * 65 + 3] = v[i][3]; } }
    LDS_WAIT(); asm volatile("" ::: "memory");
    if (shift) {
        const float h0 = shift[64 * kb + lane], h1 = shift[3 * D + 64 * kb + lane], h2 = shift[6 * D + 64 * kb + lane];
        float s0 = 0.f, s1 = 0.f, s2 = 0.f;
#pragma unroll
        for (int k = 0; k < 64; ++k) { const float w = scr[k * 65 + lane];
            s0 += __builtin_bit_cast(float, __builtin_amdgcn_readlane(__builtin_bit_cast(int, h0), k)) * w;
            s1 += __builtin_bit_cast(float, __builtin_amdgcn_readlane(__builtin_bit_cast(int, h1), k)) * w;
            s2 += __builtin_bit_cast(float, __builtin_amdgcn_readlane(__builtin_bit_cast(int, h2), k)) * w; }
        pg8::facc_t* bp = bias2 + 64 * nb + lane;
        atomicAdd(bp, (pg8::facc_t)(int)rintf(s0 * pg8::B2_SCALE)); atomicAdd(bp + pg8::NB2, (pg8::facc_t)(int)rintf(s1 * pg8::B2_SCALE)); atomicAdd(bp + 2 * pg8::NB2, (pg8::facc_t)(int)rintf(s2 * pg8::B2_SCALE));
    }
    const int c = lane & 7;
#pragma unroll
    for (int j = 0; j < 8; ++j) { const int n = (lane >> 3) + 8 * j; const LAS float* q = scr + (8 * c) * 65 + n;
        v4u o; o.x = pk2(q[0 * 65], q[1 * 65]); o.y = pk2(q[2 * 65], q[3 * 65]); o.z = pk2(q[4 * 65], q[5 * 65]); o.w = pk2(q[6 * 65], q[7 * 65]);
        __builtin_nontemporal_store(o, (GAS v4u*)(WT + (size_t)(64 * nb + n) * K + 64 * kb + 8 * c)); }
    LDS_WAIT(); asm volatile("" ::: "memory");
}

struct BgTasks { int ada_layer, gate_lj, tr0, tr1, ada_lo = 0, ada_hi = 192; };
DI void bg_run(const Args& a, LAS unsigned char* lds, int tid, int wave, int lane, int widx, int nw, const BgTasks t) {
    asm volatile("" : "+v"(tid), "+v"(lane));
    unsigned char* ws = a.ws;
    if (t.ada_layer >= 0) {
        const int i = t.ada_layer;
        LAS f32x4* condL = (LAS f32x4*)lds;
        LAS float* red = (LAS float*)(lds + 65536);
        const float* c = a.in[I_C]; const float* cc = a.in[I_CCTX];
        for (int k = tid; k < D; k += NWAVES * 64) { f32x4 v; v[0] = pg8::silu_f(c[k]); v[1] = pg8::silu_f(c[D + k]); v[2] = pg8::silu_f(cc[k]); v[3] = 0.f; condL[k] = v; }
        __syncthreads();
        float* mod = (float*)(ws + WS_MOD);
        const int cw = nw >= 256 ? 48 : 64, ilo = nw >= 256 ? 0 : t.ada_lo, ihi = nw >= 256 ? (3 * D) / 48 : t.ada_hi;
        for (int item = ilo + widx; item < ihi; item += nw) {
            const int n0 = item * cw;
            const float* wp = a.in[I_ADAW] + ((size_t)i * D + wave * 512) * (3 * D) + n0 + lane;
            float a0 = 0.f, a1 = 0.f, a2 = 0.f;
            if (lane < cw) for (int kk = 0; kk < 512; kk += 32) {
                float w[32];
#pragma unroll
                for (int j = 0; j < 32; ++j) w[j] = __builtin_nontemporal_load(wp + (size_t)(kk + j) * (3 * D));
#pragma unroll
                for (int j = 0; j < 32; ++j) { const f32x4 cv = condL[wave * 512 + kk + j]; a0 += cv[0] * w[j]; a1 += cv[1] * w[j]; a2 += cv[2] * w[j]; }
            }
            red[(wave * 3 + 0) * 64 + lane] = a0; red[(wave * 3 + 1) * 64 + lane] = a1; red[(wave * 3 + 2) * 64 + lane] = a2;
            __syncthreads();
            if (tid < 192 && (tid & 63) < cw) { const int r = tid >> 6, l = tid & 63, n = n0 + l; float s = 0.f;
#pragma unroll
                for (int w8 = 0; w8 < 8; ++w8) s += red[(w8 * 3 + r) * 64 + l];
                const float val = s + a.in[I_ADAB][(size_t)i * (3 * D) + n];
                mod[((size_t)i * 3 + r) * (3 * D) + n] = val;
                if (n >= D && n < 2 * D) { float gsx = a.in[I_NORMG][(size_t)i * D + n - D] * (1.0f + val);
                    if (!(fabsf(gsx) >= 1e-18f)) gsx = gsx < 0.f ? -1e-18f : 1e-18f;
                    ((float*)(ws + WS_GS))[((size_t)i * 3 + r) * D + n - D] = gsx; ((float*)(ws + WS_RGS))[((size_t)i * 3 + r) * D + n - D] = 1.0f / gsx; } }
            __syncthreads();
        }
    }
    if (t.gate_lj >= 0) {
        const float* gw = a.in[I_LGATEW]; v4u* dst = (v4u*)(ws + WS_WGATE);
        for (int f0 = widx * (NWAVES * 64) + tid; f0 < 16 * 2 * 8 * 2 * 16 * 64; f0 += nw * NWAVES * 64) {
            const int f = f0 + (t.gate_lj << 19);
            const int ln = f & 63, ks = (f >> 6) & 15, gate = (f >> 10) & 1, jt = (f >> 11) & 7, dir = (f >> 14) & 1, nb = (f >> 15) & 15, lj = f >> 19;
            const int k0 = ks * 16 + 8 * (ln >> 5), j = jt * 32 + (ln & 31);
            const float* s = gw + ((((size_t)(lj * 2 + dir) * 2 + gate) * 16 + nb) * 256 + k0) * 256 + j;
            v4u o; o.x = pk2(s[0], s[256]); o.y = pk2(s[512], s[768]); o.z = pk2(s[1024], s[1280]); o.w = pk2(s[1536], s[1792]);
            dst[f] = o;
        }
    }
    {
        LAS float* scr = (LAS float*)(lds + wave * 16640);
#ifndef BG_WAVES
#define BG_WAVES 8
#endif
        const int nwv = nw >= 256 ? NWAVES : BG_WAVES;
        const int gw = widx * nwv + wave, NGW = nw * nwv;
#pragma unroll 1
        for (int q = 0; q < 2; ++q) { const int id = q == 0 ? t.tr0 : t.tr1; if (id < 0 || wave >= nwv) continue;
            const int kind = id >> 1, lj = id & 1; const int N = kind == 0 ? 8192 : (kind == 2 ? 16384 : D);
            const float* W = a.in[kind == 0 ? I_LIN : (kind == 1 ? I_LOUT : (kind == 2 ? I_NIN : I_NOUT))] + (size_t)lj * D * N;
            bf16* WT = (bf16*)(ws + (kind == 0 ? WS_WLIN : (kind == 1 ? WS_WLOUT : (kind == 2 ? WS_WNIN : WS_WNOUT)))) + (size_t)lj * N * D;
            const int nitems = 64 * (N / 64);
            const int lay = kind == 0 ? 2 * lj : 2 * lj + 1;
            const float* shift = (kind == 0 || kind == 2) ? (const float*)(ws + WS_MOD) + (size_t)lay * 3 * (3 * D) : nullptr;
            pg8::facc_t* bias2 = (pg8::facc_t*)(ws + CTL_BIAS2) + (size_t)lay * 3 * pg8::NB2;
            f32x4 va[16], vb[16];
            if (gw < nitems) tr_load(W, N, gw, lane, va);
            for (int it = gw; it < nitems; it += 2 * NGW) {
                if (it + NGW < nitems) tr_load(W, N, it + NGW, lane, vb);
                tr_store(WT, D, N, it, lane, scr, va, shift, bias2);
                if (it + 2 * NGW < nitems) tr_load(W, N, it + 2 * NGW, lane, va);
                if (it + NGW < nitems) tr_store(WT, D, N, it + NGW, lane, scr, vb, shift, bias2);
            }
        }
    }
    __syncthreads();
}
constexpr DI int gemm_wgs(int nunits, int G) { const int rounds = (nunits + G - 1) / G; return (nunits + rounds - 1) / rounds; }
#define BG_SPARE(Gg, ...) do { const BgTasks _t = __VA_ARGS__; if ((Gg) >= G) bg_run(args, lds, tid, wave, lane, bx, G, _t); else if (bx >= (Gg)) bg_run(args, lds, tid, wave, lane, bx - (Gg), G - (Gg), _t); } while (0)

DI void prescale_phase(const Args& a, int wave, int lane, int vcu, int G) {
    asm volatile("" : "+v"(lane));
    unsigned char* ws = a.ws;
    const float* gs = (const float*)(ws + WS_GS);
    pg8::facc_t* rowss = (pg8::facc_t*)(ws + CTL_ROWSS);
    bf16* E = (bf16*)(ws + WS_E);
    const int gw = vcu * NWAVES + wave, NGW = G * NWAVES;
    for (int m2 = gw; m2 < MT * NREP(1); m2 += NGW) { const int m = m2 >= MT ? m2 - MT : m2;
        const float* src = m < ML ? a.in[I_X] + (size_t)m * D : a.in[I_CTX] + (size_t)(m - ML) * D;
        const float* g = gs + (size_t)(m < ML ? (m >> 12) : 2) * D;
        const GAS f32x4* xr = (const GAS f32x4*)src + lane;
        GAS v2u* o8 = (GAS v2u*)(E + (size_t)m * D) + lane;
        float s = 0.f;
        f32x4 xv[16], gv[16];
#pragma unroll
        for (int j = 0; j < 16; ++j) xv[j] = xr[64 * j];
#pragma unroll
        for (int j = 0; j < 16; ++j) gv[j] = *((const GAS f32x4*)g + lane + 64 * j);
        asm volatile("" ::: "memory");
#pragma unroll
        for (int j = 0; j < 16; ++j) { const f32x4 v = xv[j]; s += (v[0] * v[0] + v[1] * v[1]) + (v[2] * v[2] + v[3] * v[3]);
            const f32x4 y = v * gv[j];
            v2u w; w.x = pk2(y[0], y[1]); w.y = pk2(y[2], y[3]); o8[64 * j] = w; }
        s = wave_sum(s);
        if (lane == 0) rowss[m] = (pg8::facc_t)(s * pg8::RS_SCALE + 0.5f);
    }
}

DI int rg_rmap(int t) { return ((t >> 4) & 3) * 32 + ((t >> 2) & 3) * 8 + (t >> 6) * 4 + (t & 3); }
template <int PASS, int DIR>
DI void rg_dir(LAS unsigned char* lds, bf16x8 (&bwr)[16], bf16x8 (&bwi)[16], const GAS bf16x8* wpn, const float gbr2, const float gbi2, const float kk2,
               const unsigned abase, const unsigned ubase, GAS unsigned* coef, float& S2, float& h, const bool plain) {
    f32x16 nr, ni;
#pragma unroll
    for (int i = 0; i < 16; ++i) { nr[i] = 0.f; ni[i] = 0.f; }
    { const LAS unsigned char* at = lds + (DIR == 0 ? 0 : 3) * 16384;
#pragma unroll
      for (int ks = 0; ks < 16; ++ks) { const bf16x8 av = *(const LAS bf16x8*)(at + (abase ^ ((unsigned)ks << 5)));
          nr = __builtin_amdgcn_mfma_f32_32x32x16_bf16(av, bwr[ks], nr, 0, 0, 0); ni = __builtin_amdgcn_mfma_f32_32x32x16_bf16(av, bwi[ks], ni, 0, 0, 0); } }
#pragma unroll
    for (int ti = 0; ti < 4; ++ti) {
        const int mt = DIR == 0 ? ti : 3 - ti, mtn = DIR == 0 ? ti + 1 : 2 - ti;
        const f32x16 zr = nr, zi = ni;
        if (ti < 3) {
#pragma unroll
            for (int i = 0; i < 16; ++i) { nr[i] = 0.f; ni[i] = 0.f; } }
        else if (wpn) {
#pragma unroll
            for (int ks = 0; ks < 16; ++ks) { bwr[ks] = wpn[ks * 64]; bwi[ks] = wpn[(16 + ks) * 64]; } }

        const LAS unsigned char* at = lds + mt * 16384; const LAS unsigned char* atn = lds + mtn * 16384;
        v4u cpk;
        bf16x8 avn = *(const LAS bf16x8*)((ti < 3 ? atn : at) + abase);
        unsigned short upn = *(const LAS unsigned short*)(at + (ubase ^ ((unsigned)((((DIR == 0 ? 0 : 15) >> 2) & 1) * 8 + ((DIR == 0 ? 0 : 15) & 3)) << 4)) + ((DIR == 0 ? 0 : 15) >> 2) * 4096 + ((DIR == 0 ? 0 : 15) & 3) * 512);
#pragma unroll
        for (int rr = 0; rr < 16; ++rr) {
            const bf16x8 av = avn; const unsigned short upc = upn;
            if (rr < 15) { if (ti < 3) avn = *(const LAS bf16x8*)(atn + (abase ^ ((unsigned)(rr + 1) << 5)));
                const int r1 = DIR == 0 ? rr + 1 : 14 - rr; const unsigned cr1 = (unsigned)(((r1 >> 2) & 1) * 8 + (r1 & 3));
                upn = *(const LAS unsigned short*)(at + (ubase ^ (cr1 << 4)) + (r1 >> 2) * 4096 + (r1 & 3) * 512); }
            if (ti < 3) { nr = __builtin_amdgcn_mfma_f32_32x32x16_bf16(av, bwr[rr], nr, 0, 0, 0); ni = __builtin_amdgcn_mfma_f32_32x32x16_bf16(av, bwi[rr], ni, 0, 0, 0); }

            const int r = DIR == 0 ? rr : 15 - rr;
            const float up = __uint_as_float((unsigned)upc << 16);
            const float rg = fast_rcp(1.0f + fast_exp2(__builtin_fmaf(zr[r], -LOG2E, gbr2)));
            const float ig = fast_rcp(1.0f + fast_exp2(__builtin_fmaf(zi[r], -LOG2E, gbi2)));
            const float la2 = kk2 * rg, av_ = fast_exp2(la2);
            const float em = __builtin_fmaf(-av_, av_, 1.0f);
            const float bv = __builtin_amdgcn_sqrtf(em) * (ig * up);
            h = __builtin_fmaf(av_, h, bv);
            S2 += la2; cpk[r & 3] = pk2(la2, bv);
            if ((rr & 3) == 3) { if (plain) *((GAS v4u*)coef + (size_t)(mt * 4 + (r >> 2)) * 512) = cpk; else __builtin_nontemporal_store(cpk, (GAS v4u*)coef + (size_t)(mt * 4 + (r >> 2)) * 512); }
#ifndef RG_SB_EVERY
#define RG_SB_EVERY 16
#endif
#ifndef P1_PLAIN_LAST
#define P1_PLAIN_LAST 1
#endif
#ifndef RG_SGB
#define RG_SGB 0
#endif
#if RG_SGB
#ifndef RG_SGP
#define RG_SGP 1
#endif
            if (ti < 3) {
                if (RG_SGP == 1) { __builtin_amdgcn_sched_group_barrier(0x8, 1, 0); __builtin_amdgcn_sched_group_barrier(0x402, RG_SGB, 0);
                                   __builtin_amdgcn_sched_group_barrier(0x8, 1, 0); __builtin_amdgcn_sched_group_barrier(0x402, RG_SGB, 0); __builtin_amdgcn_sched_group_barrier(0x100, 2, 0); }
                if (RG_SGP == 2) { __builtin_amdgcn_sched_group_barrier(0x100, 2, 0); __builtin_amdgcn_sched_group_barrier(0x8, 1, 0); __builtin_amdgcn_sched_group_barrier(0x402, RG_SGB, 0);
                                   __builtin_amdgcn_sched_group_barrier(0x8, 1, 0); __builtin_amdgcn_sched_group_barrier(0x402, RG_SGB, 0); }
                if (RG_SGP == 3) { __builtin_amdgcn_sched_group_barrier(0x8, 2, 0); __builtin_amdgcn_sched_group_barrier(0x402, 2 * RG_SGB, 0); __builtin_amdgcn_sched_group_barrier(0x100, 2, 0); }
                if (RG_SGP == 4) { __builtin_amdgcn_sched_group_barrier(0x8, 1, 0); __builtin_amdgcn_sched_group_barrier(0x402, 6, 0); __builtin_amdgcn_sched_group_barrier(0x100, 1, 0);
                                   __builtin_amdgcn_sched_group_barrier(0x8, 1, 0); __builtin_amdgcn_sched_group_barrier(0x402, 6, 0); __builtin_amdgcn_sched_group_barrier(0x100, 1, 0);
                                   __builtin_amdgcn_sched_group_barrier(0x402, 6, 0); }
            }
#endif
            if ((rr % RG_SB_EVERY) == RG_SB_EVERY - 1) __builtin_amdgcn_sched_barrier(0);
        }
    }
}
#ifndef STAMP_SEL
#define STAMP_SEL 0
#endif
#ifndef STAMP_WG
#define STAMP_WG 0
#endif
#ifndef STAMP_WAVE
#define STAMP_WAVE 0
#endif
#if STAMP_SEL
#define STAMP_T(v) const unsigned long long v = __builtin_amdgcn_s_memtime()
#define STAMP_ACC(k, a, b) do { if (STAMP_SEL == (k) && tid == STAMP_WAVE * 64) *(volatile LAS unsigned*)(lds + MISC_OFF + 80) += (unsigned)((b) - (a)); } while (0)
#else
#define STAMP_T(v) do {} while (0)
#define STAMP_ACC(k, a, b) do {} while (0)
#endif
template <int PASS>
DI void rg_unit(LAS unsigned char* lds, int unit, int lj, const bf16* U, const bf16* Gb, bf16* HS, const float* conv_w, const float* conv_b, const v4u* wgt, const float* gate_b, const float* lam,
                float* agg, const float* carry, unsigned* coefb, int tid, int wave, int lane, const bool plain_st) {
    asm volatile("" : "+v"(tid), "+v"(lane));
    const int nb = unit / 68, gc = unit - nb * 68, m0 = gc * 128;
    const bool has_left = gc < 64 ? ((gc & 31) != 0) : ((gc & 1) != 0);
    const bool has_right = gc < 64 ? ((gc & 31) != 31) : ((gc & 1) != 1);
#ifndef RG_BWI_EARLY
#define RG_BWI_EARLY 1
#endif
    unsigned lo_ = (unsigned)lane; asm volatile("" : "+v"(lo_));
    const GAS bf16x8* wp0 = (const GAS bf16x8*)wgt + ((((size_t)(lj * 16 + nb) * 2 + 0) * 8 + wave) * 2) * (16 * 64) + lo_;
    const GAS bf16x8* wp1 = wp0 + (size_t)8 * 2 * 16 * 64;
    bf16x8 bwr[16], bwi[16];
#ifndef RG_BWR_PRE
#define RG_BWR_PRE 0
#endif
#pragma unroll
    for (int ks = 0; ks < RG_BWR_PRE; ++ks) bwr[ks] = wp0[ks * 64];
    asm volatile("" ::: "memory");
    STAMP_T(st0);
#ifndef RGP
#define RGP 0
#endif
#if RGP == 1
    int nrepA = 2; asm volatile("" : "+s"(nrepA));
#pragma unroll 1
    for (int repA = 0; repA < nrepA; ++repA)
#endif
    {
        asm volatile("" ::: "memory");
        const int cg = tid & 31, run = tid >> 5, ch0 = nb * 256 + cg * 8;
        float xin[11][8];
#pragma unroll
        for (int rr = 0; rr < 11; ++rr) { const int lr = run * 8 - 2 + rr; const bool valid = (lr >= 0 || has_left) && (lr < 128 || has_right);
            v4u raw = (v4u){0u, 0u, 0u, 0u}; if (valid) raw = *(const GAS v4u*)(U + (size_t)(m0 + lr) * D + ch0);
            xin[rr][0] = bflo(raw.x); xin[rr][1] = bfhi(raw.x); xin[rr][2] = bflo(raw.y); xin[rr][3] = bfhi(raw.y); xin[rr][4] = bflo(raw.z); xin[rr][5] = bfhi(raw.z); xin[rr][6] = bflo(raw.w); xin[rr][7] = bfhi(raw.w); }
        float cw[4][8], cb[8];
#pragma unroll
        for (int k = 0; k < 4; ++k) { const f32x4 w0 = *(const GAS f32x4*)(conv_w + ((size_t)lj * 4 + k) * D + ch0), w1 = *(const GAS f32x4*)(conv_w + ((size_t)lj * 4 + k) * D + ch0 + 4);
#pragma unroll
            for (int e = 0; e < 4; ++e) { cw[k][e] = w0[e]; cw[k][4 + e] = w1[e]; } }
        { const f32x4 b0 = *(const GAS f32x4*)(conv_b + (size_t)lj * D + ch0), b1 = *(const GAS f32x4*)(conv_b + (size_t)lj * D + ch0 + 4);
#pragma unroll
          for (int e = 0; e < 4; ++e) { cb[e] = b0[e]; cb[4 + e] = b1[e]; } }
#pragma unroll
        for (int ks = RG_BWR_PRE; ks < 16; ++ks) bwr[ks] = wp0[ks * 64];
#pragma unroll
        for (int tt = 0; tt < 8; ++tt) { float o[8];
#pragma unroll
            for (int e = 0; e < 8; ++e) { float sacc = cb[e];
#pragma unroll
                for (int k = 0; k < 4; ++k) sacc += cw[k][e] * xin[tt + k][e];
                o[e] = sacc; }
            v4u w; w.x = pk2(o[0], o[1]); w.y = pk2(o[2], o[3]); w.z = pk2(o[4], o[5]); w.w = pk2(o[6], o[7]);
            const int R = rg_rmap(run * 8 + tt);
            *(LAS v4u*)(lds + R * 512 + ((cg ^ (R & 15)) << 4)) = w;
#if RG_BWI_EARLY
            if (tt == 3) { asm volatile("" ::: "memory");
#pragma unroll
                for (int ks = 0; ks < 8; ++ks) bwi[ks] = wp0[(16 + ks) * 64]; asm volatile("" ::: "memory"); }
            if (tt == 6) { asm volatile("" ::: "memory");
#pragma unroll
                for (int ks = 8; ks < 16; ++ks) bwi[ks] = wp0[(16 + ks) * 64]; asm volatile("" ::: "memory"); }
#endif
        }
    }
    STAMP_T(st1); STAMP_ACC(1, st0, st1);
    asm volatile("" ::: "memory");
#if !RG_BWI_EARLY
#pragma unroll
    for (int ks = 0; ks < 16; ++ks) bwi[ks] = wp0[(16 + ks) * 64];
#endif
#if RGP == 2
    asm volatile("s_waitcnt vmcnt(0)" ::: "memory");
#pragma unroll
    for (int ks = 0; ks < 16; ++ks) { asm volatile("" : "+v"(bwr[ks]), "+v"(bwi[ks])); }
    { const GAS bf16x8* wq = wp0; asm volatile("" : "+v"(wq));
#pragma unroll
    for (int ks = 0; ks < 16; ++ks) { bwr[ks] = wq[ks * 64]; bwi[ks] = wq[(16 + ks) * 64]; } }
#endif
    LDS_WAIT(); __syncthreads();
    STAMP_T(st2); STAMP_ACC(2, st1, st2);
#if STAMP_SEL == 6
    asm volatile("s_waitcnt vmcnt(0)" ::: "memory");
    STAMP_T(st2b); STAMP_ACC(6, st2, st2b);
#endif
#if RG_SETPRIO
    if (wave < 4) __builtin_amdgcn_s_setprio(1);
#endif
    const unsigned c_ = lo_ & 31u, hh_ = lo_ >> 5, chl_ = (unsigned)wave * 32u + c_;
    const int ch = nb * 256 + (int)chl_, sc = gc * 2 + (int)hh_;
    const unsigned abase = c_ * 512u + ((hh_ ^ (c_ & 15u)) << 4);
    const unsigned ubase = hh_ * 2048u + ((((chl_ >> 3) ^ (hh_ << 2))) << 4) + (chl_ & 7u) * 2u;
    LAS unsigned short* hst = (LAS unsigned short*)(lds + 65536) + chl_ + hh_ * (64 * 256);
    {
        const float gbr2 = -LOG2E * gate_b[((size_t)(lj * 2 + 0) * 2 + 0) * D + ch], gbi2 = -LOG2E * gate_b[((size_t)(lj * 2 + 0) * 2 + 1) * D + ch];
        const float kk2 = -8.0f * LOG2E * log1pf(__expf(-lam[(size_t)(lj * 2 + 0) * D + ch]));
        float S2 = 0.f, h = PASS == 2 ? carry[(size_t)(sc * 2 + 0) * D + ch] : 0.f;
        rg_dir<PASS, 0>(lds, bwr, bwi, wp1, gbr2, gbi2, kk2, abase, ubase, (GAS unsigned*)coefb + ((size_t)unit * 2 + 0) * 64 * 512 + (wave * 64 + lo_) * 4, S2, h, plain_st);
        if (PASS == 1) { float* ap = agg + ((size_t)(sc * 2 + 0) * 2) * D + ch; ap[0] = fast_exp2(S2); ap[D] = h; }
    }
    __builtin_amdgcn_sched_barrier(0);
    STAMP_T(st3); STAMP_ACC(3, st2, st3);
    {
        const float gbr2 = -LOG2E * gate_b[((size_t)(lj * 2 + 1) * 2 + 0) * D + ch], gbi2 = -LOG2E * gate_b[((size_t)(lj * 2 + 1) * 2 + 1) * D + ch];
        const float kk2 = -8.0f * LOG2E * log1pf(__expf(-lam[(size_t)(lj * 2 + 1) * D + ch]));
        float S2 = 0.f, h = PASS == 2 ? carry[(size_t)(sc * 2 + 1) * D + ch] : 0.f;
        rg_dir<PASS, 1>(lds, bwr, bwi, (const GAS bf16x8*)nullptr, gbr2, gbi2, kk2, abase, ubase, (GAS unsigned*)coefb + ((size_t)unit * 2 + 1) * 64 * 512 + (wave * 64 + lo_) * 4, S2, h, plain_st);
        if (PASS == 1) { float* ap = agg + ((size_t)(sc * 2 + 1) * 2) * D + ch; ap[0] = fast_exp2(S2); ap[D] = h; }
    }
    __builtin_amdgcn_s_setprio(0);
    STAMP_T(st4); STAMP_ACC(4, st3, st4);
    if (PASS == 2) {
        LDS_WAIT(); __syncthreads();
        int tid2 = tid; asm volatile("" : "+v"(tid2));
        const int cg = tid2 & 31, run = tid2 >> 5, ch0 = nb * 256 + cg * 8;
#pragma unroll
        for (int tt = 0; tt < 8; ++tt) { const int t = run * 8 + tt;
            const v4u hv = *(const LAS v4u*)(lds + 65536 + t * 512 + cg * 16); const v4u gv = *(const GAS v4u*)(Gb + (size_t)(m0 + t) * D + ch0);
            v4u o; o.x = pk2(bflo(hv.x) * bflo(gv.x), bfhi(hv.x) * bfhi(gv.x)); o.y = pk2(bflo(hv.y) * bflo(gv.y), bfhi(hv.y) * bfhi(gv.y));
            o.z = pk2(bflo(hv.z) * bflo(gv.z), bfhi(hv.z) * bfhi(gv.z)); o.w = pk2(bflo(hv.w) * bflo(gv.w), bfhi(hv.w) * bfhi(gv.w));
            *(GAS v4u*)(HS + (size_t)(m0 + t) * D + ch0) = o; }
    }
    LDS_WAIT(); __syncthreads();
    STAMP_T(st5); STAMP_ACC(5, st4, st5); STAMP_ACC(9, st0, st5);
}
DI void rg_unit2(int unit, const bf16* __restrict__ Gb, bf16* __restrict__ HS, const float* __restrict__ carry, const unsigned* __restrict__ coefb, int wave, int lane) {
    asm volatile("" : "+v"(lane));
    const int nb = unit / 68, gc = unit - nb * 68;
    const int hh = wave >> 2, chl = (wave & 3) * 64 + lane, ch = nb * 256 + chl, sc = gc * 2 + hh;
    const GAS v4u* cf = (const GAS v4u*)coefb + (size_t)unit * 2 * 16 * 512 + (chl >> 5) * 64 + hh * 32 + (chl & 31);
    const size_t row0 = (size_t)(gc * 128 + hh * 64) * D + ch;
    float hf[64];
    const GAS v4u* cb = cf + (size_t)16 * 512;
    unsigned wa[16], wb[16]; unsigned short ga[16], gb[16];
#define P2_LOADF(WV, t0) do { _Pragma("unroll") for (int j = 0; j < 4; ++j) { const v4u _q = __builtin_nontemporal_load(cf + (size_t)((t0) / 4 + j) * 512); WV[4 * j] = _q[0]; WV[4 * j + 1] = _q[1]; WV[4 * j + 2] = _q[2]; WV[4 * j + 3] = _q[3]; } } while (0)
#define P2_LOADB(WV, gq, t0) do { _Pragma("unroll") for (int j = 0; j < 4; ++j) { const v4u _q = __builtin_nontemporal_load(cb + (size_t)((t0) / 4 + j) * 512); WV[4 * j] = _q[0]; WV[4 * j + 1] = _q[1]; WV[4 * j + 2] = _q[2]; WV[4 * j + 3] = _q[3]; } \
        _Pragma("unroll") for (int j = 0; j < 16; ++j) gq[j] = *(const GAS unsigned short*)(Gb + row0 + (size_t)((t0) + j) * D); } while (0)
#define P2_FWD(w, t0) do { _Pragma("unroll") for (int j = 0; j < 16; ++j) { h = __builtin_fmaf(fast_exp2(bflo(w[j])), h, bfhi(w[j])); hf[(t0) + j] = h; } } while (0)
#define P2_BWD(w, gq, t0) do { _Pragma("unroll") for (int j = 15; j >= 0; --j) { h = __builtin_fmaf(fast_exp2(bflo(w[j])), h, bfhi(w[j])); \
        *(GAS unsigned short*)(HS + row0 + (size_t)((t0) + j) * D) = (unsigned short)(pk2((hf[(t0) + j] + h) * __uint_as_float((unsigned)gq[j] << 16), 0.f) & 0xffffu); } } while (0)
    float h = carry[(size_t)(sc * 2 + 0) * D + ch]; const float hb0 = carry[(size_t)(sc * 2 + 1) * D + ch];
    P2_LOADF(wa, 0); P2_LOADF(wb, 16); P2_FWD(wa, 0); P2_LOADF(wa, 32); P2_FWD(wb, 16); P2_LOADF(wb, 48); P2_FWD(wa, 32); P2_LOADB(wa, ga, 48); P2_FWD(wb, 48);
    h = hb0;
    P2_LOADB(wb, gb, 32); asm volatile("" ::: "memory"); P2_BWD(wa, ga, 48); P2_LOADB(wa, ga, 16); asm volatile("" ::: "memory"); P2_BWD(wb, gb, 32);
    P2_LOADB(wb, gb, 0); asm volatile("" ::: "memory"); P2_BWD(wa, ga, 16); asm volatile("" ::: "memory"); P2_BWD(wb, gb, 0);
#undef P2_LOADF
#undef P2_LOADB
#undef P2_FWD
#undef P2_BWD
}
DI void rg_carry(LAS unsigned char* lds, int item, const float* agg, float* carry, int tid, int wave, int lane) {
    asm volatile("" : "+v"(tid), "+v"(lane));
    const int b = item >> 7, d = (item >> 6) & 1, ch = (item & 63) * 64 + lane;
    float A[9], H[9]; int scs[9];
#pragma unroll
    for (int e9 = 0; e9 < 9; ++e9) { const int e0 = wave * 9 + e9; const bool valid = e0 < 68; const int e = valid ? e0 : 67;
        const int sq = d == 0 ? (e < 4 ? 128 + b * 4 + e : b * 64 + (e - 4)) : (e < 4 ? 128 + b * 4 + 3 - e : b * 64 + 63 - (e - 4));
        scs[e9] = valid ? sq : -1;
        const GAS float* ap = (const GAS float*)agg + ((size_t)(sq * 2 + d) * 2) * D + ch; A[e9] = ap[0]; H[e9] = ap[D]; }
    asm volatile("" : "+v"(A[0]), "+v"(A[1]), "+v"(A[2]), "+v"(A[3]), "+v"(A[4]), "+v"(A[5]), "+v"(A[6]), "+v"(A[7]), "+v"(A[8]),
                      "+v"(H[0]), "+v"(H[1]), "+v"(H[2]), "+v"(H[3]), "+v"(H[4]), "+v"(H[5]), "+v"(H[6]), "+v"(H[7]), "+v"(H[8]));
#pragma unroll
    for (int e9 = 0; e9 < 9; ++e9) if (scs[e9] < 0) { A[e9] = 1.f; H[e9] = 0.f; }
    float Ac = 1.f, Hc = 0.f;
#pragma unroll
    for (int e9 = 0; e9 < 9; ++e9) { Hc = A[e9] * Hc + H[e9]; Ac *= A[e9]; }
    LAS float* comp = (LAS float*)lds;
    comp[(wave * 64 + lane) * 2 + 0] = Ac; comp[(wave * 64 + lane) * 2 + 1] = Hc;
    LDS_WAIT(); __syncthreads();
    float h = 0.f;
    for (int w2 = 0; w2 < wave; ++w2) h = comp[(w2 * 64 + lane) * 2 + 0] * h + comp[(w2 * 64 + lane) * 2 + 1];
#pragma unroll
    for (int e9 = 0; e9 < 9; ++e9) { if (scs[e9] >= 0) carry[(size_t)(scs[e9] * 2 + d) * D + ch] = h; h = A[e9] * h + H[e9]; }
    LDS_WAIT(); __syncthreads();
}

DI unsigned off_b(unsigned row, unsigned ch) { return 256u * row + 16u * (ch ^ (((row & 3u) << 2) | ((row >> 2) & 3u))); }
DI int clampi(int v, int lo, int hi) { return v < lo ? lo : (v > hi ? hi : v); }
constexpr int VT_DT = 3104, VT_KG = 384, TILE_BUF = 8 * VT_DT;
DI unsigned off_v(unsigned row, unsigned ch) { return (ch >> 1) * VT_DT + (row >> 3) * VT_KG + (row & 7u) * 32u + (ch & 1u) * 16u; }
#define TRS(n) "ds_read_b64_tr_b16 %" #n ", %16 offset:"
DI void tr_read16(s16x4 (&o)[16], unsigned a) {
    asm volatile(TRS(0) "0\n\t" TRS(1) "128\n\t" TRS(2) "3104\n\t" TRS(3) "3232\n\t" TRS(4) "6208\n\t" TRS(5) "6336\n\t" TRS(6) "9312\n\t" TRS(7) "9440\n\t"
                 TRS(8) "12416\n\t" TRS(9) "12544\n\t" TRS(10) "15520\n\t" TRS(11) "15648\n\t" TRS(12) "18624\n\t" TRS(13) "18752\n\t" TRS(14) "21728\n\t" TRS(15) "21856\n\t"
                 "s_waitcnt lgkmcnt(0)"
                 : "=&v"(o[0]), "=&v"(o[1]), "=&v"(o[2]), "=&v"(o[3]), "=&v"(o[4]), "=&v"(o[5]), "=&v"(o[6]), "=&v"(o[7]),
                   "=&v"(o[8]), "=&v"(o[9]), "=&v"(o[10]), "=&v"(o[11]), "=&v"(o[12]), "=&v"(o[13]), "=&v"(o[14]), "=&v"(o[15])
                 : "v"(a) : "memory");
}
DI void tr_issue16(s16x4 (&o)[16], unsigned a) {
    asm volatile(TRS(0) "0\n\t" TRS(1) "128\n\t" TRS(2) "3104\n\t" TRS(3) "3232\n\t" TRS(4) "6208\n\t" TRS(5) "6336\n\t" TRS(6) "9312\n\t" TRS(7) "9440\n\t"
                 TRS(8) "12416\n\t" TRS(9) "12544\n\t" TRS(10) "15520\n\t" TRS(11) "15648\n\t" TRS(12) "18624\n\t" TRS(13) "18752\n\t" TRS(14) "21728\n\t" TRS(15) "21856"
                 : "=&v"(o[0]), "=&v"(o[1]), "=&v"(o[2]), "=&v"(o[3]), "=&v"(o[4]), "=&v"(o[5]), "=&v"(o[6]), "=&v"(o[7]),
                   "=&v"(o[8]), "=&v"(o[9]), "=&v"(o[10]), "=&v"(o[11]), "=&v"(o[12]), "=&v"(o[13]), "=&v"(o[14]), "=&v"(o[15])
                 : "v"(a) : "memory");
}
#undef TRS
DI void lds_read8(bf16x8 (&o)[8], unsigned a0, unsigned a1, unsigned a2, unsigned a3, unsigned a4, unsigned a5, unsigned a6, unsigned a7) {
    asm volatile("ds_read_b128 %0, %8\n\tds_read_b128 %1, %9\n\tds_read_b128 %2, %10\n\tds_read_b128 %3, %11\n\tds_read_b128 %4, %12\n\tds_read_b128 %5, %13\n\tds_read_b128 %6, %14\n\tds_read_b128 %7, %15\n\ts_waitcnt lgkmcnt(0)"
                 : "=&v"(o[0]), "=&v"(o[1]), "=&v"(o[2]), "=&v"(o[3]), "=&v"(o[4]), "=&v"(o[5]), "=&v"(o[6]), "=&v"(o[7])
                 : "v"(a0), "v"(a1), "v"(a2), "v"(a3), "v"(a4), "v"(a5), "v"(a6), "v"(a7) : "memory");
}
constexpr int ATT_BUF = 16384 + TILE_BUF;
constexpr float ATT_THR = 10.0f;
#ifndef ATT_PROBE
#define ATT_PROBE 0
#endif
DI void lds_bias16(float (&o0)[8], float (&o1)[8], unsigned a0, unsigned a1, unsigned a2, unsigned a3, unsigned a4, unsigned a5, unsigned a6, unsigned a7) {
    asm volatile("ds_read_b32 %0, %16 offset:128\n\tds_read_b32 %1, %17 offset:128\n\tds_read_b32 %2, %18 offset:128\n\tds_read_b32 %3, %19 offset:128\n\t"
                 "ds_read_b32 %4, %20 offset:128\n\tds_read_b32 %5, %21 offset:128\n\tds_read_b32 %6, %22 offset:128\n\tds_read_b32 %7, %23 offset:128\n\t"
                 "ds_read_b32 %8, %16\n\tds_read_b32 %9, %17\n\tds_read_b32 %10, %18\n\tds_read_b32 %11, %19\n\t"
                 "ds_read_b32 %12, %20\n\tds_read_b32 %13, %21\n\tds_read_b32 %14, %22\n\tds_read_b32 %15, %23\n\ts_waitcnt lgkmcnt(0)"
                 : "=&v"(o0[0]), "=&v"(o0[1]), "=&v"(o0[2]), "=&v"(o0[3]), "=&v"(o0[4]), "=&v"(o0[5]), "=&v"(o0[6]), "=&v"(o0[7]),
                   "=&v"(o1[0]), "=&v"(o1[1]), "=&v"(o1[2]), "=&v"(o1[3]), "=&v"(o1[4]), "=&v"(o1[5]), "=&v"(o1[6]), "=&v"(o1[7])
                 : "v"(a0), "v"(a1), "v"(a2), "v"(a3), "v"(a4), "v"(a5), "v"(a6), "v"(a7) : "memory");
}
template <bool MASKED>
DI void att_softmax(f32x4 (&S)[2], const float (&bv)[8], const float (&madd)[2][4], const bool rowok, float& m, float& l, f32x4 (&O)[8], v4u& P) {
    float v[2][4]; float lm = -__builtin_inff();
#pragma unroll
    for (int t = 0; t < 2; ++t)
#pragma unroll
        for (int r = 0; r < 4; ++r) { v[t][r] = MASKED ? __builtin_fmaf(S[t][r], ATTN_C1, rowok ? bv[t * 4 + r] + madd[t][r] : -__builtin_inff()) : S[t][r] * ATTN_C1; lm = fmaxf(lm, v[t][r]); }
    if (__any(lm > m + ATT_THR)) {
        const float mx = pg8::xrow16_max(lm);
        const float mn = fmaxf(m, mx), alpha = fast_exp2(m - mn);
#pragma unroll
        for (int dt = 0; dt < 8; ++dt) O[dt] = O[dt] * alpha;
        l *= alpha; m = mn;
    }
    float p[2][4];
#pragma unroll
    for (int t = 0; t < 2; ++t)
#pragma unroll
        for (int r = 0; r < 4; ++r) { p[t][r] = fast_exp2(v[t][r] - m); l += p[t][r]; }
    P.x = pk2(p[0][0], p[0][1]); P.y = pk2(p[0][2], p[0][3]); P.z = pk2(p[1][0], p[1][1]); P.w = pk2(p[1][2], p[1][3]);
}
#ifndef ATT_PRIO
#define ATT_PRIO 1
#endif
#define ATT_PRIO_UP() do { if (ATT_PRIO) __builtin_amdgcn_s_setprio(1); } while (0)
#define ATT_PRIO_DN() do { if (ATT_PRIO) __builtin_amdgcn_s_setprio(0); } while (0)
DI void attn_unit(LAS unsigned char* lds, int unit, const bf16* Qb, const bf16* Kb, const bf16* Vb, const bf16* Gb, bf16* Ob, const float* rpb, int tid, int wave, int lane) {
    asm volatile("" : "+v"(tid), "+v"(lane));
    const bool lat = unit < 1024;
    int b, hd, R0 = 0;
    if (lat) { b = unit >> 9; hd = (unit >> 4) & 31; R0 = (unit & 15) * 4; } else { const int u2 = unit - 1024; b = u2 >> 5; hd = u2 & 31; }
    const int n = wave & 3, rp = wave >> 2, ql = lane & 15, g = lane >> 4;
    const int rw0 = R0 + 2 * rp;
    int qtok[2];
#pragma unroll
    for (int j = 0; j < 2; ++j) qtok[j] = lat ? b * SEQ + (rw0 + j) * 64 + n * 16 + ql : ML + b * CTXL + (2 * rp + j) * 64 + n * 16 + ql;
    const int rs0 = clampi(R0 - 4, 0, 56);
    const int rot = (11 - rs0 % 11) % 11;
    const int bs = n == 0 ? 0 : (n == 1 ? 8 : (n == 2 ? 24 : 32));
    const int qc = n * 16 + ql, qcs = clampi(qc - 8, 0, 48);
    LAS unsigned char* rpbL = lds + 2 * ATT_BUF;
    bf16x8 qf[2][4];
#pragma unroll
    for (int j = 0; j < 2; ++j)
#pragma unroll
        for (int ks = 0; ks < 4; ++ks) qf[j][ks] = *(const GAS bf16x8*)(Qb + (size_t)qtok[j] * D + hd * HDIM + ks * 32 + 8 * g);
    if (lat) for (int i = tid; i < 15 * 31; i += NWAVES * 64) { const int r1 = i / 31, c1 = i - r1 * 31; ((LAS float*)rpbL)[r1 * 32 + c1] = rpb[((size_t)hd * 15 + r1) * 31 + c1] * LOG2E; }
    float madd[2][4]; unsigned bptr[2][4];
#pragma unroll
    for (int t = 0; t < 2; ++t)
#pragma unroll
        for (int r = 0; r < 4; ++r) { const int kc = bs + 8 * g + 4 * t + r; madd[t][r] = (kc >= qcs && kc < qcs + 16) ? 0.f : -__builtin_inff();
            bptr[t][r] = (unsigned)(size_t)rpbL + (unsigned)(((rs0 - rw0 + 7) * 32 + clampi(kc - qc + 15, 0, 30)) * 4); }
    const int crow = tid >> 4, cch = tid & 15;
    const unsigned stK0 = off_b(crow, cch), stK1 = off_b(crow + 32, cch), stV0 = 16384u + off_v(crow, cch), stV1 = 16384u + off_v(crow + 32, cch);
#define TILE_LOAD(st, p) do { const int _s = (st); size_t _t0; if (_s < 11) { int _l = _s + rot; _l = _l >= 11 ? _l - 11 : _l; const int _kr = (rs0 + _l) > 63 ? 63 : (rs0 + _l); _t0 = ((size_t)(b * NHEAD + hd) * SEQ + _kr * 64) * HDIM; } else _t0 = pg8::HM_CTX + ((size_t)(b * NHEAD + hd) * CTXL + (_s - 11) * 64) * HDIM; \
        const size_t _o0 = _t0 + (size_t)tid * 8, _o1 = _o0 + (size_t)32 * HDIM;     \
        p[0] = *(const GAS v4u*)(Kb + _o0); p[1] = *(const GAS v4u*)(Kb + _o1); p[2] = *(const GAS v4u*)(Vb + _o0); p[3] = *(const GAS v4u*)(Vb + _o1); } while (0)
#define TILE_STORE(st, p) do { LAS unsigned char* _b = lds + ((st) & 1) * ATT_BUF; *(LAS v4u*)(_b + stK0) = p[0]; *(LAS v4u*)(_b + stK1) = p[1]; *(LAS v4u*)(_b + stV0) = p[2]; *(LAS v4u*)(_b + stV1) = p[3]; } while (0)
    v4u PF[4];
    if (lat) { TILE_LOAD(0, PF); TILE_STORE(0, PF); TILE_LOAD(1, PF); }
    else { TILE_LOAD(11, PF); TILE_STORE(11, PF); TILE_LOAD(12, PF); }
    f32x4 O[2][8];
#pragma unroll
    for (int j = 0; j < 2; ++j)
#pragma unroll
        for (int dt = 0; dt < 8; ++dt) O[j][dt] = (f32x4){0.f, 0.f, 0.f, 0.f};
    float mrun[2] = {-1e30f, -1e30f}, lrun[2] = {0.f, 0.f};
    unsigned kb_lat[2], kb_ctx[2][2];
#pragma unroll
    for (int t = 0; t < 2; ++t) { kb_lat[t] = off_b((unsigned)(bs + 8 * (ql >> 2) + 4 * t + (ql & 3)), (unsigned)g);
#pragma unroll
        for (int pp = 0; pp < 2; ++pp) kb_ctx[pp][t] = off_b((unsigned)(32 * pp + 8 * (ql >> 2) + 4 * t + (ql & 3)), (unsigned)g); }
    const unsigned ldsb = (unsigned)(size_t)lds;
    const unsigned vlane = 16384u + (unsigned)(g * VT_KG + (ql >> 2) * 32 + (lane & 3) * 8);
    if (lat) {
#pragma unroll
        for (int st = 0; st < 11; ++st) {
            LDS_WAIT(); __syncthreads();
            TILE_STORE(st + 1, PF); TILE_LOAD(st + 2, PF);
            int sts = st + rot; sts = sts >= 11 ? sts - 11 : sts;
            const int kr = rs0 + sts;
            const bool ok0 = kr >= clampi(rw0 - 4, 0, 56) && kr < clampi(rw0 - 4, 0, 56) + 8, ok1 = kr >= clampi(rw0 - 3, 0, 56) && kr < clampi(rw0 - 3, 0, 56) + 8;
            if (ok0 || ok1) {
                const unsigned kbuf = ldsb + (unsigned)(st & 1) * ATT_BUF;
                bf16x8 kf[8];
                lds_read8(kf, kbuf + kb_lat[0], kbuf + (kb_lat[0] ^ 64u), kbuf + (kb_lat[0] ^ 128u), kbuf + (kb_lat[0] ^ 192u), kbuf + kb_lat[1], kbuf + (kb_lat[1] ^ 64u), kbuf + (kb_lat[1] ^ 128u), kbuf + (kb_lat[1] ^ 192u));
                f32x4 S0[2], S1[2];
#if ATT_PROBE == 2
                for (int rep_ = 0; rep_ < 2; ++rep_) { asm volatile("" ::: "memory");
                lds_read8(kf, kbuf + kb_lat[0], kbuf + (kb_lat[0] ^ 64u), kbuf + (kb_lat[0] ^ 128u), kbuf + (kb_lat[0] ^ 192u), kbuf + kb_lat[1], kbuf + (kb_lat[1] ^ 64u), kbuf + (kb_lat[1] ^ 128u), kbuf + (kb_lat[1] ^ 192u));
#endif
                ATT_PRIO_UP();
#pragma unroll
                for (int t = 0; t < 2; ++t) { f32x4 a0 = (f32x4){0.f, 0.f, 0.f, 0.f}, a1 = (f32x4){0.f, 0.f, 0.f, 0.f};
#pragma unroll
                    for (int ks = 0; ks < 4; ++ks) { a0 = __builtin_amdgcn_mfma_f32_16x16x32_bf16(kf[t * 4 + ks], qf[0][ks], a0, 0, 0, 0); a1 = __builtin_amdgcn_mfma_f32_16x16x32_bf16(kf[t * 4 + ks], qf[1][ks], a1, 0, 0, 0); }
                    S0[t] = a0; S1[t] = a1; }
                ATT_PRIO_DN();
#if ATT_PROBE == 2
                asm volatile("" : "+v"(S0[0]), "+v"(S0[1]), "+v"(S1[0]), "+v"(S1[1])); }
#endif
                v4u P0, P1;
                s16x4 o[16];
                tr_issue16(o, ldsb + (unsigned)(st & 1) * ATT_BUF + vlane + (unsigned)(bs >> 3) * VT_KG);
                float bv0[8], bv1[8];
                { const unsigned bo = (unsigned)((sts - 1) * 128);
                  lds_bias16(bv0, bv1, bptr[0][0] + bo, bptr[0][1] + bo, bptr[0][2] + bo, bptr[0][3] + bo, bptr[1][0] + bo, bptr[1][1] + bo, bptr[1][2] + bo, bptr[1][3] + bo); }
                att_softmax<true>(S0, bv0, madd, ok0, mrun[0], lrun[0], O[0], P0);
                att_softmax<true>(S1, bv1, madd, ok1, mrun[1], lrun[1], O[1], P1);
                const bf16x8 p0 = __builtin_bit_cast(bf16x8, P0), p1 = __builtin_bit_cast(bf16x8, P1);
                ATT_PRIO_UP();
#pragma unroll
                for (int dt = 0; dt < 8; ++dt) { const bf16x8 vf = __builtin_shufflevector(o[2 * dt], o[2 * dt + 1], 0, 1, 2, 3, 4, 5, 6, 7);
                    O[0][dt] = __builtin_amdgcn_mfma_f32_16x16x32_bf16(vf, p0, O[0][dt], 0, 0, 0);
                    O[1][dt] = __builtin_amdgcn_mfma_f32_16x16x32_bf16(vf, p1, O[1][dt], 0, 0, 0); }
                ATT_PRIO_DN();
            }
        }
    }
#pragma unroll
    for (int st = 11; st < 15; ++st) {
        LDS_WAIT(); __syncthreads();
        if (st + 1 < 15) { TILE_STORE(st + 1, PF); if (st + 2 < 15) TILE_LOAD(st + 2, PF); }
        const unsigned kbuf = ldsb + (unsigned)(st & 1) * ATT_BUF;
#pragma unroll
        for (int pp = 0; pp < 2; ++pp) {
            bf16x8 kf[8];
            lds_read8(kf, kbuf + kb_ctx[pp][0], kbuf + (kb_ctx[pp][0] ^ 64u), kbuf + (kb_ctx[pp][0] ^ 128u), kbuf + (kb_ctx[pp][0] ^ 192u), kbuf + kb_ctx[pp][1], kbuf + (kb_ctx[pp][1] ^ 64u), kbuf + (kb_ctx[pp][1] ^ 128u), kbuf + (kb_ctx[pp][1] ^ 192u));
            f32x4 S0[2], S1[2];
            ATT_PRIO_UP();
#pragma unroll
            for (int t = 0; t < 2; ++t) { f32x4 a0 = (f32x4){0.f, 0.f, 0.f, 0.f}, a1 = (f32x4){0.f, 0.f, 0.f, 0.f};
#pragma unroll
                for (int ks = 0; ks < 4; ++ks) { a0 = __builtin_amdgcn_mfma_f32_16x16x32_bf16(kf[t * 4 + ks], qf[0][ks], a0, 0, 0, 0); a1 = __builtin_amdgcn_mfma_f32_16x16x32_bf16(kf[t * 4 + ks], qf[1][ks], a1, 0, 0, 0); }
                S0[t] = a0; S1[t] = a1; }
            ATT_PRIO_DN();
            v4u P0, P1;
            const float bvz[8] = {0.f, 0.f, 0.f, 0.f, 0.f, 0.f, 0.f, 0.f};
            att_softmax<false>(S0, bvz, madd, true, mrun[0], lrun[0], O[0], P0);
            att_softmax<false>(S1, bvz, madd, true, mrun[1], lrun[1], O[1], P1);
            s16x4 o[16];
            tr_read16(o, ldsb + (unsigned)(st & 1) * ATT_BUF + vlane + (unsigned)(4 * pp) * VT_KG);
            const bf16x8 p0 = __builtin_bit_cast(bf16x8, P0), p1 = __builtin_bit_cast(bf16x8, P1);
            ATT_PRIO_UP();
#pragma unroll
            for (int dt = 0; dt < 8; ++dt) { const bf16x8 vf = __builtin_shufflevector(o[2 * dt], o[2 * dt + 1], 0, 1, 2, 3, 4, 5, 6, 7);
                O[0][dt] = __builtin_amdgcn_mfma_f32_16x16x32_bf16(vf, p0, O[0][dt], 0, 0, 0);
                O[1][dt] = __builtin_amdgcn_mfma_f32_16x16x32_bf16(vf, p1, O[1][dt], 0, 0, 0); }
            ATT_PRIO_DN();
        }
    }
#undef TILE_LOAD
#undef TILE_STORE
    v4u gvs[2][4];
#pragma unroll
    for (int j = 0; j < 2; ++j)
#pragma unroll
        for (int dp = 0; dp < 4; ++dp) gvs[j][dp] = *(const GAS v4u*)(Gb + (size_t)qtok[j] * D + hd * HDIM + 16 * (g & 1) + 8 * (g >> 1) + dp * 32);
    asm volatile("" ::: "memory");
#pragma unroll
    for (int j = 0; j < 2; ++j) {
        const float l1 = pg8::xrow16_sum(lrun[j]);
        const float inv = fast_rcp(l1);
        const size_t rowoff = (size_t)qtok[j] * D + hd * HDIM + 16 * (g & 1) + 8 * (g >> 1);
#pragma unroll
        for (int dp = 0; dp < 4; ++dp) {
            float na[4], nb[4];
#pragma unroll
            for (int c = 0; c < 4; ++c) { const auto r = __builtin_amdgcn_permlane16_swap(__float_as_uint(O[j][2 * dp][c]), __float_as_uint(O[j][2 * dp + 1][c]), false, false);
                na[c] = __uint_as_float(r[0]); nb[c] = __uint_as_float(r[1]); }
            const size_t off = rowoff + dp * 32;
            const v4u gv = gvs[j][dp];
            v4u w; w.x = pk2(na[0] * inv * bflo(gv.x), na[1] * inv * bfhi(gv.x)); w.y = pk2(na[2] * inv * bflo(gv.y), na[3] * inv * bfhi(gv.y));
            w.z = pk2(nb[0] * inv * bflo(gv.z), nb[1] * inv * bfhi(gv.z)); w.w = pk2(nb[2] * inv * bflo(gv.w), nb[3] * inv * bfhi(gv.w));
            *(GAS v4u*)(Ob + off) = w; }
    }
    __syncthreads();
}

__global__ void __launch_bounds__(NWAVES * 64, 2) mega_fwd(Args args) {
    extern __shared__ __attribute__((aligned(16))) unsigned char lds_raw[];
    LAS unsigned char* lds = (LAS unsigned char*)lds_raw;
    volatile LAS unsigned* MISC = (volatile LAS unsigned*)(lds + MISC_OFF);
    const int tid = threadIdx.x, lane = tid & 63, wave = __builtin_amdgcn_readfirstlane(tid >> 6);
    constexpr int G = 256;
    const int bx = blockIdx.x; const int vcu = (bx % 8) * (G / 8) + bx / 8;
    unsigned char* ws = args.ws;
    if (tid < 32) MISC[tid] = 0u;
    __syncthreads();
    XcdBarrier bar; bar.bar = (unsigned*)(ws + WS_CTL) + CW_BAR; bar.x = 0; bar.st = nullptr;
    if (!MK_PER_PHASE) bar = xcd_barrier_post((unsigned*)(ws + WS_CTL) + CW_BAR, MISC + 8);
#if MK_PER_PHASE
    const int lo = args.ph_lo, hi = args.ph_hi;
#else
    constexpr int lo = 0, hi = NPHASE;
#endif
#ifndef SITE_MASK
#define SITE_MASK 0xffff
#endif
#define SITE(x) ((SITE_MASK >> (x)) & 1)
#define IN(k) (lo <= (k) && (k) < hi)
#define SEAM(k) do { if (IN(k) && IN((k) + 1)) xcd_barrier(bar); } while (0)
#define FRESH() int vcu_ = vcu; constexpr int G_ = G; asm volatile("" : "+s"(vcu_))

#define PTRS() unsigned char* ws_ = ws; asm volatile("" : "+s"(ws_)); bf16* Hb = (bf16*)(ws_ + WS_H); bf16* Ab = (bf16*)(ws_ + WS_A); bf16* Bb = (bf16*)(ws_ + WS_B); bf16* Cb = (bf16*)(ws_ + WS_C); bf16* Db = (bf16*)(ws_ + WS_D); \
    bf16* Eb = (bf16*)(ws_ + WS_E); const float* mod = (const float*)(ws_ + WS_MOD); const float* gsv = (const float*)(ws_ + WS_GS); \
    pg8::facc_t* rowss = (pg8::facc_t*)(ws_ + CTL_ROWSS); const pg8::facc_t* bias2 = (const pg8::facc_t*)(ws_ + CTL_BIAS2); \
    (void)Hb; (void)Ab; (void)Bb; (void)Cb; (void)Db; (void)Eb; (void)mod; (void)gsv; (void)rowss; (void)bias2

    if (SITE(0) && IN(0)) { FRESH(); bg_run(args, lds, tid, wave, lane, vcu_, G_, BgTasks{0, -1, -1, -1}); }
    SEAM(0);
    if (SITE(0) && IN(1)) { for (int rep = 0; rep < NREP(0); ++rep) { FRESH(); bg_run(args, lds, tid, wave, lane, vcu_, G_, BgTasks{-1, 0, 0, -1}); prescale_phase(args, wave, lane, vcu_, G_); } }
    SEAM(1);

    for (int lp = 0; lp < 2; ++lp) {
        const int pb = 2 + lp * 8;
        { const int layer = 2 * lp;
          if (SITE(2) && IN(pb + 0)) { PTRS();
              constexpr int Gg = gemm_wgs((MT / 256) * (8192 / 256), G);
              pg8::Gemm g{Eb, (const bf16*)(ws_ + WS_WLIN) + (size_t)lp * 8192 * D, MT, 8192, D}; pg8::StaticOrder S; S.init(MT, 8192, Gg, bx);
              pg8::EpiRgIn E{Ab, Bb, rowss + (size_t)layer * MT, bias2 + (size_t)layer * 3 * pg8::NB2};
              S.rep = NREP(2);
              if (bx < Gg) pg8::gemm_phase<pg8::EpiRgIn, pg8::StaticOrder, true, PG8_SP2V>(lds, g, S, E);
              BG_SPARE(Gg, BgTasks{2 * lp + 1, -1, 2 + lp, -1});
          }
          SEAM(pb + 0);
          constexpr int GS = 218; const int sw = (bx & 7) * (GS / 8) + ((bx & 7) < (GS & 7) ? (bx & 7) : (GS & 7)) + (bx >> 3);
          if (SITE(3) && IN(pb + 1)) { PTRS();
              { int sw_ = sw; asm volatile("" : "+s"(sw_));
              if (bx < GS) for (int u2 = sw_; u2 < 68 * 16 * NREP(3); u2 += GS) { const int u = (NREP(3) == 2 && u2 >= 68 * 16) ? u2 - 68 * 16 : u2;
                  rg_unit<1>(lds, u, lp, Ab, Bb, Hb, args.in[I_LCONVW], args.in[I_LCONVB], (const v4u*)(ws_ + WS_WGATE), args.in[I_LGATEB], args.in[I_LLAM], (float*)(ws_ + WS_AGG2), (const float*)(ws_ + WS_CARRY), (unsigned*)(ws_ + WS_COEF), tid, wave, lane, P1_PLAIN_LAST && u2 + GS >= 68 * 16 * NREP(3)); } }
              if (lp == 0) BG_SPARE(GS, BgTasks{2, -1, -1, -1, 0, 96});
          }
          SEAM(pb + 1);
          if (SITE(3) && IN(pb + 2)) { PTRS(); FRESH();
              for (int it = vcu_; it < 256; it += G_) rg_carry(lds, it, (const float*)(ws_ + WS_AGG2), (float*)(ws_ + WS_CARRY), tid, wave, lane);
          }
          SEAM(pb + 2);
          if (SITE(4) && IN(pb + 3)) { PTRS();
              for (int rep = 0; rep < NREP(4); ++rep) { int sw_ = sw; asm volatile("" : "+s"(sw_));
#ifndef P2_REV
#define P2_REV 1
#endif
              if (bx < GS) for (int u0 = sw_; u0 < 68 * 16; u0 += GS) { const int ul = (68 * 16 - 1 - sw_) / GS * GS + sw_;
                  const int u = P2_REV ? ul - (u0 - sw_) : u0;
                  rg_unit2(u, Bb, Hb, (const float*)(ws_ + WS_CARRY), (const unsigned*)(ws_ + WS_COEF), wave, lane); } }
          }
          SEAM(pb + 3);
          if (SITE(5) && IN(pb + 4)) { PTRS();
              constexpr int Gg = gemm_wgs((MT / 256) * (D / 256), G);
              pg8::Gemm g{Hb, (const bf16*)(ws_ + WS_WLOUT) + (size_t)lp * D * D, MT, D, D}; pg8::StaticOrder S; S.init(MT, D, Gg, bx);
              const float* rgsv = (const float*)(ws_ + WS_RGS) + (size_t)layer * 3 * D;
              if (layer == 0) {
                  pg8::EpiOut<false, true> E{args.in[I_X], args.in[I_CTX], nullptr, mod + (size_t)layer * 3 * (3 * D) + 2 * D, rgsv,
                            Eb, gsv + (size_t)(layer + 1) * 3 * D, rowss + (size_t)(layer + 1) * MT, (LAS float*)(lds + EPI_P_OFF), NREP(5) == 2 ? 0.5f : 1.0f};
                  S.rep = NREP(5);
                  if (bx < Gg) pg8::gemm_phase<pg8::EpiOut<false, true>, pg8::StaticOrder, EPIOUT_ALIGN, PG8_SP2V>(lds, g, S, E);
              } else {
                  pg8::EpiOut<true, true> E{Eb, Eb + (size_t)ML * D, nullptr, mod + (size_t)layer * 3 * (3 * D) + 2 * D, rgsv,
                            Eb, gsv + (size_t)(layer + 1) * 3 * D, rowss + (size_t)(layer + 1) * MT, (LAS float*)(lds + EPI_P_OFF), 1.0f};
                  if (bx < Gg) pg8::gemm_phase<pg8::EpiOut<true, true>, pg8::StaticOrder, EPIOUT_ALIGN, PG8_SP2V>(lds, g, S, E);
              }
              BG_SPARE(Gg, BgTasks{-1, -1, 4 + lp, -1});
          }
          SEAM(pb + 4);
        }
        { const int layer = 2 * lp + 1; const bool last = layer == DEPTH - 1;
          if (SITE(6) && IN(pb + 5)) { PTRS();
              constexpr int Gg = gemm_wgs((MT / 256) * (16384 / 256), G);
              pg8::Gemm g{Eb, (const bf16*)(ws_ + WS_WNIN) + (size_t)lp * 16384 * D, MT, 16384, D}; pg8::StaticOrder S; S.init(MT, 16384, Gg, bx);
              pg8::EpiNaIn E{Ab, Bb, Cb, Db, args.in[I_NQKN] + (size_t)lp * 2 * HDIM, (LAS float*)(lds + EPI_P_OFF), rowss + (size_t)layer * MT, bias2 + (size_t)layer * 3 * pg8::NB2};
              S.rep = NREP(6);
              if (bx < Gg) pg8::gemm_phase<pg8::EpiNaIn, pg8::StaticOrder, true, PG8_SP2V>(lds, g, S, E);
              BG_SPARE(Gg, BgTasks{lp == 0 ? 2 : -1, -1, 6 + lp, -1, 96, 192});
          }
          SEAM(pb + 5);
          if (SITE(7) && IN(pb + 6)) { PTRS();
              { FRESH();
              const int nun = (4 + ((!last && vcu_ < 64) ? 1 : 0)) * NREP(7);
              for (int i2 = 0; i2 < nun; ++i2) { const int i = NREP(7) == 2 ? (i2 >> 1) : i2;
                  const int u = i < 4 ? ((vcu_ >> 5) * 8 + 2 * i + ((vcu_ >> 4) & 1)) * 16 + (vcu_ & 15) : 1024 + vcu_;
                  attn_unit(lds, u, Ab, Bb, Cb, Db, Hb, args.in[I_NRPB] + (size_t)lp * NHEAD * 15 * 31, tid, wave, lane); } }
          }
          SEAM(pb + 6);
          if (SITE(5) && IN(pb + 7)) { PTRS();
              const int Mo = last ? ML : MT;
              const int Gg = last ? gemm_wgs((ML / 256) * (D / 256), G) : gemm_wgs((MT / 256) * (D / 256), G);
              pg8::Gemm g{Hb, (const bf16*)(ws_ + WS_WNOUT) + (size_t)lp * D * D, Mo, D, D}; pg8::StaticOrder S; S.init(Mo, D, Gg, bx);
              const float* rgsv = (const float*)(ws_ + WS_RGS) + (size_t)layer * 3 * D;
              if (!last) {
                  pg8::EpiOut<true, true> E{Eb, Eb + (size_t)ML * D, nullptr, mod + (size_t)layer * 3 * (3 * D) + 2 * D, rgsv,
                            Eb, gsv + (size_t)(layer + 1) * 3 * D, rowss + (size_t)(layer + 1) * MT, (LAS float*)(lds + EPI_P_OFF), 1.0f};
                  if (bx < Gg) pg8::gemm_phase<pg8::EpiOut<true, true>, pg8::StaticOrder, EPIOUT_ALIGN, PG8_SP2V>(lds, g, S, E);
              } else {
                  pg8::EpiOut<true, false> E{Eb, Eb + (size_t)ML * D, args.out, mod + (size_t)layer * 3 * (3 * D) + 2 * D, rgsv,
                            (bf16*)nullptr, gsv, rowss, (LAS float*)(lds + EPI_P_OFF), 1.0f};
                  if (bx < Gg) pg8::gemm_phase<pg8::EpiOut<true, false>, pg8::StaticOrder, EPIOUT_ALIGN, PG8_SP2V>(lds, g, S, E);
              }
              if (!last) BG_SPARE(Gg, BgTasks{-1, 1, 1, -1});
          }
          SEAM(pb + 7);
        }
    }
#if STAMP_SEL
    xcd_barrier(bar);
    if (bx == STAMP_WG && tid == 0) args.out[0] = (float)MISC[20] * 1e-3f;
#endif
#undef IN
#undef SEAM
}

extern "C" void kernel_launch(void* const* d_in, const int* in_sizes, int n_in, void* d_out, int out_size, void* d_ws, size_t ws_size, hipStream_t stream) {
    static int grid = 0;
    if (grid == 0) {
        if (n_in != 18 || ws_size < WS_END) { fprintf(stderr, "kernel_launch: unexpected inputs (n_in %d, ws %zu)\n", n_in, ws_size); grid = -1; return; }
        int dev = 0, cus = 0, per_cu = 0;
        if (hipGetDevice(&dev) != hipSuccess || hipDeviceGetAttribute(&cus, hipDeviceAttributeMultiprocessorCount, dev) != hipSuccess) { grid = -1; return; }
        if (hipFuncSetAttribute((const void*)mega_fwd, hipFuncAttributeMaxDynamicSharedMemorySize, LDS_BYTES) != hipSuccess) { fprintf(stderr, "kernel_launch: hipFuncSetAttribute failed\n"); grid = -1; return; }
        if (hipOccupancyMaxActiveBlocksPerMultiprocessor(&per_cu, (const void*)mega_fwd, NWAVES * 64, LDS_BYTES) != hipSuccess || per_cu < 1)
            fprintf(stderr, "kernel_launch: occupancy query reports %d workgroups per CU\n", per_cu);
        (void)hipGetLastError();
        if (cus != 256) fprintf(stderr, "kernel_launch: built for a 256-CU device (one workgroup per CU), found %d CUs\n", cus);
        grid = 256;
    }
    if (grid < 0) return;
    if (hipMemsetAsync((char*)d_ws + WS_CTL, 0, CTL_ZERO_BYTES, stream) != hipSuccess) return;
    Args a{};
    for (int i = 0; i < 18; ++i) a.in[i] = (const float*)d_in[i];
    a.out = (float*)d_out; a.ws = (unsigned char*)d_ws;
#if MK_PER_PHASE
    for (int p = 0; p < NPHASE; ++p) { a.ph_lo = p; a.ph_hi = p + 1; hipLaunchKernelGGL(mega_fwd, dim3(grid), dim3(NWAVES * 64), LDS_BYTES, stream, a); }
#else
    a.ph_lo = 0; a.ph_hi = NPHASE;
    hipLaunchKernelGGL(mega_fwd, dim3(grid), dim3(NWAVES * 64), LDS_BYTES, stream, a);
#endif
    (void)in_sizes; (void)out_size;
}
```
